# Optimizing an MI355X kernel written in HIP

```python
import jax, jax.numpy as jnp
from jax import lax
import numpy as np

D_MODEL = 1024
BATCH = 8
SEQ = 4096
DEPTH = 2

HEAD_DIM = 64
ROPE_THETA = 10000.0
Q_BLOCK = 128
MLA_HEADS = 4
MLA_NOPE = 64
MLA_ROPE = 32
MLA_V = 64
MLA_Q_LORA = 256
MLA_KV_LORA = 128
MOBA_HEADS = 6
MOBA_BLOCK = 256
MOBA_TOPK = 3
MOBA_Q_CHUNK = 32
DIL_HEADS = 6
DIL_PAIRS = ((128, 1), (512, 4), (2048, 16))
MLA_W = MLA_HEADS * MLA_V
MOBA_W = MOBA_HEADS * HEAD_DIM
DIL_W = DIL_HEADS * HEAD_DIM
MIX_W = MLA_W + MOBA_W + DIL_W
SPLITS = (MLA_Q_LORA, MLA_KV_LORA, MLA_ROPE, 3 * MOBA_W, 3 * DIL_W)
N_IN = sum(SPLITS)
N_EXPERTS = 64
N_GROUPS = 8
EXP_PER_GROUP = N_EXPERTS // N_GROUPS
TOP_K = 2
D_EXPERT = 256
MOE_BLOCK = 128
ALPHA = (2 * DEPTH) ** 0.25
BETA = (8 * DEPTH) ** -0.25
LN_EPS = 1e-5
RMS_EPS = 1e-6

kernel_name = "hymba_mla_moba_dilated_grouped_moe"


def layer_norm(x, g, b):
    xf = x.astype(jnp.float32)
    mu = xf.mean(-1, keepdims=True)
    var = jnp.square(xf - mu).mean(-1, keepdims=True)
    return ((xf - mu) * lax.rsqrt(var + LN_EPS) * g + b).astype(x.dtype)


def rms_norm(x, g):
    xf = x.astype(jnp.float32)
    return (xf * lax.rsqrt(jnp.square(xf).mean(-1, keepdims=True) + RMS_EPS) * g).astype(x.dtype)


def rope_tables(n_pos, dim):
    inv = ROPE_THETA ** (-jnp.arange(0, dim, 2, dtype=jnp.float32) / dim)
    ang = jnp.arange(n_pos, dtype=jnp.float32)[:, None] * inv[None, :]
    return jnp.cos(ang), jnp.sin(ang)


def apply_rope(x, cos, sin):
    x1, x2 = jnp.split(x.astype(jnp.float32), 2, axis=-1)
    return jnp.concatenate([x1 * cos - x2 * sin, x2 * cos + x1 * sin], axis=-1).astype(x.dtype)


def causal_dense_attention(q, k, v):
    B, H, S, Dk = q.shape
    scale = Dk ** -0.5
    kpos = jnp.arange(S)

    def one_block(i):
        qb = lax.dynamic_slice_in_dim(q, i * Q_BLOCK, Q_BLOCK, axis=2)
        s = jnp.einsum('bhqd,bhkd->bhqk', qb, k, preferred_element_type=jnp.float32) * scale
        qpos = i * Q_BLOCK + jnp.arange(Q_BLOCK)
        s = jnp.where(kpos[None, :] <= qpos[:, None], s, -jnp.inf)
        p = jax.nn.softmax(s, axis=-1)
        return jnp.einsum('bhqk,bhkd->bhqd', p.astype(v.dtype), v)

    o = lax.map(one_block, jnp.arange(S // Q_BLOCK))
    return o.transpose(1, 2, 0, 3, 4).reshape(B, H, S, v.shape[-1])


def mla_attention(c_q, c_kv, k_r, q_norm, w_uq, kv_norm, w_ukv):
    B, S, _ = c_q.shape
    cos, sin = rope_tables(S, MLA_ROPE)
    q = (rms_norm(c_q, q_norm) @ w_uq).reshape(B, S, MLA_HEADS, MLA_NOPE + MLA_ROPE).transpose(0, 2, 1, 3)
    q = jnp.concatenate([q[..., :MLA_NOPE], apply_rope(q[..., MLA_NOPE:], cos, sin)], axis=-1)
    kv = (rms_norm(c_kv, kv_norm) @ w_ukv).reshape(B, S, MLA_HEADS, MLA_NOPE + MLA_V).transpose(0, 2, 1, 3)
    k_rope = apply_rope(k_r[:, None], cos, sin)
    k = jnp.concatenate([kv[..., :MLA_NOPE], jnp.broadcast_to(k_rope, (B, MLA_HEADS, S, MLA_ROPE))], axis=-1)
    v = kv[..., MLA_NOPE:]
    return causal_dense_attention(q, k, v)


def moba_attention(q, k, v):
    B, H, S, hd = q.shape
    n_kb = -(-S // MOBA_BLOCK)
    pad = ((0, 0), (0, 0), (0, n_kb * MOBA_BLOCK - S), (0, 0))
    kb = jnp.pad(k, pad).reshape(B, H, n_kb, MOBA_BLOCK, hd)
    vb = jnp.pad(v, pad).reshape(B, H, n_kb, MOBA_BLOCK, hd)
    k_mean = kb.astype(jnp.float32).mean(axis=3)
    gate = jnp.einsum('bhsd,bhnd->bhsn', q.astype(jnp.float32), k_mean)
    q_blk = jnp.arange(S) // MOBA_BLOCK
    gate = jnp.where(jnp.arange(n_kb)[None, :] < q_blk[:, None], gate, -jnp.inf)
    n_sel = min(MOBA_TOPK, n_kb)
    _, g_idx = lax.top_k(gate, n_sel)
    slot_ok = jnp.arange(n_sel)[None, :] < q_blk[:, None]
    bi = jnp.arange(B)[:, None, None, None]
    hi = jnp.arange(H)[None, :, None, None]
    scale = hd ** -0.5
    n_sk = n_sel * MOBA_BLOCK

    def one_chunk(c):
        s0 = c * MOBA_Q_CHUNK
        qc = lax.dynamic_slice_in_dim(q, s0, MOBA_Q_CHUNK, axis=2)
        idx = lax.dynamic_slice_in_dim(g_idx, s0, MOBA_Q_CHUNK, axis=2)
        ok = lax.dynamic_slice_in_dim(slot_ok, s0, MOBA_Q_CHUNK, axis=0)
        ks = kb[bi, hi, idx]
        vs = vb[bi, hi, idx]
        s_sel = jnp.einsum('bhqd,bhqnkd->bhqnk', qc, ks, preferred_element_type=jnp.float32) * scale
        s_sel = jnp.where(ok[None, None, :, :, None], s_sel, -jnp.inf).reshape(B, H, MOBA_Q_CHUNK, n_sk)
        own = s0 // MOBA_BLOCK
        k_own = lax.dynamic_slice_in_dim(kb, own, 1, axis=2)[:, :, 0]
        v_own = lax.dynamic_slice_in_dim(vb, own, 1, axis=2)[:, :, 0]
        s_own = jnp.einsum('bhqd,bhkd->bhqk', qc, k_own, preferred_element_type=jnp.float32) * scale
        qpos = s0 + jnp.arange(MOBA_Q_CHUNK)
        kpos = own * MOBA_BLOCK + jnp.arange(MOBA_BLOCK)
        s_own = jnp.where(kpos[None, :] <= qpos[:, None], s_own, -jnp.inf)
        p = jax.nn.softmax(jnp.concatenate([s_sel, s_own], axis=-1), axis=-1).astype(v.dtype)
        p_sel = p[..., :n_sk].reshape(B, H, MOBA_Q_CHUNK, n_sel, MOBA_BLOCK)
        return (jnp.einsum('bhqnk,bhqnkd->bhqd', p_sel, vs)
                + jnp.einsum('bhqk,bhkd->bhqd', p[..., n_sk:], v_own))

    o = lax.map(one_chunk, jnp.arange(S // MOBA_Q_CHUNK))
    return o.transpose(1, 2, 0, 3, 4).reshape(B, H, S, hd)


def dilated_attention(q, k, v):
    B, H, S, hd = q.shape
    scale = hd ** -0.5
    outs, lses = [], []
    for window, dil in DIL_PAIRS:
        W = window // dil
        unit = dil * W
        S_pad = -(-S // unit) * unit
        L = S_pad // dil
        nb = L // W

        def to_sub(t):
            t = jnp.pad(t, ((0, 0), (0, 0), (0, S_pad - S), (0, 0)))
            return t.reshape(B, H, L, dil, hd).transpose(0, 1, 3, 2, 4)

        def band(t):
            tp = jnp.pad(to_sub(t), ((0, 0), (0, 0), (0, 0), (W, 0), (0, 0))).reshape(B, H, dil, nb + 1, W, hd)
            return jnp.concatenate([tp[:, :, :, :-1], tp[:, :, :, 1:]], axis=4)

        qb = to_sub(q).reshape(B, H, dil, nb, W, hd)
        kw, vw = band(k), band(v)
        s = jnp.einsum('bhrnqd,bhrnkd->bhrnqk', qb, kw, preferred_element_type=jnp.float32) * scale
        ki = jnp.arange(2 * W) - W
        delta = jnp.arange(W)[:, None] - ki[None, :]
        key_abs = jnp.arange(nb)[:, None, None] * W + ki[None, None, :]
        valid = ((delta >= 0) & (delta <= W))[None] & (key_abs >= 0)
        s = jnp.where(valid[None, None, None], s, -jnp.inf)
        m = s.max(axis=-1, keepdims=True)
        e = jnp.exp(s - m)
        l = e.sum(axis=-1, keepdims=True)
        o = jnp.einsum('bhrnqk,bhrnkd->bhrnqd', e, vw.astype(jnp.float32)) / l
        lse = m + jnp.log(l)

        def back(t):
            return t.reshape(B, H, dil, L, t.shape[-1]).transpose(0, 1, 3, 2, 4).reshape(B, H, S_pad, t.shape[-1])[:, :, :S]

        outs.append(back(o))
        lses.append(back(lse))
    w = jax.nn.softmax(jnp.stack(lses, axis=0), axis=0)
    return (w * jnp.stack(outs, axis=0)).sum(axis=0).astype(q.dtype)


def hybrid_mixer(x, w_in, q_norm, w_uq, kv_norm, w_ukv, w_out):
    B, S, _ = x.shape
    h = x @ w_in
    offs = np.cumsum(SPLITS)[:-1].tolist()
    c_q, c_kv, k_r, qkv_b, qkv_c = jnp.split(h, offs, axis=-1)
    cos, sin = rope_tables(S, HEAD_DIM)

    def heads(t, n):
        return t.reshape(B, S, n, HEAD_DIM).transpose(0, 2, 1, 3)

    qb, kb, vb = [heads(t, MOBA_HEADS) for t in jnp.split(qkv_b, 3, axis=-1)]
    qc, kc, vc = [heads(t, DIL_HEADS) for t in jnp.split(qkv_c, 3, axis=-1)]
    o_a = mla_attention(c_q, c_kv, k_r, q_norm, w_uq, kv_norm, w_ukv)
    o_b = moba_attention(apply_rope(qb, cos, sin), apply_rope(kb, cos, sin), vb)
    o_c = dilated_attention(apply_rope(qc, cos, sin), apply_rope(kc, cos, sin), vc)
    o = jnp.concatenate([o_a, o_b, o_c], axis=1).transpose(0, 2, 1, 3).reshape(B, S, MIX_W)
    return o @ w_out


def route(xf, router_w, router_b):
    T = xf.shape[0]
    s = jax.nn.sigmoid((xf @ router_w).astype(jnp.float32))
    sb = (s + router_b.astype(jnp.float32)).reshape(T, N_GROUPS, EXP_PER_GROUP)
    g_sel = jnp.argmax(lax.top_k(sb, 2)[0].sum(-1), axis=-1)
    in_grp = sb[jnp.arange(T), g_sel]
    _, j = lax.top_k(in_grp, TOP_K)
    e_idx = g_sel[:, None] * EXP_PER_GROUP + j
    s_sel = jnp.take_along_axis(s, e_idx, axis=1)
    return e_idx, s_sel / s_sel.sum(-1, keepdims=True)


def moe_ffn(x, router_w, router_b, w1, w3, w2):
    B, S, D = x.shape
    T = B * S
    xf = x.reshape(T, D)
    e_idx, gates = route(xf, router_w, router_b)
    A = T * TOP_K
    e_flat = e_idx.reshape(A)
    t_flat = jnp.repeat(jnp.arange(T), TOP_K)
    order = jnp.argsort(e_flat)
    e_s, t_s, g_s = e_flat[order], t_flat[order], gates.reshape(A)[order]
    counts = jnp.bincount(e_flat, length=N_EXPERTS)
    start = jnp.cumsum(counts) - counts
    padded = (counts + MOE_BLOCK - 1) // MOE_BLOCK * MOE_BLOCK
    pend = jnp.cumsum(padded)
    dest = (pend - padded)[e_s] + (jnp.arange(A) - start[e_s])
    n_rows = A + N_EXPERTS * MOE_BLOCK
    n_blk = n_rows // MOE_BLOCK
    row_tok = jnp.full((n_rows,), T, jnp.int32).at[dest].set(t_s.astype(jnp.int32))
    row_gate = jnp.zeros((n_rows,), x.dtype).at[dest].set(g_s.astype(x.dtype))
    blk_exp = jnp.minimum(jnp.searchsorted(pend, jnp.arange(n_blk) * MOE_BLOCK, side='right'), N_EXPERTS - 1)
    x_pad = jnp.concatenate([xf, jnp.zeros((1, D), x.dtype)], axis=0)

    def one_block(args):
        toks, e = args
        xb = x_pad[toks]
        hb = jax.nn.silu(xb @ w1[e]) * (xb @ w3[e])
        return hb @ w2[e]

    y_rows = lax.map(one_block, (row_tok.reshape(n_blk, MOE_BLOCK), blk_exp)).reshape(n_rows, D)
    y = jax.ops.segment_sum(y_rows * row_gate[:, None], row_tok, num_segments=T + 1)[:T]
    return y.reshape(B, S, D)


def setup_inputs(seed: int = 0) -> dict:
    key = jax.random.key(seed)
    ks = jax.random.split(key, 17)

    def nrm(k, shape, scale):
        return jax.random.normal(k, shape, jnp.float32) * scale

    x = nrm(ks[0], (BATCH, SEQ, D_MODEL), 1.0)
    col = jnp.concatenate([
        jnp.ones((MLA_Q_LORA + MLA_KV_LORA + MLA_ROPE + 2 * MOBA_W,), jnp.float32),
        jnp.full((MOBA_W,), BETA, jnp.float32),
        jnp.ones((2 * DIL_W,), jnp.float32),
        jnp.full((DIL_W,), BETA, jnp.float32)])
    w_in = nrm(ks[1], (DEPTH, D_MODEL, N_IN), D_MODEL ** -0.5) * col
    mla_q_norm = 1.0 + nrm(ks[2], (DEPTH, MLA_Q_LORA), 0.02)
    mla_w_uq = nrm(ks[3], (DEPTH, MLA_Q_LORA, MLA_HEADS * (MLA_NOPE + MLA_ROPE)), MLA_Q_LORA ** -0.5)
    mla_kv_norm = 1.0 + nrm(ks[4], (DEPTH, MLA_KV_LORA), 0.02)
    kv_col = jnp.tile(jnp.concatenate([jnp.ones((MLA_NOPE,), jnp.float32), jnp.full((MLA_V,), BETA, jnp.float32)]), MLA_HEADS)
    mla_w_ukv = nrm(ks[5], (DEPTH, MLA_KV_LORA, MLA_HEADS * (MLA_NOPE + MLA_V)), MLA_KV_LORA ** -0.5) * kv_col
    w_out = nrm(ks[6], (DEPTH, MIX_W, D_MODEL), MIX_W ** -0.5 * BETA)
    ln1_g = 1.0 + nrm(ks[7], (DEPTH, D_MODEL), 0.02)
    ln1_b = nrm(ks[8], (DEPTH, D_MODEL), 0.02)
    router_w = nrm(ks[9], (D_MODEL, N_EXPERTS), D_MODEL ** -0.5)
    router_b = nrm(ks[10], (N_EXPERTS,), 0.01)
    moe_w1 = nrm(ks[11], (DEPTH, N_EXPERTS, D_MODEL, D_EXPERT), D_MODEL ** -0.5)
    moe_w3 = nrm(ks[12], (DEPTH, N_EXPERTS, D_MODEL, D_EXPERT), D_MODEL ** -0.5)
    moe_w2 = nrm(ks[13], (DEPTH, N_EXPERTS, D_EXPERT, D_MODEL), D_EXPERT ** -0.5 * BETA)
    ln2_g = 1.0 + nrm(ks[14], (DEPTH, D_MODEL), 0.02)
    ln2_b = nrm(ks[15], (DEPTH, D_MODEL), 0.02)
    return {"x": x, "w_in": w_in, "mla_q_norm": mla_q_norm, "mla_w_uq": mla_w_uq,
            "mla_kv_norm": mla_kv_norm, "mla_w_ukv": mla_w_ukv, "w_out": w_out,
            "ln1_g": ln1_g, "ln1_b": ln1_b, "router_w": router_w, "router_b": router_b,
            "moe_w1": moe_w1, "moe_w3": moe_w3, "moe_w2": moe_w2,
            "ln2_g": ln2_g, "ln2_b": ln2_b}


def reference(x, w_in, mla_q_norm, mla_w_uq, mla_kv_norm, mla_w_ukv, w_out, ln1_g, ln1_b,
              router_w, router_b, moe_w1, moe_w3, moe_w2, ln2_g, ln2_b):
    for l in range(DEPTH):
        mix = hybrid_mixer(x, w_in[l], mla_q_norm[l], mla_w_uq[l], mla_kv_norm[l], mla_w_ukv[l], w_out[l])
        x = layer_norm(ALPHA * x + mix, ln1_g[l], ln1_b[l])
        ffn = moe_ffn(x, router_w, router_b, moe_w1[l], moe_w3[l], moe_w2[l])
        x = layer_norm(ALPHA * x + ffn, ln2_g[l], ln2_b[l])
    return x
```

```cpp
#include <hip/hip_runtime.h>
#include <cstdio>
#include <cstdint>

#define LAS __attribute__((address_space(3)))
#define GAS __attribute__((address_space(1)))
typedef unsigned short bf16_t;
typedef short bf16x8 __attribute__((ext_vector_type(8)));
typedef short s16x4 __attribute__((ext_vector_type(4)));
typedef float f32x2 __attribute__((ext_vector_type(2)));
typedef float f32x4 __attribute__((ext_vector_type(4)));
typedef float f32x16 __attribute__((ext_vector_type(16)));
typedef unsigned u32x2 __attribute__((ext_vector_type(2)));
typedef unsigned u32x4 __attribute__((ext_vector_type(4)));
typedef GAS unsigned gu32;

constexpr int BATCH = 8, SEQ = 4096, DM = 1024, T = BATCH * SEQ, DEPTH = 2;
constexpr int N_IN = 2720, N_INP = 2816;
constexpr int NEXP = 64, DEXP = 256, CAP = T;
constexpr float ALPHA = 1.4142135623730951f;
constexpr float LN_EPS = 1e-5f, RMS_EPS = 1e-6f;
constexpr float LOG2E = 1.4426950408889634f;
constexpr int NWAVES = 8, NTHREADS = 512;

constexpr size_t MiB = 1u << 20;
constexpr size_t WS_CTL = 0, CTL_BYTES = 2 * MiB;
constexpr size_t WS_T64 = 2 * MiB;
constexpr size_t WS_T32 = 3 * MiB;
constexpr size_t WS_GB = 3 * MiB + 512 * 1024;
constexpr size_t WS_WIN = 4 * MiB;
constexpr size_t WIN_L = (size_t)N_INP * DM * 2;
constexpr size_t WS_WOUT = 15 * MiB;
constexpr size_t WS_WUQ = 19 * MiB;
constexpr size_t WS_WUKV = 19 * MiB + 512 * 1024;
constexpr size_t WS_RW = 20 * MiB;
constexpr size_t WS_STATS = 21 * MiB;
constexpr size_t WS_TOKSLOT = 22 * MiB;
constexpr size_t WS_GATE = 30 * MiB;
constexpr size_t WS_XB = 38 * MiB;
constexpr size_t WS_A = 102 * MiB;
constexpr size_t WS_QKV = WS_A;
constexpr size_t SEG_ELEMS = (size_t)T * 384;
constexpr size_t WS_QA = WS_A + 144 * MiB;
constexpr size_t WS_KA = WS_A + 168 * MiB;
constexpr size_t WS_VA = WS_A + 192 * MiB;
constexpr size_t WS_CQ = WS_A + 208 * MiB;
constexpr size_t WS_CKV = WS_A + 224 * MiB;
constexpr size_t WS_KR = WS_A + 232 * MiB;
constexpr size_t WS_Y = WS_A;
constexpr size_t WS_H = WS_A + 144 * MiB;
constexpr size_t WS_MOE = 336 * MiB;
constexpr size_t MOE_L = 96 * MiB;
constexpr size_t WS_END = WS_MOE + 2 * MOE_L;
constexpr int CW_BAR = 4096;
constexpr int CW_QUEUE = 8192;
constexpr int CW_CNT = 8192 + 256;
constexpr int CW_KMEAN = 65536;
static_assert((CW_KMEAN + 2 * 8 * 6 * 16 * 64) * 4 <= (int)CTL_BYTES, "ctl");

constexpr int LDS_BYTES = 147456;
constexpr int LDSCTL_OFF = 146432;
constexpr int LC_BAR = 0, LC_BCAST = 2, LC_TB = 16, LC_CNT = 96;

__device__ const float INV64[32] = {1.000000000e+00f, 7.498942614e-01f, 5.623413324e-01f, 4.216965139e-01f, 3.162277639e-01f, 2.371373773e-01f, 1.778279394e-01f, 1.333521307e-01f, 1.000000015e-01f, 7.498941571e-02f, 5.623413250e-02f, 4.216965288e-02f, 3.162277490e-02f, 2.371373773e-02f, 1.778279431e-02f, 1.333521493e-02f, 9.999999776e-03f, 7.498941850e-03f, 5.623413250e-03f, 4.216964822e-03f, 3.162277630e-03f, 2.371373586e-03f, 1.778279431e-03f, 1.333521446e-03f, 1.000000047e-03f, 7.498942432e-04f, 5.623413017e-04f, 4.216965172e-04f, 3.162277571e-04f, 2.371373703e-04f, 1.778279402e-04f, 1.333521504e-04f};
__device__ const float INV32[16] = {1.000000000e+00f, 5.623413324e-01f, 3.162277639e-01f, 1.778279394e-01f, 1.000000015e-01f, 5.623413250e-02f, 3.162277490e-02f, 1.778279431e-02f, 9.999999776e-03f, 5.623413250e-03f, 3.162277630e-03f, 1.778279431e-03f, 1.000000047e-03f, 5.623413017e-04f, 3.162277571e-04f, 1.778279402e-04f};

#define LDS_WAIT() asm volatile("s_waitcnt lgkmcnt(0)" ::: "memory")
#define VM_WAIT() asm volatile("s_waitcnt vmcnt(0)" ::: "memory")
#define RLX_AGENT __ATOMIC_RELAXED, __HIP_MEMORY_SCOPE_AGENT
__device__ __forceinline__ unsigned f2bf(float f) { unsigned u = __builtin_bit_cast(unsigned, f); return (u + 0x7fffu + ((u >> 16) & 1u)) >> 16; }
__device__ __forceinline__ unsigned pk2(float lo, float hi) { return f2bf(lo) | (f2bf(hi) << 16); }
__device__ __forceinline__ float bf2f(unsigned short b) { return __builtin_bit_cast(float, (unsigned)b << 16); }
__device__ __forceinline__ float bflo(unsigned w) { return __builtin_bit_cast(float, w << 16); }
__device__ __forceinline__ float bfhi(unsigned w) { return __builtin_bit_cast(float, w & 0xffff0000u); }
__device__ __forceinline__ int crow(int r, int hi) { return (r & 3) + 8 * (r >> 2) + 4 * hi; }
__device__ __forceinline__ float wave_sum(float v) {
#pragma unroll
    for (int o = 1; o < 64; o <<= 1) v += __shfl_xor(v, o);
    return v;
}
__device__ __forceinline__ float xhalf(float v) {
    auto rr = __builtin_amdgcn_permlane32_swap(__float_as_uint(v), __float_as_uint(v), false, false);
    return (threadIdx.x & 32) ? __uint_as_float(rr[0]) : __uint_as_float(rr[1]);
}

namespace pg8 {
constexpr int BM = 256, BK = 64, HALF = 128, HTB = HALF * BK * 2, STAGE_BYTES = 8 * HTB, NXCD = 8, WGM = 8;
__host__ __device__ __forceinline__ int lds_byte(int r, int c) { const int st = (r >> 4) * 2 + (c >> 5), rr = r & 15, cc = c & 31, ob = rr * 64 + cc * 2; return st * 1024 + (ob ^ (((ob >> 9) & 1) << 5)); }
__host__ __device__ __forceinline__ void stage_rc(int b, int& R, int& C) { const int st = b / 1024, sb = b % 1024, swz = sb ^ (((sb >> 9) & 1) << 5); R = (st >> 1) * 16 + swz / 64; C = (st & 1) * 32 + (swz % 64) / 2; }
__host__ __device__ __forceinline__ int perm32(int rho) { const int n = rho >> 4, i = rho & 15; return 8 * (i >> 2) + 4 * n + (i & 3); }

struct Unit { int pm, pn; };

struct StaticOrder {
    int nM, nN, nwg, G, c;
    __device__ void init(int M, int N, int G_, int c_) { nM = M / BM; nN = N / BM; nwg = nM * nN; G = G_; c = c_; }
    __device__ bool next(int i, Unit& u) const {
        const long L = (long)i * G + c; if (L >= nwg) return false;
        int wgid = (int)L; { const int q = nwg / NXCD, r = nwg % NXCD, xcd = wgid % NXCD, off = wgid / NXCD; wgid = (xcd < r ? xcd * (q + 1) : r * (q + 1) + (xcd - r) * q) + off; }
        const int nig = WGM * nN, gid = wgid / nig, fm = gid * WGM, gsz = (nM - fm) < WGM ? (nM - fm) : WGM;
        u.pm = fm + ((wgid % nig) % gsz); u.pn = (wgid % nig) / gsz; return true;
    }
    __device__ __forceinline__ int a_row(const Unit& u, int r) const { return u.pm * BM + r; }
};

template <class Epi, class Sched, bool ALIGN_EPI, bool SP2>
__device__ __forceinline__ void gemm_phase(const int tid, LAS unsigned char* lds, const bf16_t* A, const bf16_t* Bt, const int K, const Sched& S, const Epi& E) {
    const int wid = __builtin_amdgcn_readfirstlane(tid >> 6), lane = tid & 63, wr = wid >> 2, wc = wid & 3, fr = lane & 15, fq = lane >> 4;
    const int nt = K / BK;
    int Rr[2], Cc[2]; unsigned voffB[2];
#pragma unroll
    for (int i = 0; i < 2; ++i) { int R, C; stage_rc(tid * 16 + i * 8192, R, C); const int Rb = Epi::PERM ? ((R & ~31) + perm32(R & 31)) : R;
        Rr[i] = R; Cc[i] = C; voffB[i] = (unsigned)(Rb * K + C) * 2u; }
    const size_t kstep = (size_t)(BK * 2);
    const size_t hstep = (size_t)HALF * K * 2;
    const size_t tstep = 2 * hstep;
    const unsigned ldsw = (unsigned)wid * 1024u;
    const int aoff = lds_byte(wr * 64 + fr, fq * 8), boff = lds_byte(wc * 32 + fr, fq * 8);
#define PG8_SA(b, h) (((b) * 2 + (h)) * HTB)
#define PG8_SB(b, h) ((4 + (b) * 2 + (h)) * HTB)
#define PG8_STAGE(bufoff, gbase, voff) do { _Pragma("unroll") for (int _i = 0; _i < 2; ++_i) \
        __builtin_amdgcn_global_load_lds((const unsigned*)((const char*)(gbase) + (voff)[_i]), (LAS unsigned*)(lds + (bufoff) + ldsw + _i * 8192), 16, 0, 0); } while (0)
#define PG8_AVOFF(dst, u) do { _Pragma("unroll") for (int _h = 0; _h < 2; ++_h) _Pragma("unroll") for (int _i = 0; _i < 2; ++_i) \
        dst[_h][_i] = (unsigned)((unsigned)S.a_row(u, _h * HALF + Rr[_i]) * (unsigned)K + (unsigned)Cc[_i]) * 2u; } while (0)
#define PG8_LDA(dst, b, h) do { _Pragma("unroll") for (int m = 0; m < 4; ++m) _Pragma("unroll") for (int k = 0; k < 2; ++k) dst[m][k] = *(const LAS bf16x8*)(lds + PG8_SA(b, h) + aoff + m * 2048 + k * 1024); } while (0)
#define PG8_LDB(dst, b, h) do { _Pragma("unroll") for (int n = 0; n < 2; ++n) _Pragma("unroll") for (int k = 0; k < 2; ++k) dst[n][k] = *(const LAS bf16x8*)(lds + PG8_SB(b, h) + boff + n * 2048 + k * 1024); } while (0)
#define PG8_MMA(ai, bj, At, Bt_) do { __builtin_amdgcn_s_setprio(1); _Pragma("unroll") for (int m = 0; m < 4; ++m) _Pragma("unroll") for (int n = 0; n < 2; ++n) _Pragma("unroll") for (int k = 0; k < 2; ++k) \
        acc[ai][bj][m][n] = __builtin_amdgcn_mfma_f32_16x16x32_bf16(Bt_[n][k], At[m][k], acc[ai][bj][m][n], 0, 0, 0); __builtin_amdgcn_s_setprio(0); } while (0)
#define PG8_WAIT_V(n) asm volatile("s_waitcnt vmcnt(" #n ")" ::: "memory")
#define PG8_WAIT_L(n) asm volatile("s_waitcnt lgkmcnt(" #n ")" ::: "memory")
#define PG8_BAR __builtin_amdgcn_s_barrier()
#define PG8_SCHED __builtin_amdgcn_sched_barrier(0)
    Unit cur, nxt; int ui = 0;
    if (!S.next(0, cur)) return;
    f32x4 acc[2][2][4][2];
#pragma unroll
    for (int a = 0; a < 2; ++a)
#pragma unroll
        for (int b = 0; b < 2; ++b)
#pragma unroll
            for (int m = 0; m < 4; ++m)
#pragma unroll
                for (int n = 0; n < 2; ++n) acc[a][b][m][n] = (f32x4){0.f, 0.f, 0.f, 0.f};
    bf16x8 At[4][2], B0[2][2], B1[2][2];
    unsigned vc[2][2], vn[2][2];
    PG8_AVOFF(vc, cur);
    const char* cB = (const char*)Bt + (size_t)cur.pn * tstep;
    const char* gA = (const char*)A;
    if constexpr (SP2) {
        PG8_STAGE(PG8_SB(0, 0), cB, voffB); PG8_STAGE(PG8_SB(0, 1), cB + hstep, voffB); PG8_STAGE(PG8_SA(0, 0), gA, vc[0]); PG8_STAGE(PG8_SA(0, 1), gA, vc[1]);
        if (wr == 1) PG8_BAR;
        PG8_WAIT_V(2); PG8_BAR;
        PG8_STAGE(PG8_SB(1, 0), cB + kstep, voffB); PG8_STAGE(PG8_SA(1, 0), gA + kstep, vc[0]); PG8_STAGE(PG8_SB(1, 1), cB + hstep + kstep, voffB);
        PG8_WAIT_V(6); PG8_BAR;
    } else {
        PG8_STAGE(PG8_SB(0, 0), cB, voffB); PG8_STAGE(PG8_SA(0, 0), gA, vc[0]); PG8_STAGE(PG8_SB(0, 1), cB + hstep, voffB); PG8_STAGE(PG8_SA(0, 1), gA, vc[1]);
        if (wr == 1) PG8_BAR;
        PG8_WAIT_V(4); PG8_BAR;
        PG8_STAGE(PG8_SB(1, 0), cB + kstep, voffB); PG8_STAGE(PG8_SA(1, 0), gA + kstep, vc[0]); PG8_STAGE(PG8_SB(1, 1), cB + hstep + kstep, voffB);
        PG8_WAIT_V(6); PG8_BAR;
    }
    for (;;) {
        const bool has_next = S.next(ui + 1, nxt);
        if (has_next) { PG8_AVOFF(vn, nxt); } else {
#pragma unroll
            for (int h = 0; h < 2; ++h)
#pragma unroll
                for (int i = 0; i < 2; ++i) vn[h][i] = vc[h][i]; }
        const char* nB = has_next ? (const char*)Bt + (size_t)nxt.pn * tstep : cB;
        for (int t = 0; t < nt; t += 2) {
            const bool last = (t == nt - 2);
            const char* a1 = gA + (size_t)(t + 1) * kstep;
            const char* a2 = last ? gA : gA + (size_t)(t + 2) * kstep; const char* b2 = last ? nB : cB + (size_t)(t + 2) * kstep;
            const char* a3 = a2 + kstep; const char* b3 = b2 + kstep;
            unsigned v2[2][2];
#pragma unroll
            for (int h = 0; h < 2; ++h)
#pragma unroll
                for (int i = 0; i < 2; ++i) v2[h][i] = last ? vn[h][i] : vc[h][i];
            if constexpr (SP2) {
            PG8_LDB(B0, 0, 0); PG8_LDB(B1, 0, 1); PG8_SCHED; PG8_LDA(At, 0, 0); PG8_STAGE(PG8_SA(1, 1), a1, vc[1]);
            PG8_WAIT_V(8); PG8_WAIT_L(0); PG8_BAR; PG8_MMA(0, 0, At, B0); PG8_MMA(0, 1, At, B1); PG8_BAR; PG8_SCHED;
            PG8_LDA(At, 0, 1); PG8_STAGE(PG8_SB(0, 0), b2, voffB); PG8_STAGE(PG8_SB(0, 1), b2 + hstep, voffB); PG8_STAGE(PG8_SA(0, 0), a2, v2[0]);
            PG8_WAIT_V(8); PG8_WAIT_L(0); PG8_BAR; PG8_MMA(1, 0, At, B0); PG8_MMA(1, 1, At, B1); PG8_BAR; PG8_SCHED;
            PG8_LDB(B0, 1, 0); PG8_LDB(B1, 1, 1); PG8_SCHED; PG8_LDA(At, 1, 0); PG8_STAGE(PG8_SA(0, 1), a2, v2[1]);
            PG8_WAIT_V(8); PG8_WAIT_L(0); PG8_BAR; PG8_MMA(0, 0, At, B0); PG8_MMA(0, 1, At, B1); PG8_BAR; PG8_SCHED;
            PG8_LDA(At, 1, 1); PG8_STAGE(PG8_SB(1, 0), b3, voffB); PG8_STAGE(PG8_SB(1, 1), b3 + hstep, voffB); PG8_STAGE(PG8_SA(1, 0), a3, v2[0]);
            PG8_WAIT_V(8); PG8_WAIT_L(0); PG8_BAR; PG8_MMA(1, 0, At, B0); PG8_MMA(1, 1, At, B1); PG8_BAR; PG8_SCHED;
            } else {
            PG8_LDB(B0, 0, 0); PG8_SCHED; PG8_LDA(At, 0, 0); PG8_STAGE(PG8_SA(1, 1), a1, vc[1]);
            PG8_WAIT_L(8); PG8_BAR; PG8_WAIT_L(0); PG8_MMA(0, 0, At, B0); PG8_BAR; PG8_SCHED;
            PG8_LDB(B1, 0, 1); PG8_STAGE(PG8_SB(0, 0), b2, voffB);
            PG8_BAR; PG8_WAIT_L(0); PG8_MMA(0, 1, At, B1); PG8_BAR;
            PG8_LDA(At, 0, 1); PG8_STAGE(PG8_SA(0, 0), a2, v2[0]);
            PG8_BAR; PG8_WAIT_L(0); PG8_MMA(1, 0, At, B0); PG8_BAR; PG8_SCHED;
            PG8_STAGE(PG8_SB(0, 1), b2 + hstep, voffB);
            PG8_WAIT_V(6); PG8_BAR; PG8_MMA(1, 1, At, B1); PG8_BAR;
            PG8_LDB(B0, 1, 0); PG8_SCHED; PG8_LDA(At, 1, 0); PG8_STAGE(PG8_SA(0, 1), a2, v2[1]);
            PG8_WAIT_L(8); PG8_BAR; PG8_WAIT_L(0); PG8_MMA(0, 0, At, B0); PG8_BAR; PG8_SCHED;
            PG8_LDB(B1, 1, 1); PG8_STAGE(PG8_SB(1, 0), b3, voffB);
            PG8_BAR; PG8_WAIT_L(0); PG8_MMA(0, 1, At, B1); PG8_BAR;
            PG8_LDA(At, 1, 1); PG8_STAGE(PG8_SA(1, 0), a3, v2[0]);
            PG8_BAR; PG8_WAIT_L(0); PG8_MMA(1, 0, At, B0); PG8_BAR; PG8_SCHED;
            PG8_STAGE(PG8_SB(1, 1), b3 + hstep, voffB);
            PG8_WAIT_V(6); PG8_BAR; PG8_MMA(1, 1, At, B1); PG8_BAR;
            }
        }
        if constexpr (ALIGN_EPI) { if (wr == 0) PG8_BAR; }
        E(acc, cur, wr, wc, fr, fq);
        if (!has_next) break;
#pragma unroll
        for (int a = 0; a < 2; ++a)
#pragma unroll
            for (int b = 0; b < 2; ++b)
#pragma unroll
                for (int m = 0; m < 4; ++m)
#pragma unroll
                    for (int n = 0; n < 2; ++n) acc[a][b][m][n] = (f32x4){0.f, 0.f, 0.f, 0.f};
        cur = nxt; cB = nB; ++ui;
#pragma unroll
        for (int h = 0; h < 2; ++h)
#pragma unroll
            for (int i = 0; i < 2; ++i) vc[h][i] = vn[h][i];
        if constexpr (ALIGN_EPI) { if (wr == 1) PG8_BAR; }
    }
    PG8_WAIT_V(0);
    if constexpr (!ALIGN_EPI) { if (wr == 0) PG8_BAR; }
    PG8_BAR;
#undef PG8_SA
#undef PG8_SB
#undef PG8_STAGE
#undef PG8_AVOFF
#undef PG8_LDA
#undef PG8_LDB
#undef PG8_MMA
#undef PG8_WAIT_V
#undef PG8_WAIT_L
#undef PG8_BAR
#undef PG8_SCHED
}
}

#define XB_TMO      128
#define XB_XCNT(j)  (256  + 64 * (j))
#define XB_XSUB(j)  (1280 + 64 * (j))
#define XB_XGEN(j)  (2304 + 64 * (j))
#define XB_TOP      3328
#define XB_TOPGEN   3392
#define XCD_BAR_WORDS 3456
#define XB_SPIN_CAP (1u << 20)
__device__ __forceinline__ unsigned xb_ld(unsigned* p)              { return __hip_atomic_load(p, __ATOMIC_RELAXED, __HIP_MEMORY_SCOPE_AGENT); }
__device__ __forceinline__ unsigned xb_add(unsigned* p, unsigned v) { return __hip_atomic_fetch_add(p, v, __ATOMIC_RELAXED, __HIP_MEMORY_SCOPE_AGENT); }
__device__ __forceinline__ unsigned xb_xcc_id() { return (unsigned)__builtin_amdgcn_s_getreg((3 << 11) | 20) & 0xFu; }
#define XB_SPIN(cond, bar) do { unsigned _sp = 0; while (cond) { __builtin_amdgcn_s_sleep(1); \
    if ((++_sp & 255u) == 0u) { if (xb_ld(&(bar)[XB_TMO])) break; if (_sp > XB_SPIN_CAP) { atomicAdd(&(bar)[XB_TMO], 1u); break; } } } } while (0)
struct XcdBarrier { unsigned* bar; unsigned x; volatile LAS unsigned* st; };
__device__ __forceinline__ XcdBarrier xcd_barrier_post(unsigned* bar, volatile LAS unsigned* st) {
    XcdBarrier b; b.bar = bar; b.x = xb_xcc_id(); b.st = st;
    if (threadIdx.x == 0) (void)xb_add(&bar[XB_XCNT(b.x)], 1u);
    return b;
}
__device__ __forceinline__ void xcd_barrier_complete(unsigned* bar, unsigned x, unsigned& nloc, unsigned& nx) {
    const unsigned G = gridDim.x * gridDim.y * gridDim.z;
    unsigned sum, cnt, mine, sp = 0u;
    for (;;) {
        sum = 0u; cnt = 0u; mine = 0u;
#pragma unroll
        for (unsigned j = 0; j < 16; ++j) { const unsigned c = xb_ld(&bar[XB_XCNT(j)]); sum += c; cnt += (c > 0u) ? 1u : 0u; mine = (j == x) ? c : mine; }
        if (sum == G) break;
        __builtin_amdgcn_s_sleep(1);
        if ((++sp & 255u) == 0u) { if (xb_ld(&bar[XB_TMO])) break; if (sp > XB_SPIN_CAP) { atomicAdd(&bar[XB_TMO], 1u); break; } }
    }
    nloc = mine > 0u ? mine : 1u; nx = cnt > 0u ? cnt : 1u;
}
__device__ __forceinline__ void xcd_barrier(const XcdBarrier& b) {
    asm volatile("s_waitcnt vmcnt(0)" ::: "memory");
    __syncthreads();
    if (threadIdx.x == 0) {
        unsigned* bar = b.bar;
        __builtin_amdgcn_s_waitcnt(0);
        unsigned nloc = b.st[0], nx = b.st[1];
        if (nloc == 0u) { xcd_barrier_complete(bar, b.x, nloc, nx); b.st[0] = nloc; b.st[1] = nx; }
        const unsigned old = xb_add(&bar[XB_XSUB(b.x)], 1u);
        const unsigned gen = old / nloc;
        if (old + 1u == (gen + 1u) * nloc) {
            __builtin_amdgcn_fence(__ATOMIC_RELEASE, "agent");
            asm volatile("s_waitcnt vmcnt(0)" ::: "memory");
            const unsigned og = xb_add(&bar[XB_TOP], 1u);
            const unsigned tg = og / nx;
            if (og + 1u == (tg + 1u) * nx) xb_add(&bar[XB_TOPGEN], 1u);
            else XB_SPIN(xb_ld(&bar[XB_TOPGEN]) == tg, bar);
            __builtin_amdgcn_fence(__ATOMIC_ACQUIRE, "agent");
            xb_add(&bar[XB_XGEN(b.x)], 1u);
            asm volatile("s_waitcnt vmcnt(0)" ::: "memory");
        } else {
            XB_SPIN(xb_ld(&bar[XB_XGEN(b.x)]) == gen, bar);
            __builtin_amdgcn_fence(__ATOMIC_ACQUIRE, "agent");
            asm volatile("s_waitcnt vmcnt(0)" ::: "memory");
        }
    }
    __syncthreads();
}

struct Args {
    const float* x; const float* w_in; const float* q_norm; const float* w_uq; const float* kv_norm; const float* w_ukv; const float* w_out;
    const float* ln1_g; const float* ln1_b; const float* router_w; const float* router_b; const float* w1; const float* w3; const float* w2;
    const float* ln2_g; const float* ln2_b;
    float* out; unsigned char* ws;
    int ph_lo, ph_hi;
};
struct Frame {
    LAS unsigned char* lds;
    volatile LAS unsigned* LC;
    gu32* ctl;
    unsigned char* ws;
    int tid, lane, wave, vcu, G;
};

template <class Map>
__device__ __forceinline__ void transpose_item(const float* W, int K, int N, bf16_t* WT, const float* kscale, LAS float* scr, int item, int lane, Map map) {
    const int nblk = N / 32, kb = item / nblk, nb = item % nblk, k0 = 64 * kb, n0 = 32 * nb;
#pragma unroll 8
    for (int i = 0; i < 32; ++i) { const int kk = 2 * i + (lane >> 5); float v = W[(size_t)(k0 + kk) * N + n0 + (lane & 31)]; if (kscale) v *= kscale[k0 + kk]; scr[kk * 33 + (lane & 31)] = v; }
    LDS_WAIT(); asm volatile("" ::: "memory");
    const int c = lane & 7;
#pragma unroll
    for (int j = 0; j < 4; ++j) { const int n = (lane >> 3) + 8 * j; const LAS float* s = scr + (8 * c) * 33 + n;
        u32x4 o; o.x = pk2(s[0], s[33]); o.y = pk2(s[66], s[99]); o.z = pk2(s[132], s[165]); o.w = pk2(s[198], s[231]);
        const int row = map(n0 + n);
        *(GAS u32x4*)(WT + (size_t)row * K + k0 + 8 * c) = o; }
    LDS_WAIT(); asm volatile("" ::: "memory");
}
__device__ __forceinline__ void router_item(const float* W, const float* g, bf16_t* WH, bf16_t* WL, LAS float* scr, int item, int lane) {
    const int K = 1024, N = 64, nblk = 2, kb = item / nblk, nb = item % nblk, k0 = 64 * kb, n0 = 32 * nb;
#pragma unroll 8
    for (int i = 0; i < 32; ++i) { const int kk = 2 * i + (lane >> 5); scr[kk * 33 + (lane & 31)] = W[(size_t)(k0 + kk) * N + n0 + (lane & 31)] * g[k0 + kk]; }
    LDS_WAIT(); asm volatile("" ::: "memory");
    const int c = lane & 7;
#pragma unroll
    for (int j = 0; j < 4; ++j) { const int n = (lane >> 3) + 8 * j; const LAS float* s = scr + (8 * c) * 33 + n;
        unsigned h[8], l[8];
#pragma unroll
        for (int q = 0; q < 8; ++q) { const float v = s[q * 33]; h[q] = f2bf(v); l[q] = f2bf(v - __builtin_bit_cast(float, h[q] << 16)); }
        u32x4 oh, ol; oh.x = h[0] | (h[1] << 16); oh.y = h[2] | (h[3] << 16); oh.z = h[4] | (h[5] << 16); oh.w = h[6] | (h[7] << 16);
        ol.x = l[0] | (l[1] << 16); ol.y = l[2] | (l[3] << 16); ol.z = l[4] | (l[5] << 16); ol.w = l[6] | (l[7] << 16);
        *(GAS u32x4*)(WH + (size_t)(n0 + n) * K + k0 + 8 * c) = oh; *(GAS u32x4*)(WL + (size_t)(n0 + n) * K + k0 + 8 * c) = ol; }
    LDS_WAIT(); asm volatile("" ::: "memory");
}
struct MapId { int off; __device__ __forceinline__ int operator()(int n) const { return off + n; } };
struct MapWin { __device__ __forceinline__ int operator()(int n) const {
    if (n < 384) return n;
    if (n < 416) { const int e = n - 384, nn = e >> 4, fq = (e >> 2) & 3, j = e & 3; return 384 + 8 * fq + 4 * nn + j; }
    const int m = n - 416, seg = m / 384, r = m % 384, hh = r >> 6, e = r & 63, base = 512 + seg * 384 + hh * 64;
    if (seg == 2 || seg == 5) return base + e;
    const int nn = e >> 5, wcl = (e >> 4) & 1, fq = (e >> 2) & 3, j = e & 3; return base + 32 * wcl + 8 * fq + 4 * nn + j; } };
struct MapW13 { int e, which; __device__ __forceinline__ int operator()(int n) const { return e * 512 + 256 * (n >> 7) + 128 * which + (n & 127); } };

__device__ __forceinline__ void sincos_d(double a, float& s, float& c) {
    const double TWO_PI = 6.283185307179586476925, INV = 0.15915494309189533577;
    const double k = __builtin_rint(a * INV); const double r = a - k * TWO_PI; const double r2 = r * r;
    double ts = r, ss = r, tc = 1.0, cs = 1.0;
    for (int n = 1; n <= 14; ++n) { tc *= -r2 / (double)((2 * n - 1) * (2 * n)); cs += tc; ts *= -r2 / (double)((2 * n) * (2 * n + 1)); ss += ts; }
    s = (float)ss; c = (float)cs;
}

__device__ __forceinline__ void p0_prologue(Frame& F, const Args& a) {
    LAS float* scr = (LAS float*)(F.lds + F.wave * 16384);
    const int gw = F.vcu * NWAVES + F.wave, NGW = F.G * NWAVES, lane = F.lane;
    unsigned char* ws = F.ws;
    constexpr int I_WIN = 16 * 85, I_WUQ = 4 * 12, I_WUKV = 2 * 16, I_WOUT = 16 * 32, I_RW = 16 * 2, I_MOE = 128;
    constexpr int PER_L = I_WIN + I_WUQ + I_WUKV + I_WOUT + I_RW;
    constexpr int N_SMALL = 2 * PER_L, N_MOE = 2 * 64 * 3 * I_MOE, NITEMS = N_SMALL + N_MOE;
    for (int it = gw; it < NITEMS; it += NGW) {
        if (it >= N_SMALL) {
            int r = it - N_SMALL; const int item = r % I_MOE; r /= I_MOE; const int which = r % 3; r /= 3; const int e = r % 64, l = r / 64;
            bf16_t* W13t = (bf16_t*)(ws + WS_MOE + (size_t)l * MOE_L); bf16_t* W2t = (bf16_t*)(ws + WS_MOE + (size_t)l * MOE_L + 64 * MiB);
            const size_t eoff = ((size_t)l * 64 + e) * (size_t)(1024 * 256);
            if (which == 0) transpose_item(a.w1 + eoff, 1024, 256, W13t, nullptr, scr, item, lane, MapW13{e, 0});
            else if (which == 1) transpose_item(a.w3 + eoff, 1024, 256, W13t, nullptr, scr, item, lane, MapW13{e, 1});
            else transpose_item(a.w2 + eoff, 256, 1024, W2t, nullptr, scr, item, lane, MapId{e * 1024});
            continue;
        }
        const int l = it / PER_L; int r = it % PER_L;
        if (r < I_WIN) { transpose_item(a.w_in + (size_t)l * 1024 * N_IN, 1024, N_IN, (bf16_t*)(ws + WS_WIN + (size_t)l * WIN_L), nullptr, scr, r, lane, MapWin{}); continue; } r -= I_WIN;
        if (r < I_WUQ) { transpose_item(a.w_uq + (size_t)l * 256 * 384, 256, 384, (bf16_t*)(ws + WS_WUQ) + (size_t)l * 384 * 256, a.q_norm + l * 256, scr, r, lane, MapId{0}); continue; } r -= I_WUQ;
        if (r < I_WUKV) { transpose_item(a.w_ukv + (size_t)l * 128 * 512, 128, 512, (bf16_t*)(ws + WS_WUKV) + (size_t)l * 512 * 128, a.kv_norm + l * 128, scr, r, lane, MapId{0}); continue; } r -= I_WUKV;
        if (r < I_WOUT) { transpose_item(a.w_out + (size_t)l * 1024 * 1024, 1024, 1024, (bf16_t*)(ws + WS_WOUT) + (size_t)l * 1024 * 1024, nullptr, scr, r, lane, MapId{0}); continue; } r -= I_WOUT;
        router_item(a.router_w, a.ln1_g + l * 1024, (bf16_t*)(ws + WS_RW) + (size_t)(l * 2) * 65536, (bf16_t*)(ws + WS_RW) + (size_t)(l * 2 + 1) * 65536, scr, r, lane);
    }
    { const int gt = gw * 64 + lane, NT_ = NGW * 64;
      for (int i = gt; i < 2 * 96 * 128; i += NT_) { const int l = i / (96 * 128), r = i % (96 * 128);
          *(GAS u32x4*)(ws + WS_WIN + (size_t)l * WIN_L + (size_t)416 * 2048 + (size_t)r * 16) = (u32x4){0u, 0u, 0u, 0u}; }
      for (int i = gt; i < 4096 * 32; i += NT_) { const int pos = i >> 5, f = i & 31; const float ang = (float)pos * INV64[f]; float s, c; sincos_d((double)ang, s, c);
          ((GAS f32x2*)(ws + WS_T64))[i] = (f32x2){c, s}; }
      for (int i = gt; i < 4096 * 16; i += NT_) { const int pos = i >> 4, f = i & 15; const float ang = (float)pos * INV32[f]; float s, c; sincos_d((double)ang, s, c);
          ((GAS f32x2*)(ws + WS_T32))[i] = (f32x2){c, s}; }
    }
    for (int it = gw; it < 256; it += NGW) { const int e = it & 63, which = (it >> 6) & 1, l = it >> 7;
        const float* v = (which ? a.ln1_b : a.ln1_g) + l * 1024; float s = 0.f;
        for (int i = 0; i < 16; ++i) { const int c = lane + 64 * i; s += v[c] * a.router_w[c * 64 + e]; }
        s = wave_sum(s); if (lane == 0) ((GAS float*)(ws + WS_GB))[it] = s; }
    { bf16_t* xb = (bf16_t*)(ws + WS_XB);
      for (int it = gw; it < T * DM / 512; it += NGW) { const size_t o = (size_t)it * 512 + lane * 8;
          const f32x4 v0 = *(const GAS f32x4*)(a.x + o), v1 = *(const GAS f32x4*)(a.x + o + 4);
          u32x4 w; w.x = pk2(v0.x, v0.y); w.y = pk2(v0.z, v0.w); w.z = pk2(v1.x, v1.y); w.w = pk2(v1.z, v1.w);
          *(GAS u32x4*)(xb + o) = w; } }
}

__device__ __forceinline__ u32x4 pack8(const f32x4& a, const f32x4& b) { u32x4 w; w.x = pk2(a[0], a[1]); w.y = pk2(a[2], a[3]); w.z = pk2(b[0], b[1]); w.w = pk2(b[2], b[3]); return w; }
__device__ __forceinline__ u32x2 pack4(const f32x4& a) { u32x2 w; w.x = pk2(a[0], a[1]); w.y = pk2(a[2], a[3]); return w; }

struct EpiP1 {
    static constexpr bool PERM = true;
    bf16_t *CQ, *CKV, *KR, *QKV; const f32x2* T64; const f32x2* T32; float* KM;
    __device__ __forceinline__ void operator()(const f32x4 (&acc)[2][2][4][2], const pg8::Unit& u, int wr, int wc, int fr, int fq) const {
        const int rowb = u.pm * 256 + wr * 64 + fr;
        if (u.pn == 0) {
#pragma unroll
            for (int ai = 0; ai < 2; ++ai)
#pragma unroll
                for (int m = 0; m < 4; ++m) { const size_t row = rowb + ai * 128 + m * 16;
#pragma unroll
                    for (int bj = 0; bj < 2; ++bj) *(GAS u32x4*)(CQ + row * 256 + bj * 128 + wc * 32 + 8 * fq) = pack8(acc[ai][bj][m][0], acc[ai][bj][m][1]); }
        } else if (u.pn == 1) {
#pragma unroll
            for (int ai = 0; ai < 2; ++ai)
#pragma unroll
                for (int m = 0; m < 4; ++m) { const size_t row = rowb + ai * 128 + m * 16;
                    *(GAS u32x4*)(CKV + row * 128 + wc * 32 + 8 * fq) = pack8(acc[ai][0][m][0], acc[ai][0][m][1]);
                    if (wc == 0) { const int pos = (int)(row & 4095);
                        const f32x4 t0 = *(const GAS f32x4*)(T32 + pos * 16 + 4 * fq), t1 = *(const GAS f32x4*)(T32 + pos * 16 + 4 * fq + 2);
                        const f32x4 x1 = acc[ai][1][m][0], x2 = acc[ai][1][m][1];
                        const f32x4 c = {t0[0], t0[2], t1[0], t1[2]}, s = {t0[1], t0[3], t1[1], t1[3]};
                        const f32x4 o1 = x1 * c - x2 * s, o2 = x2 * c + x1 * s;
                        *(GAS u32x2*)(KR + row * 32 + 4 * fq) = pack4(o1); *(GAS u32x2*)(KR + row * 32 + 16 + 4 * fq) = pack4(o2); } asm volatile("" ::: "memory"); }
        } else {
#pragma unroll
            for (int bj = 0; bj < 2; ++bj) {
                const int gh = (u.pn - 2) * 4 + 2 * bj + (wc >> 1), seg = gh / 6, hh = gh % 6, wcl = wc & 1;
                bf16_t* dst = QKV + (size_t)seg * SEG_ELEMS;
                if (seg == 2 || seg == 5) {
#pragma unroll
                    for (int ai = 0; ai < 2; ++ai)
#pragma unroll
                        for (int m = 0; m < 4; ++m) { const size_t row = rowb + ai * 128 + m * 16;
                            *(GAS u32x4*)(dst + row * 384 + hh * 64 + 32 * wcl + 8 * fq) = pack8(acc[ai][bj][m][0], acc[ai][bj][m][1]); }
                } else {
                    const int e0 = 16 * wcl + 4 * fq; f32x4 s1 = {0.f, 0.f, 0.f, 0.f}, s2 = {0.f, 0.f, 0.f, 0.f};
#pragma unroll
                    for (int ai = 0; ai < 2; ++ai)
#pragma unroll
                        for (int m = 0; m < 4; ++m) { const size_t row = rowb + ai * 128 + m * 16; const int pos = (int)(row & 4095);
                            const f32x4 t0 = *(const GAS f32x4*)(T64 + pos * 32 + e0), t1 = *(const GAS f32x4*)(T64 + pos * 32 + e0 + 2);
                            const f32x4 x1 = acc[ai][bj][m][0], x2 = acc[ai][bj][m][1];
                            const f32x4 c = {t0[0], t0[2], t1[0], t1[2]}, s = {t0[1], t0[3], t1[1], t1[3]};
                            const f32x4 o1 = x1 * c - x2 * s, o2 = x2 * c + x1 * s;
                            *(GAS u32x2*)(dst + row * 384 + hh * 64 + e0) = pack4(o1); *(GAS u32x2*)(dst + row * 384 + hh * 64 + 32 + e0) = pack4(o2);
                            s1 += o1; s2 += o2; asm volatile("" ::: "memory"); }
                    if (seg == 1) {
#pragma unroll
                        for (int j = 0; j < 4; ++j) {
#pragma unroll
                            for (int o = 1; o < 16; o <<= 1) { s1[j] += __shfl_xor(s1[j], o); s2[j] += __shfl_xor(s2[j], o); } }
                        if (fr == 0) { float* km = KM + (((size_t)(u.pm >> 4) * 6 + hh) * 16 + (u.pm & 15)) * 64 + e0;
#pragma unroll
                            for (int j = 0; j < 4; ++j) { atomicAdd(km + j, s1[j]); atomicAdd(km + 32 + j, s2[j]); } }
                    }
                }
            }
        }
    }
};

struct EpiP3 {
    static constexpr bool PERM = false;
    const float* res; float* out;
    __device__ __forceinline__ void operator()(const f32x4 (&acc)[2][2][4][2], const pg8::Unit& u, int wr, int wc, int fr, int fq) const {
        const int col0 = u.pn * 256 + wc * 32 + 4 * fq;
#pragma unroll
        for (int ai = 0; ai < 2; ++ai)
#pragma unroll
            for (int m = 0; m < 4; ++m) { const size_t row = u.pm * 256 + ai * 128 + wr * 64 + m * 16 + fr;
#pragma unroll
                for (int bj = 0; bj < 2; ++bj)
#pragma unroll
                    for (int n = 0; n < 2; ++n) { const size_t off = row * 1024 + col0 + bj * 128 + n * 16;
                        const f32x4 r = *(const GAS f32x4*)(res + off); *(GAS f32x4*)(out + off) = r * ALPHA + acc[ai][bj][m][n]; } asm volatile("" ::: "memory"); }
    }
};

struct MoeSched {
    const LAS int* tb; const LAS int* cnt; const int* tokslot; int NCT, G, c, ntiles; bool gather;
    __device__ __forceinline__ bool next(int i, pg8::Unit& u) const {
        const long L = (long)i * G + c; if (L >= (long)ntiles * NCT) return false;
        const int tau = (int)(L / NCT), ct = (int)(L % NCT);
        int lo = 0, hi = 64;
        while (hi - lo > 1) { const int mid = (lo + hi) >> 1; if (tb[mid] <= tau) lo = mid; else hi = mid; }
        u.pm = tau; u.pn = lo * NCT + ct; return true;
    }
    __device__ __forceinline__ int a_row(const pg8::Unit& u, int r) const {
        if (!gather) return u.pm * 256 + r;
        const int e = u.pn / NCT, slot = (u.pm - tb[e]) * 256 + r;
        return slot < cnt[e] ? (tokslot[(size_t)e * CAP + slot] >> 1) : 0;
    }
};
__device__ __forceinline__ float silu_f(float x) { return x * __builtin_amdgcn_rcpf(1.f + __builtin_amdgcn_exp2f(-x * LOG2E)); }
struct EpiP5 {
    static constexpr bool PERM = true;
    bf16_t* H;
    __device__ __forceinline__ void operator()(const f32x4 (&acc)[2][2][4][2], const pg8::Unit& u, int wr, int wc, int fr, int fq) const {
        const int ct = u.pn & 1;
#pragma unroll
        for (int ai = 0; ai < 2; ++ai)
#pragma unroll
            for (int m = 0; m < 4; ++m) { const size_t row = (size_t)u.pm * 256 + ai * 128 + wr * 64 + m * 16 + fr;
                f32x4 v[2];
#pragma unroll
                for (int n = 0; n < 2; ++n)
#pragma unroll
                    for (int j = 0; j < 4; ++j) v[n][j] = silu_f(acc[ai][0][m][n][j]) * acc[ai][1][m][n][j];
                *(GAS u32x4*)(H + row * 256 + ct * 128 + wc * 32 + 8 * fq) = pack8(v[0], v[1]); }
    }
};
struct EpiP6 {
    static constexpr bool PERM = true;
    bf16_t* Y; const LAS int* tb; const LAS int* cnt; const int* tokslot; const float* gate;
    __device__ __forceinline__ void operator()(const f32x4 (&acc)[2][2][4][2], const pg8::Unit& u, int wr, int wc, int fr, int fq) const {
        const int e = u.pn >> 2, ct = u.pn & 3, bs = (u.pm - tb[e]) * 256, ne = cnt[e];
#pragma unroll
        for (int ai = 0; ai < 2; ++ai)
#pragma unroll
            for (int m = 0; m < 4; ++m) { const int slot = bs + ai * 128 + wr * 64 + m * 16 + fr;
                if (slot < ne) { const size_t idx = (size_t)e * CAP + slot; const size_t dst = (size_t)tokslot[idx]; const float g = gate[idx];
#pragma unroll
                    for (int bj = 0; bj < 2; ++bj) *(GAS u32x4*)(Y + dst * 1024 + ct * 256 + bj * 128 + wc * 32 + 8 * fq) = pack8(acc[ai][bj][m][0] * g, acc[ai][bj][m][1] * g); } }
    }
};

#define MFMA32(a, b, c) __builtin_amdgcn_mfma_f32_32x32x16_bf16(a, b, c, 0, 0, 0)
__device__ __forceinline__ float ssq8(const bf16x8& v) { float s = 0.f;
#pragma unroll
    for (int j = 0; j < 8; ++j) { const float f = bf2f((unsigned short)v[j]); s += f * f; } return s; }

__device__ __forceinline__ void p1b_mla(Frame& F, int l) {
    unsigned char* ws = F.ws;
    const bf16_t* CQ = (const bf16_t*)(ws + WS_CQ); const bf16_t* CKV = (const bf16_t*)(ws + WS_CKV); const bf16_t* KR = (const bf16_t*)(ws + WS_KR);
    const bf16_t* Wuq = (const bf16_t*)(ws + WS_WUQ) + (size_t)l * 384 * 256; const bf16_t* Wukv = (const bf16_t*)(ws + WS_WUKV) + (size_t)l * 512 * 128;
    bf16_t* QA = (bf16_t*)(ws + WS_QA); bf16_t* KA = (bf16_t*)(ws + WS_KA); bf16_t* VA = (bf16_t*)(ws + WS_VA);
    const f32x2* T32 = (const f32x2*)(ws + WS_T32);
    const int gw = F.vcu * NWAVES + F.wave, NGW = F.G * NWAVES, lane = F.lane, r32 = lane & 31, hi = lane >> 5;
    for (int it = gw; it < T / 32; it += NGW) {
        const size_t tok = (size_t)it * 32 + r32; const int pos = (int)(tok & 4095);
        {
            bf16x8 bq[16]; float ss = 0.f;
#pragma unroll
            for (int ks = 0; ks < 16; ++ks) { bq[ks] = *(const GAS bf16x8*)(CQ + tok * 256 + 16 * ks + 8 * hi); ss += ssq8(bq[ks]); }
            ss += xhalf(ss);
            const float rq = 1.0f / sqrtf(ss * (1.0f / 256.0f) + RMS_EPS);
            f32x4 cs[2][2];
#pragma unroll
            for (int g = 0; g < 2; ++g) { cs[g][0] = *(const GAS f32x4*)(T32 + pos * 16 + 8 * g + 4 * hi); cs[g][1] = *(const GAS f32x4*)(T32 + pos * 16 + 8 * g + 4 * hi + 2); }
#pragma unroll 1
            for (int fb = 0; fb < 12; ++fb) {
                f32x16 acc = {};
                const bf16_t* wrow = Wuq + (size_t)(32 * fb + r32) * 256 + 8 * hi;
#pragma unroll
                for (int ks = 0; ks < 16; ++ks) { const bf16x8 a = *(const GAS bf16x8*)(wrow + 16 * ks); acc = MFMA32(a, bq[ks], acc); }
#pragma unroll
                for (int r = 0; r < 16; ++r) acc[r] *= rq;
                const int head = fb / 3, part = fb % 3;
                if (part == 2) {
#pragma unroll
                    for (int r = 0; r < 8; ++r) { const int g = r >> 2, j = r & 3; const float c = cs[g][j >> 1][(j & 1) * 2], s = cs[g][j >> 1][(j & 1) * 2 + 1];
                        const float x1 = acc[r], x2 = acc[r + 8]; acc[r] = x1 * c - x2 * s; acc[r + 8] = x2 * c + x1 * s; }
                }
                bf16_t* dst = QA + tok * 384 + head * 96 + part * 32 + 4 * hi;
#pragma unroll
                for (int g = 0; g < 4; ++g) { u32x2 w; w.x = pk2(acc[4 * g], acc[4 * g + 1]); w.y = pk2(acc[4 * g + 2], acc[4 * g + 3]); *(GAS u32x2*)(dst + 8 * g) = w; }
            }
        }
        {
            bf16x8 bk[8]; float ss = 0.f;
#pragma unroll
            for (int ks = 0; ks < 8; ++ks) { bk[ks] = *(const GAS bf16x8*)(CKV + tok * 128 + 16 * ks + 8 * hi); ss += ssq8(bk[ks]); }
            ss += xhalf(ss);
            const float rk = 1.0f / sqrtf(ss * (1.0f / 128.0f) + RMS_EPS);
#pragma unroll 1
            for (int fb = 0; fb < 16; ++fb) {
                f32x16 acc = {};
                const bf16_t* wrow = Wukv + (size_t)(32 * fb + r32) * 128 + 8 * hi;
#pragma unroll
                for (int ks = 0; ks < 8; ++ks) { const bf16x8 a = *(const GAS bf16x8*)(wrow + 16 * ks); acc = MFMA32(a, bk[ks], acc); }
#pragma unroll
                for (int r = 0; r < 16; ++r) acc[r] *= rk;
                const int head = fb >> 2, part = fb & 3;
                bf16_t* dst = (part < 2) ? (KA + tok * 384 + head * 96 + part * 32 + 4 * hi) : (VA + tok * 256 + head * 64 + (part - 2) * 32 + 4 * hi);
#pragma unroll
                for (int g = 0; g < 4; ++g) { u32x2 w; w.x = pk2(acc[4 * g], acc[4 * g + 1]); w.y = pk2(acc[4 * g + 2], acc[4 * g + 3]); *(GAS u32x2*)(dst + 8 * g) = w; }
            }
            const u32x4 k0 = *(const GAS u32x4*)(KR + tok * 32 + 16 * hi), k1 = *(const GAS u32x4*)(KR + tok * 32 + 16 * hi + 8);
#pragma unroll
            for (int h = 0; h < 4; ++h) { *(GAS u32x4*)(KA + tok * 384 + h * 96 + 64 + 16 * hi) = k0; *(GAS u32x4*)(KA + tok * 384 + h * 96 + 64 + 16 * hi + 8) = k1; }
        }
    }
}

typedef const LAS char* lds_cptr;
typedef short v4i16_t __attribute__((ext_vector_type(4)));
__device__ __forceinline__ s16x4 vtr(lds_cptr p) { return __builtin_bit_cast(s16x4, __builtin_amdgcn_ds_read_tr16_b64_v4i16((LAS v4i16_t*)p)); }
#define MX3(a, b, c) __builtin_fmaxf(__builtin_fmaxf((a), (b)), (c))
__device__ __forceinline__ float rowmax32(const f32x16& p0, const f32x16& p1) {
    float a = MX3(p0[0], p0[1], p1[0]), b = MX3(p0[2], p0[3], p1[1]); a = MX3(a, p1[2], p1[3]);
#pragma unroll
    for (int r = 4; r < 16; r += 4) { a = MX3(a, p0[r], p0[r + 1]); b = MX3(b, p0[r + 2], p0[r + 3]); a = MX3(a, p1[r], p1[r + 1]); b = MX3(b, p1[r + 2], p1[r + 3]); }
    const float m = __builtin_fmaxf(a, b); auto rr = __builtin_amdgcn_permlane32_swap(__float_as_uint(m), __float_as_uint(m), false, false);
    return __builtin_fmaxf(__uint_as_float(rr[0]), __uint_as_float(rr[1]));
}
struct AttnSt { f32x16 o0, o1; float m, l; };
constexpr float NEG_BIG = -1e30f, M_FLOOR = -1e29f;
__device__ __forceinline__ void attn_init(AttnSt& st) { st.o0 = f32x16{}; st.o1 = f32x16{}; st.m = M_FLOOR; st.l = 0.f; }

template <int DK>
__device__ __forceinline__ void qk_tile(f32x16& p0, f32x16& p1, lds_cptr K, const bf16x8* qr, int r32, int hi) {
    p0 = f32x16{}; p1 = f32x16{};
    const lds_cptr kb = K + hi * 1024 + r32 * 16;
#pragma unroll
    for (int d0 = 0; d0 < DK / 16; ++d0) {
        const bf16x8 b0 = *(const LAS bf16x8*)(kb + d0 * 2048), b1 = *(const LAS bf16x8*)(kb + d0 * 2048 + 512);
        p0 = MFMA32(b0, qr[d0], p0); p1 = MFMA32(b1, qr[d0], p1); }
}
__device__ __forceinline__ void softmax_step(f32x16& p0, f32x16& p1, AttnSt& st, LAS float* wsf, int r32, int hi, u32x4 (&pw)[4]) {
    const float rm = rowmax32(p0, p1);
    const float mnew = __builtin_fmaxf(st.m, rm);
    const float alpha = __builtin_amdgcn_exp2f(st.m - mnew);
    if (__any(mnew > st.m)) {
        if (hi == 0) wsf[r32] = alpha;
#pragma unroll
        for (int r = 0; r < 16; ++r) { const float a = wsf[crow(r, hi)]; st.o0[r] *= a; st.o1[r] *= a; }
    }
    st.m = mnew;
    float s = 0.f;
#pragma unroll
    for (int r = 0; r < 16; ++r) { p0[r] = __builtin_amdgcn_exp2f(p0[r] - mnew); p1[r] = __builtin_amdgcn_exp2f(p1[r] - mnew); s += p0[r] + p1[r]; }
    st.l = st.l * alpha + s;
    pw[0] = (u32x4){pk2(p0[0], p0[1]), pk2(p0[2], p0[3]), pk2(p0[4], p0[5]), pk2(p0[6], p0[7])};
    pw[1] = (u32x4){pk2(p0[8], p0[9]), pk2(p0[10], p0[11]), pk2(p0[12], p0[13]), pk2(p0[14], p0[15])};
    pw[2] = (u32x4){pk2(p1[0], p1[1]), pk2(p1[2], p1[3]), pk2(p1[4], p1[5]), pk2(p1[6], p1[7])};
    pw[3] = (u32x4){pk2(p1[8], p1[9]), pk2(p1[10], p1[11]), pk2(p1[12], p1[13]), pk2(p1[14], p1[15])};
}
__device__ __forceinline__ void pv_tile(AttnSt& st, lds_cptr V, const u32x4 (&pw)[4], int lane) {
    const int hi = lane >> 5;
    const lds_cptr vp = V + ((lane >> 4) & 1) * 32 + (lane & 3) * 8 + (4 * hi + ((lane & 15) >> 2)) * 64;
#pragma unroll
    for (int ks = 0; ks < 4; ++ks) {
        const s16x4 l0 = vtr(vp + ks * 1024), h0 = vtr(vp + ks * 1024 + 512), l1 = vtr(vp + 4096 + ks * 1024), h1 = vtr(vp + 4096 + ks * 1024 + 512);
        const bf16x8 f0 = {l0[0], l0[1], l0[2], l0[3], h0[0], h0[1], h0[2], h0[3]}, f1 = {l1[0], l1[1], l1[2], l1[3], h1[0], h1[1], h1[2], h1[3]};
        const bf16x8 pa = __builtin_bit_cast(bf16x8, pw[ks]);
        st.o0 = MFMA32(pa, f0, st.o0); st.o1 = MFMA32(pa, f1, st.o1); }
}
__device__ __forceinline__ void attn_finish(AttnSt& st, LAS float* wsf, int r32, int hi, float (&rli)[16], float& lse2) {
    const float lt = st.l + xhalf(st.l);
    lse2 = st.m + __builtin_amdgcn_logf(lt);
    if (hi == 0) wsf[32 + r32] = lt;
#pragma unroll
    for (int r = 0; r < 16; ++r) rli[r] = __builtin_amdgcn_rcpf(wsf[32 + crow(r, hi)]);
}

constexpr int AL_K0 = 0, AL_K1 = 12288, AL_V0 = 24576, AL_V1 = 32768, AL_WSF = 65536, AL_OST = 67584;
constexpr int AL_M = 67584, AL_ML = 67584 + 65536;

template <int DK>
__device__ __forceinline__ void attn_shared_unit(Frame& F, const bf16_t* Qp, int qpitch, const bf16_t* Kp, int kpitch, const bf16_t* Vp, int vpitch, bf16_t* Op,
                                                 int q0, int NT, float sc, bool moba, const float* km) {
    const int tid = F.tid, lane = F.lane, wid = F.wave, r32 = lane & 31, hi = lane >> 5;
    LAS unsigned char* lds = F.lds; LAS float* wsf = (LAS float*)(lds + AL_WSF) + wid * 64;
    bf16x8 qr[DK / 16];
    { const bf16_t* qrow = Qp + (size_t)(q0 + wid * 32 + r32) * qpitch + 8 * hi;
#pragma unroll
      for (int d0 = 0; d0 < DK / 16; ++d0) qr[d0] = *(const GAS bf16x8*)(qrow + 16 * d0); }
    unsigned selmask = 0xffffffffu;
    if (moba) {
        const int nb = q0 >> 8;
        if (nb <= 3) selmask = (1u << nb) - 1u;
        else {
            float v1 = -3e38f, v2 = -3e38f, v3 = -3e38f; int i1 = 0, i2 = 0, i3 = 0;
#pragma unroll
            for (int j = 0; j < 15; ++j) {
                if (j < nb) {
                    float g = 0.f;
#pragma unroll
                    for (int d0 = 0; d0 < 4; ++d0) { const float* kp = km + j * 64 + 16 * d0 + 8 * hi; const f32x4 a = *(const GAS f32x4*)kp, b = *(const GAS f32x4*)(kp + 4);
                        const bf16x8 qv = qr[d0];
#define QF(e) bf2f((unsigned short)qv[e])
                        g += QF(0) * a[0] + QF(1) * a[1] + QF(2) * a[2] + QF(3) * a[3] + QF(4) * b[0] + QF(5) * b[1] + QF(6) * b[2] + QF(7) * b[3];
#undef QF
                    }
                    g += xhalf(g);
                    if (g > v1) { v3 = v2; i3 = i2; v2 = v1; i2 = i1; v1 = g; i1 = j; }
                    else if (g > v2) { v3 = v2; i3 = i2; v2 = g; i2 = j; }
                    else if (g > v3) { v3 = g; i3 = j; }
                }
            }
            selmask = (1u << i1) | (1u << i2) | (1u << i3);
        }
    }
    const int krow = tid & 63, kch = tid >> 6, vdh = tid >> 8, vrow = (tid >> 2) & 63, vc4 = tid & 3;
    const bf16_t* ksrc = Kp + (size_t)krow * kpitch + kch * 8;
    const bf16_t* vsrc = Vp + (size_t)vrow * vpitch + vdh * 32 + vc4 * 8;
    const int kdst = kch * 1024 + krow * 16, vdst = vdh * 4096 + vrow * 64 + vc4 * 16;
    const bool k2 = (DK > 64) && (tid < (DK - 64) * 8);
    u32x4 kreg0, kreg1 = {0u, 0u, 0u, 0u}, vreg;
    kreg0 = *(const GAS u32x4*)ksrc; if (k2) kreg1 = *(const GAS u32x4*)(ksrc + 64); vreg = *(const GAS u32x4*)vsrc;
    *(LAS u32x4*)(lds + AL_K0 + kdst) = kreg0; if (k2) *(LAS u32x4*)(lds + AL_K0 + kdst + 8192) = kreg1; *(LAS u32x4*)(lds + AL_V0 + vdst) = vreg;
    __syncthreads();
    AttnSt st; attn_init(st);
    const int qrel = wid * 32 + r32;
#pragma unroll 1
    for (int t = 0; t < NT; ++t) {
        const int cur = t & 1;
        const bool more = (t + 1 < NT);
        if (more) { const size_t ro = (size_t)(t + 1) * 64;
            kreg0 = *(const GAS u32x4*)(ksrc + ro * kpitch); if (k2) kreg1 = *(const GAS u32x4*)(ksrc + ro * kpitch + 64); vreg = *(const GAS u32x4*)(vsrc + ro * vpitch); }
        const int jb = t - (NT - 4);
        const int allowed = (jb >= 0) ? 1 : (int)((selmask >> (t >> 2)) & 1u);
        const bool active = (jb >= 0) ? (64 * jb <= 32 * wid + 31) : (__any(allowed) != 0);
        if (active) {
            const lds_cptr Kb = (lds_cptr)(lds + (cur ? AL_K1 : AL_K0)), Vb = (lds_cptr)(lds + (cur ? AL_V1 : AL_V0));
            f32x16 p0, p1;
            qk_tile<DK>(p0, p1, Kb, qr, r32, hi);
            if (jb >= 0) {
#pragma unroll
                for (int r = 0; r < 16; ++r) { const int kv = 64 * jb + crow(r, hi); p0[r] = (kv > qrel) ? NEG_BIG : p0[r] * sc; p1[r] = (kv + 32 > qrel) ? NEG_BIG : p1[r] * sc; }
            } else {
#pragma unroll
                for (int r = 0; r < 16; ++r) { p0[r] = allowed ? p0[r] * sc : NEG_BIG; p1[r] = allowed ? p1[r] * sc : NEG_BIG; }
            }
            u32x4 pw[4];
            softmax_step(p0, p1, st, wsf, r32, hi, pw);
            pv_tile(st, Vb, pw, lane);
        }
        if (more) { const int kb = cur ? AL_K0 : AL_K1, vb = cur ? AL_V0 : AL_V1;
            *(LAS u32x4*)(lds + kb + kdst) = kreg0; if (k2) *(LAS u32x4*)(lds + kb + kdst + 8192) = kreg1; *(LAS u32x4*)(lds + vb + vdst) = vreg; }
        __syncthreads();
    }
    float rli[16], lse2; attn_finish(st, wsf, r32, hi, rli, lse2);
    LAS bf16_t* stg = (LAS bf16_t*)(lds + AL_OST) + wid * 2048;
#pragma unroll
    for (int r = 0; r < 16; ++r) { const int orow = crow(r, hi); stg[orow * 64 + r32] = (bf16_t)f2bf(st.o0[r] * rli[r]); stg[orow * 64 + 32 + r32] = (bf16_t)f2bf(st.o1[r] * rli[r]); }
#pragma unroll
    for (int i = 0; i < 4; ++i) { const int row = i * 8 + (lane >> 3), ch = lane & 7; const u32x4 v = *(const LAS u32x4*)(stg + row * 64 + ch * 8);
        *(GAS u32x4*)(Op + (size_t)(q0 + wid * 32 + row) * 1024 + ch * 8) = v; }
    __syncthreads();
}

__device__ __forceinline__ void attn_dilated_unit(Frame& F, const bf16_t* Qc, const bf16_t* Kc, const bf16_t* Vc, bf16_t* Op, int p0, float sc) {
    const int tid = F.tid, lane = F.lane, wid = F.wave, r32 = lane & 31, hi = lane >> 5;
    LAS unsigned char* lds = F.lds; LAS float* wsf = (LAS float*)(lds + AL_WSF) + wid * 64;
    LAS float* M = (LAS float*)(lds + AL_M); LAS float* ML = (LAS float*)(lds + AL_ML);
    LAS unsigned char* priv = lds + wid * 8192;
#pragma unroll 1
    for (int br = 0; br < 3; ++br) {
        const int dil = (br == 0) ? 1 : (br == 1 ? 4 : 16);
        int rrq, lq;
        if (br == 0) { rrq = 0; lq = p0 + 32 * wid + r32; }
        else if (br == 1) { rrq = wid >> 1; lq = (p0 >> 2) + 32 * (wid & 1) + r32; }
        else { rrq = 2 * wid + (r32 >> 4); lq = (p0 >> 4) + (r32 & 15); }
        const int qpos = lq * dil + rrq;
        bf16x8 qr[4];
        { const bf16_t* qrow = Qc + (size_t)qpos * 384 + 8 * hi;
#pragma unroll
          for (int d0 = 0; d0 < 4; ++d0) qr[d0] = *(const GAS bf16x8*)(qrow + 16 * d0); }
        AttnSt st; attn_init(st);
        const int nsteps = (br == 2) ? 6 : 3;
#pragma unroll 1
        for (int s = 0; s < nsteps; ++s) {
            int tres, lf;
            if (br == 0) { tres = 0; lf = p0 - 128 + 64 * ((wid >> 1) + s); }
            else if (br == 1) { tres = wid >> 1; lf = (p0 >> 2) - 128 + 64 * s; }
            else { tres = 2 * wid + (s >= 3 ? 1 : 0); lf = (p0 >> 4) - 128 + 64 * (s >= 3 ? s - 3 : s); }
            int kpos = (lf + lane) * dil + tres; kpos = kpos < 0 ? 0 : (kpos > SEQ - 1 ? SEQ - 1 : kpos);
            const bf16_t* krow = Kc + (size_t)kpos * 384; const bf16_t* vrow = Vc + (size_t)kpos * 384;
            u32x4 vv[8];
            { u32x4 kk[8];
#pragma unroll
              for (int c = 0; c < 8; ++c) kk[c] = *(const GAS u32x4*)(krow + 8 * c);
#pragma unroll
              for (int c = 0; c < 8; ++c) *(LAS u32x4*)(priv + c * 1024 + lane * 16) = kk[c]; }
            asm volatile("" ::: "memory");
#pragma unroll
            for (int c = 0; c < 8; ++c) vv[c] = *(const GAS u32x4*)(vrow + 8 * c);
            f32x16 p0s, p1s;
            qk_tile<64>(p0s, p1s, (lds_cptr)priv, qr, r32, hi);
            const bool resok = (tres == rrq);
#pragma unroll
            for (int r = 0; r < 16; ++r) {
                const int lk0 = lf + crow(r, hi), lk1 = lk0 + 32; const int d0_ = lq - lk0, d1_ = lq - lk1;
                const bool ok0 = resok && (lk0 >= 0) && (d0_ >= 0) && (d0_ <= 128), ok1 = resok && (lk1 >= 0) && (d1_ >= 0) && (d1_ <= 128);
                p0s[r] = ok0 ? p0s[r] * sc : NEG_BIG; p1s[r] = ok1 ? p1s[r] * sc : NEG_BIG; }
            u32x4 pw[4];
            softmax_step(p0s, p1s, st, wsf, r32, hi, pw);
#pragma unroll
            for (int c = 0; c < 8; ++c) *(LAS u32x4*)(priv + (c >> 2) * 4096 + lane * 64 + (c & 3) * 16) = vv[c];
            pv_tile(st, (lds_cptr)priv, pw, lane);
        }
        float rli[16], lse2; attn_finish(st, wsf, r32, hi, rli, lse2);
#define PROW(q) ((br == 0) ? (32 * wid + (q)) : (br == 1) ? (4 * (32 * (wid & 1) + (q)) + (wid >> 1)) : (16 * ((q) & 15) + 2 * wid + ((q) >> 4)))
        if (br == 0) {
#pragma unroll
            for (int r = 0; r < 16; ++r) { const int row = PROW(crow(r, hi)); M[row * 64 + r32] = st.o0[r] * rli[r]; M[row * 64 + 32 + r32] = st.o1[r] * rli[r]; }
            if (hi == 0) ML[PROW(r32)] = lse2;
        } else {
            if (hi == 0) wsf[r32] = lse2;
#pragma unroll
            for (int r = 0; r < 16; ++r) { const int q = crow(r, hi), row = PROW(q); const float lb = wsf[q], la = ML[row]; const float mx = __builtin_fmaxf(la, lb);
                const float wa = __builtin_amdgcn_exp2f(la - mx), wb = __builtin_amdgcn_exp2f(lb - mx), inv = __builtin_amdgcn_rcpf(wa + wb);
                M[row * 64 + r32] = (wa * M[row * 64 + r32] + wb * (st.o0[r] * rli[r])) * inv; M[row * 64 + 32 + r32] = (wa * M[row * 64 + 32 + r32] + wb * (st.o1[r] * rli[r])) * inv; }
            if (hi == 0) { const int row = PROW(r32); const float la = ML[row], lb = lse2, mx = __builtin_fmaxf(la, lb);
                ML[row] = mx + __builtin_amdgcn_logf(__builtin_amdgcn_exp2f(la - mx) + __builtin_amdgcn_exp2f(lb - mx)); }
        }
#undef PROW
        __syncthreads();
    }
    { const int row = tid >> 1, half = tid & 1; const LAS float* mp = M + row * 64 + 32 * half; bf16_t* op = Op + (size_t)(p0 + row) * 1024 + 32 * half;
#pragma unroll
      for (int i = 0; i < 4; ++i) { const f32x4 a = *(const LAS f32x4*)(mp + 8 * i), b = *(const LAS f32x4*)(mp + 8 * i + 4); *(GAS u32x4*)(op + 8 * i) = pack8(a, b); } }
    __syncthreads();
}

__device__ __forceinline__ void p2_attention(Frame& F0, int l) {
    Frame& F = F0;
    unsigned char* ws = F.ws;
    const bf16_t* QKV = (const bf16_t*)(ws + WS_QKV); const bf16_t* QA = (const bf16_t*)(ws + WS_QA); const bf16_t* KA = (const bf16_t*)(ws + WS_KA); const bf16_t* VA = (const bf16_t*)(ws + WS_VA);
    bf16_t* O = (bf16_t*)(ws + WS_XB);
    const float* KM = (const float*)(F.ctl + CW_KMEAN) + (size_t)l * (8 * 6 * 16 * 64);
    unsigned* queue = (unsigned*)(F.ctl + CW_QUEUE + 64 * l);
    for (;;) {
        __syncthreads();
        if (F.tid == 0) F.LC[LC_BCAST] = atomicAdd(queue, 1u);
        __syncthreads();
        const int u = __builtin_amdgcn_readfirstlane((int)F.LC[LC_BCAST]);
        if (u >= 2048) break;
        Frame Fu = F0; { int t_ = F0.tid; asm volatile("" : "+v"(t_)); Fu.tid = t_; Fu.lane = t_ & 63; Fu.wave = __builtin_amdgcn_readfirstlane(t_ >> 6); }
        Frame& F = Fu;
        if (u < 1280) {
            const int c = 15 - u / 80, v = u % 80;
            if (v < 32) { const int b = v >> 2, h = v & 3; const size_t rb = (size_t)b * SEQ;
                attn_shared_unit<96>(F, QA + rb * 384 + h * 96, 384, KA + rb * 384 + h * 96, 384, VA + rb * 256 + h * 64, 256, O + rb * 1024 + h * 64,
                                     256 * c, 4 * (c + 1), 0.10206207261596575f * LOG2E, false, nullptr);
            } else { const int bh = v - 32, b = bh / 6, h = bh % 6; const size_t rb = (size_t)b * SEQ;
                attn_shared_unit<64>(F, QKV + rb * 384 + h * 64, 384, QKV + SEG_ELEMS + rb * 384 + h * 64, 384, QKV + 2 * SEG_ELEMS + rb * 384 + h * 64, 384, O + rb * 1024 + 256 + h * 64,
                                     256 * c, 4 * (c + 1), 0.125f * LOG2E, true, KM + (size_t)(b * 6 + h) * 16 * 64);
            }
        } else {
            const int v = u - 1280, bh = v >> 4, b = bh / 6, h = bh % 6, pb = v & 15; const size_t rb = (size_t)b * SEQ;
            attn_dilated_unit(F, QKV + 3 * SEG_ELEMS + rb * 384 + h * 64, QKV + 4 * SEG_ELEMS + rb * 384 + h * 64, QKV + 5 * SEG_ELEMS + rb * 384 + h * 64,
                              O + rb * 1024 + 640 + h * 64, 256 * pb, 0.125f * LOG2E);
        }
    }
}

__device__ __forceinline__ void p4_router(Frame& F, const Args& a, int l) {
    unsigned char* ws = F.ws;
    const float* y1 = a.out;
    const bf16_t* RWh = (const bf16_t*)(ws + WS_RW) + (size_t)(l * 2) * 65536; const bf16_t* RWl = RWh + 65536;
    const float* GB = (const float*)(ws + WS_GB) + l * 128;
    unsigned* cnt = (unsigned*)(F.ctl + CW_CNT + 64 * l);
    int* tokslot = (int*)(ws + WS_TOKSLOT); float* gate = (float*)(ws + WS_GATE);
    bf16_t* x1b = (bf16_t*)(ws + WS_XB); float* stats = (float*)(ws + WS_STATS);
    const float* g1 = a.ln1_g + l * 1024; const float* b1 = a.ln1_b + l * 1024;
    const int gw = F.vcu * NWAVES + F.wave, NGW = F.G * NWAVES, lane = F.lane, r32 = lane & 31, hi = lane >> 5;
    LAS float* tab = (LAS float*)F.lds;
    if (F.tid < 128) tab[F.tid] = GB[F.tid]; else if (F.tid < 192) tab[F.tid] = a.router_b[F.tid - 128];
    __syncthreads();
    f32x4 gv[4], bv[4];
#pragma unroll
    for (int j = 0; j < 4; ++j) { gv[j] = *(const GAS f32x4*)(g1 + 4 * lane + 256 * j); bv[j] = *(const GAS f32x4*)(b1 + 4 * lane + 256 * j); }
    for (int it = gw; it < T / 32; it += NGW) {
        const size_t tok = (size_t)it * 32 + r32;
        const float* yrow = y1 + tok * 1024 + 8 * hi;
        const bf16_t* wh = RWh + (size_t)r32 * 1024 + 8 * hi; const bf16_t* wl = RWl + (size_t)r32 * 1024 + 8 * hi;
        f32x16 a0 = {}, a1 = {}; float sm = 0.f, sq = 0.f;
#pragma unroll 2
        for (int ks = 0; ks < 64; ++ks) {
            const f32x4 ya = *(const GAS f32x4*)(yrow + 16 * ks), yb = *(const GAS f32x4*)(yrow + 16 * ks + 4);
            sm += (ya[0] + ya[1]) + (ya[2] + ya[3]) + (yb[0] + yb[1]) + (yb[2] + yb[3]);
            sq += (ya[0] * ya[0] + ya[1] * ya[1]) + (ya[2] * ya[2] + ya[3] * ya[3]) + (yb[0] * yb[0] + yb[1] * yb[1]) + (yb[2] * yb[2] + yb[3] * yb[3]);
            unsigned h[8], lo[8]; const float yy[8] = {ya[0], ya[1], ya[2], ya[3], yb[0], yb[1], yb[2], yb[3]};
#pragma unroll
            for (int q = 0; q < 8; ++q) { h[q] = f2bf(yy[q]); lo[q] = f2bf(yy[q] - __builtin_bit_cast(float, h[q] << 16)); }
            const u32x4 yhw = {h[0] | (h[1] << 16), h[2] | (h[3] << 16), h[4] | (h[5] << 16), h[6] | (h[7] << 16)};
            const u32x4 ylw = {lo[0] | (lo[1] << 16), lo[2] | (lo[3] << 16), lo[4] | (lo[5] << 16), lo[6] | (lo[7] << 16)};
            const bf16x8 yh = __builtin_bit_cast(bf16x8, yhw), yl = __builtin_bit_cast(bf16x8, ylw);
            const bf16x8 h0 = *(const GAS bf16x8*)(wh + 16 * ks), h1 = *(const GAS bf16x8*)(wh + 32 * 1024 + 16 * ks);
            const bf16x8 l0 = *(const GAS bf16x8*)(wl + 16 * ks), l1 = *(const GAS bf16x8*)(wl + 32 * 1024 + 16 * ks);
            a0 = MFMA32(h0, yh, a0); a0 = MFMA32(h0, yl, a0); a0 = MFMA32(l0, yh, a0);
            a1 = MFMA32(h1, yh, a1); a1 = MFMA32(h1, yl, a1); a1 = MFMA32(l1, yh, a1);
        }
        sm += xhalf(sm); sq += xhalf(sq);
        const float mu = sm * (1.0f / 1024.0f); const float var = __builtin_fmaxf(sq * (1.0f / 1024.0f) - mu * mu, 0.f); const float rstd = 1.0f / sqrtf(var + LN_EPS);
        float bestg = -3e38f, bs1 = 0.f, bs2 = 0.f; int be1 = 0, be2 = 1;
#pragma unroll
        for (int gi = 0; gi < 8; ++gi) {
            const int blk = gi >> 2, q = gi & 3;
            float B1 = -3e38f, B2 = -3e38f, S1 = 0.f, S2 = 0.f; int I1 = 0, I2 = 0;
#pragma unroll
            for (int j = 0; j < 4; ++j) {
                const int e = 32 * blk + 8 * q + 4 * hi + j;
                const float acc = (blk == 0) ? a0[4 * q + j] : a1[4 * q + j];
                const float logit = rstd * (acc - mu * tab[e]) + tab[64 + e];
                const float s = 1.0f / (1.0f + __expf(-logit)); const float sb = s + tab[128 + e];
                const int idx = 4 * hi + j;
                if (sb > B1) { B2 = B1; S2 = S1; I2 = I1; B1 = sb; S1 = s; I1 = idx; } else if (sb > B2) { B2 = sb; S2 = s; I2 = idx; }
            }
            const float pB1 = xhalf(B1), pB2 = xhalf(B2), pS1 = xhalf(S1), pS2 = xhalf(S2); const int pI1 = __builtin_bit_cast(int, xhalf(__builtin_bit_cast(float, I1))), pI2 = __builtin_bit_cast(int, xhalf(__builtin_bit_cast(float, I2)));
            const bool mine_first = (B1 > pB1) || (B1 == pB1 && I1 < pI1);
            float T1, T2, U1, U2; int J1, J2;
            if (mine_first) { T1 = B1; U1 = S1; J1 = I1; const bool sec_mine = (B2 > pB1) || (B2 == pB1 && I2 < pI1); if (sec_mine) { T2 = B2; U2 = S2; J2 = I2; } else { T2 = pB1; U2 = pS1; J2 = pI1; } }
            else { T1 = pB1; U1 = pS1; J1 = pI1; const bool sec_p = (pB2 > B1) || (pB2 == B1 && pI2 < I1); if (sec_p) { T2 = pB2; U2 = pS2; J2 = pI2; } else { T2 = B1; U2 = S1; J2 = I1; } }
            const float gs = T1 + T2;
            if (gs > bestg) { bestg = gs; bs1 = U1; bs2 = U2; be1 = 8 * gi + J1; be2 = 8 * gi + J2; }
        }
        const float ginv = 1.0f / (bs1 + bs2);
        if (hi == 0) {
            const unsigned s1 = atomicAdd(cnt + be1, 1u), s2 = atomicAdd(cnt + be2, 1u);
            const size_t i1 = (size_t)be1 * CAP + s1, i2 = (size_t)be2 * CAP + s2;
            tokslot[i1] = (int)(2 * tok); gate[i1] = bs1 * ginv; tokslot[i2] = (int)(2 * tok + 1); gate[i2] = bs2 * ginv;
            *(GAS f32x2*)(stats + 2 * tok) = (f32x2){mu, rstd};
        }
        for (int i = 0; i < 32; ++i) {
            const float mui = __shfl(mu, i), rsi = __shfl(rstd, i); const size_t row = (size_t)it * 32 + i;
#pragma unroll
            for (int j = 0; j < 4; ++j) { const f32x4 yv = *(const GAS f32x4*)(y1 + row * 1024 + 4 * lane + 256 * j); const f32x4 xv = (yv - mui) * rsi * gv[j] + bv[j];
                *(GAS u32x2*)(x1b + row * 1024 + 4 * lane + 256 * j) = pack4(xv); }
        }
    }
    __syncthreads();
}

__device__ __forceinline__ void p7_ln2(Frame& F, const Args& a, int l) {
    unsigned char* ws = F.ws;
    float* y1 = a.out; const float* stats = (const float*)(ws + WS_STATS); const bf16_t* Y = (const bf16_t*)(ws + WS_Y); bf16_t* xb = (bf16_t*)(ws + WS_XB);
    const float* g1 = a.ln1_g + l * 1024; const float* b1 = a.ln1_b + l * 1024; const float* g2 = a.ln2_g + l * 1024; const float* b2 = a.ln2_b + l * 1024;
    const int gw = F.vcu * NWAVES + F.wave, NGW = F.G * NWAVES, lane = F.lane;
    f32x4 g1v[4], b1v[4], g2v[4], b2v[4];
#pragma unroll
    for (int j = 0; j < 4; ++j) { const int c = 4 * lane + 256 * j; g1v[j] = *(const GAS f32x4*)(g1 + c); b1v[j] = *(const GAS f32x4*)(b1 + c); g2v[j] = *(const GAS f32x4*)(g2 + c); b2v[j] = *(const GAS f32x4*)(b2 + c); }
    for (int row = gw; row < T; row += NGW) {
        const f32x2 st = *(const GAS f32x2*)(stats + 2 * (size_t)row);
        f32x4 z[4]; float s = 0.f;
#pragma unroll
        for (int j = 0; j < 4; ++j) { const int c = 4 * lane + 256 * j;
            const f32x4 yv = *(const GAS f32x4*)(y1 + (size_t)row * 1024 + c);
            const u32x2 e0 = *(const GAS u32x2*)(Y + (size_t)(2 * row) * 1024 + c), e1 = *(const GAS u32x2*)(Y + (size_t)(2 * row + 1) * 1024 + c);
            const f32x4 x1 = (yv - st[0]) * st[1] * g1v[j] + b1v[j];
            const f32x4 f0 = {bflo(e0.x), bfhi(e0.x), bflo(e0.y), bfhi(e0.y)}, f1 = {bflo(e1.x), bfhi(e1.x), bflo(e1.y), bfhi(e1.y)};
            z[j] = x1 * ALPHA + f0 + f1; s += (z[j][0] + z[j][1]) + (z[j][2] + z[j][3]); }
        const float mean = wave_sum(s) * (1.0f / 1024.0f); float s2 = 0.f;
#pragma unroll
        for (int j = 0; j < 4; ++j) { z[j] = z[j] - mean; s2 += (z[j][0] * z[j][0] + z[j][1] * z[j][1]) + (z[j][2] * z[j][2] + z[j][3] * z[j][3]); }
        const float rstd = 1.0f / sqrtf(wave_sum(s2) * (1.0f / 1024.0f) + LN_EPS);
#pragma unroll
        for (int j = 0; j < 4; ++j) { const int c = 4 * lane + 256 * j; const f32x4 o = z[j] * rstd * g2v[j] + b2v[j];
            *(GAS f32x4*)(y1 + (size_t)row * 1024 + c) = o; *(GAS u32x2*)(xb + (size_t)row * 1024 + c) = pack4(o); }
    }
}
#ifndef ONLY_K
#define ONLY_K -1
#endif

constexpr int N_PHASES = 1 + 8 * DEPTH;
#ifndef MK_N_LAUNCHES
#define MK_N_LAUNCHES 1
#endif

__device__ __forceinline__ void moe_tables(Frame& F, int l) {
    const unsigned* cntg = (const unsigned*)(F.ctl + CW_CNT + 64 * l);
    if (F.tid < 64) F.LC[LC_CNT + F.tid] = __hip_atomic_load(cntg + F.tid, RLX_AGENT);
    __syncthreads();
    if (F.tid == 0) { unsigned run = 0; for (int e = 0; e < 64; ++e) { F.LC[LC_TB + e] = run; run += (F.LC[LC_CNT + e] + 255u) >> 8; } F.LC[LC_TB + 64] = run; }
    __syncthreads();
}

__global__ void __launch_bounds__(NTHREADS, 2) mega_fwd(Args a_in) {
    extern __shared__ __attribute__((aligned(16))) unsigned char lds_raw[];
    Frame F;
    F.lds = (LAS unsigned char*)lds_raw;
    F.LC = (volatile LAS unsigned*)(F.lds + LDSCTL_OFF);
    F.ws = a_in.ws; F.ctl = (gu32*)(a_in.ws + WS_CTL);
    F.tid = threadIdx.x; F.lane = F.tid & 63; F.wave = __builtin_amdgcn_readfirstlane(F.tid >> 6);
    F.G = gridDim.x; { const int bx = blockIdx.x; F.vcu = (F.G % 8 == 0) ? (bx % 8) * (F.G / 8) + bx / 8 : bx; }
    for (int u = F.tid; u < (LDS_BYTES - LDSCTL_OFF) / 4; u += NTHREADS) F.LC[u] = 0u;
    __syncthreads();
    XcdBarrier bar; bar.bar = (unsigned*)(F.ctl + CW_BAR); bar.x = 0; bar.st = nullptr;
    if (MK_N_LAUNCHES == 1) bar = xcd_barrier_post((unsigned*)(F.ctl + CW_BAR), F.LC + LC_BAR);
    const int lo = a_in.ph_lo, hi = a_in.ph_hi;
#define LAUNDER(p) asm volatile("" : "+s"(p))
    for (int ph = lo; ph < hi; ++ph) {
        if (ph > lo) xcd_barrier(bar);
        Args a = a_in;
        LAUNDER(a.x); LAUNDER(a.w_in); LAUNDER(a.q_norm); LAUNDER(a.w_uq); LAUNDER(a.kv_norm); LAUNDER(a.w_ukv); LAUNDER(a.w_out); LAUNDER(a.ln1_g); LAUNDER(a.ln1_b);
        LAUNDER(a.router_w); LAUNDER(a.router_b); LAUNDER(a.w1); LAUNDER(a.w3); LAUNDER(a.w2); LAUNDER(a.ln2_g); LAUNDER(a.ln2_b); LAUNDER(a.out); LAUNDER(a.ws);
        unsigned char* ws = a.ws; F.ws = ws; F.ctl = (gu32*)(ws + WS_CTL);
        { int t_ = threadIdx.x; asm volatile("" : "+v"(t_)); F.tid = t_; F.lane = t_ & 63; F.wave = __builtin_amdgcn_readfirstlane(t_ >> 6); }
        if (ph == 0) { if (ONLY_K==-1||ONLY_K==8) p0_prologue(F, a); continue; }
        const int l = (ph - 1) >> 3, k = (ph - 1) & 7;
        if (k == 0 && (ONLY_K==-1||ONLY_K==0)) {
            pg8::StaticOrder S; S.init(T, N_INP, F.G, (int)blockIdx.x);
            EpiP1 E{(bf16_t*)(ws + WS_CQ), (bf16_t*)(ws + WS_CKV), (bf16_t*)(ws + WS_KR), (bf16_t*)(ws + WS_QKV), (const f32x2*)(ws + WS_T64), (const f32x2*)(ws + WS_T32),
                    (float*)(F.ctl + CW_KMEAN) + (size_t)l * (8 * 6 * 16 * 64)};
            pg8::gemm_phase<EpiP1, pg8::StaticOrder, true, true>(F.tid, F.lds, (const bf16_t*)(ws + WS_XB), (const bf16_t*)(ws + WS_WIN + (size_t)l * WIN_L), DM, S, E);
        } else if (k == 1 && (ONLY_K==-1||ONLY_K==1)) {
            p1b_mla(F, l);
        } else if (k == 2 && (ONLY_K==-1||ONLY_K==2)) {
            p2_attention(F, l);
        } else if (k == 3 && (ONLY_K==-1||ONLY_K==3)) {
            pg8::StaticOrder S; S.init(T, DM, F.G, (int)blockIdx.x);
            EpiP3 E{l == 0 ? a.x : (const float*)a.out, a.out};
            pg8::gemm_phase<EpiP3, pg8::StaticOrder, true, true>(F.tid, F.lds, (const bf16_t*)(ws + WS_XB), (const bf16_t*)(ws + WS_WOUT) + (size_t)l * DM * DM, DM, S, E);
        } else if (k == 4 && (ONLY_K==-1||ONLY_K==4)) {
            p4_router(F, a, l);
        } else if (k == 5 && (ONLY_K==-1||ONLY_K==5)) {
            moe_tables(F, l);
            const LAS int* tb = (const LAS int*)(F.lds + LDSCTL_OFF) + LC_TB; const LAS int* cn = (const LAS int*)(F.lds + LDSCTL_OFF) + LC_CNT;
            MoeSched S{tb, cn, (const int*)(ws + WS_TOKSLOT), 2, F.G, (int)blockIdx.x, tb[64], true};
            EpiP5 E{(bf16_t*)(ws + WS_H)};
            pg8::gemm_phase<EpiP5, MoeSched, true, true>(F.tid, F.lds, (const bf16_t*)(ws + WS_XB), (const bf16_t*)(ws + WS_MOE + (size_t)l * MOE_L), DM, S, E);
        } else if (k == 6 && (ONLY_K==-1||ONLY_K==6)) {
            moe_tables(F, l);
            const LAS int* tb = (const LAS int*)(F.lds + LDSCTL_OFF) + LC_TB; const LAS int* cn = (const LAS int*)(F.lds + LDSCTL_OFF) + LC_CNT;
            MoeSched S{tb, cn, (const int*)(ws + WS_TOKSLOT), 4, F.G, (int)blockIdx.x, tb[64], false};
            EpiP6 E{(bf16_t*)(ws + WS_Y), tb, cn, (const int*)(ws + WS_TOKSLOT), (const float*)(ws + WS_GATE)};
            pg8::gemm_phase<EpiP6, MoeSched, true, true>(F.tid, F.lds, (const bf16_t*)(ws + WS_H), (const bf16_t*)(ws + WS_MOE + (size_t)l * MOE_L + 64 * MiB), DEXP, S, E);
        } else if (ONLY_K==-1||ONLY_K==7) {
            p7_ln2(F, a, l);
        }
    }
}

extern "C" void kernel_launch(void* const* d_in, const int* in_sizes, int n_in, void* d_out, int out_size, void* d_ws, size_t ws_size, hipStream_t stream) {
    static int grid = 0;
    if (grid == 0) {
        if (n_in != 16 || out_size != T * DM || ws_size < WS_END) { fprintf(stderr, "kernel_launch: unexpected shapes (n_in %d out %d ws %zu need %zu)\n", n_in, out_size, ws_size, (size_t)WS_END); grid = -1; return; }
        int dev = 0, cus = 0, per_cu = 0;
        if (hipGetDevice(&dev) != hipSuccess || hipDeviceGetAttribute(&cus, hipDeviceAttributeMultiprocessorCount, dev) != hipSuccess) { grid = -1; return; }
        if (hipFuncSetAttribute((const void*)mega_fwd, hipFuncAttributeMaxDynamicSharedMemorySize, LDS_BYTES) != hipSuccess) { grid = -1; return; }
        if (hipOccupancyMaxActiveBlocksPerMultiprocessor(&per_cu, (const void*)mega_fwd, NTHREADS, LDS_BYTES) != hipSuccess || per_cu < 1) { fprintf(stderr, "kernel_launch: occupancy query says %d blocks/CU\n", per_cu); per_cu = 1; }
        (void)hipGetLastError();
        grid = cus;
    }
    if (grid < 0) return;
    if (hipMemsetAsync((char*)d_ws + WS_CTL, 0, CTL_BYTES, stream) != hipSuccess) return;
    Args a{};
    a.x = (const float*)d_in[0]; a.w_in = (const float*)d_in[1]; a.q_norm = (const float*)d_in[2]; a.w_uq = (const float*)d_in[3]; a.kv_norm = (const float*)d_in[4];
    a.w_ukv = (const float*)d_in[5]; a.w_out = (const float*)d_in[6]; a.ln1_g = (const float*)d_in[7]; a.ln1_b = (const float*)d_in[8]; a.router_w = (const float*)d_in[9];
    a.router_b = (const float*)d_in[10]; a.w1 = (const float*)d_in[11]; a.w3 = (const float*)d_in[12]; a.w2 = (const float*)d_in[13]; a.ln2_g = (const float*)d_in[14]; a.ln2_b = (const float*)d_in[15];
    a.out = (float*)d_out; a.ws = (unsigned char*)d_ws;
#if MK_N_LAUNCHES == 1
    a.ph_lo = 0; a.ph_hi = N_PHASES;
    hipLaunchKernelGGL(mega_fwd, dim3(grid), dim3(NTHREADS), LDS_BYTES, stream, a);
#else
    for (int ph = 0; ph < N_PHASES; ++ph) { a.ph_lo = ph; a.ph_hi = ph + 1; hipLaunchKernelGGL(mega_fwd, dim3(grid), dim3(NTHREADS), LDS_BYTES, stream, a); }
#endif
}
```

```cpp
#include <hip/hip_runtime.h>
#include <cstdio>
#include <cstdint>

#define LAS __attribute__((address_space(3)))
#define GAS __attribute__((address_space(1)))
typedef unsigned short bf16_t;
typedef short bf16x8 __attribute__((ext_vector_type(8)));
typedef short s16x4 __attribute__((ext_vector_type(4)));
typedef float f32x2 __attribute__((ext_vector_type(2)));
typedef float f32x4 __attribute__((ext_vector_type(4)));
typedef float f32x16 __attribute__((ext_vector_type(16)));
typedef unsigned u32x2 __attribute__((ext_vector_type(2)));
typedef unsigned u32x4 __attribute__((ext_vector_type(4)));
typedef GAS unsigned gu32;

constexpr int BATCH = 8, SEQ = 4096, DM = 1024, T = BATCH * SEQ, DEPTH = 2;
constexpr int N_IN = 2720, N_INP = 2816;
constexpr int NEXP = 64, DEXP = 256, CAP = T;
constexpr float ALPHA = 1.4142135623730951f;
constexpr float LN_EPS = 1e-5f, RMS_EPS = 1e-6f;
constexpr float LOG2E = 1.4426950408889634f;
constexpr int NWAVES = 8, NTHREADS = 512;

constexpr size_t MiB = 1u << 20;
constexpr size_t WS_CTL = 0, CTL_BYTES = 2 * MiB;
constexpr size_t WS_T64 = 2 * MiB;
constexpr size_t WS_T32 = 3 * MiB;
constexpr size_t WS_GB = 3 * MiB + 512 * 1024;
constexpr size_t WS_WIN = 4 * MiB;
constexpr size_t WIN_L = (size_t)N_INP * DM * 2;
constexpr size_t WS_WOUT = 15 * MiB;
constexpr size_t WS_WUQ = 19 * MiB;
constexpr size_t WS_WUKV = 19 * MiB + 512 * 1024;
constexpr size_t WS_RW = 20 * MiB;
constexpr size_t WS_STATS = 21 * MiB;
constexpr size_t WS_PS = 528 * MiB;
constexpr size_t WS_TOKSLOT = 22 * MiB;
constexpr size_t WS_GATE = 30 * MiB;
constexpr size_t WS_XB = 38 * MiB;
constexpr size_t WS_A = 102 * MiB;
constexpr size_t WS_QKV = WS_A;
constexpr size_t SEG_ELEMS = (size_t)T * 384;
constexpr size_t WS_QA = WS_A + 144 * MiB;
constexpr size_t WS_KA = WS_A + 168 * MiB;
constexpr size_t WS_VA = WS_A + 192 * MiB;
constexpr size_t WS_CQ = WS_A + 208 * MiB;
constexpr size_t WS_CKV = WS_A + 224 * MiB;
constexpr size_t WS_KR = WS_A + 232 * MiB;
constexpr size_t WS_Y = WS_A;
constexpr size_t WS_H = WS_A + 144 * MiB;
constexpr size_t WS_MOE = 336 * MiB;
constexpr size_t MOE_L = 96 * MiB;
constexpr size_t WS_END = WS_MOE + 2 * MOE_L + 4 * MiB;
constexpr int CW_BAR = 4096;
constexpr int CW_QUEUE = 8192;
constexpr int CW_CNT = 16384;
constexpr int CW_KMEAN = 65536;
static_assert((CW_KMEAN + 2 * 8 * 6 * 16 * 64) * 4 <= (int)CTL_BYTES, "ctl");

constexpr int LDS_BYTES = 147456;
constexpr int LDSCTL_OFF = 146432;
constexpr int LC_BAR = 0, LC_BCAST = 2, LC_TB = 16, LC_CNT = 96;

__device__ const float INV64[32] = {1.000000000e+00f, 7.498942614e-01f, 5.623413324e-01f, 4.216965139e-01f, 3.162277639e-01f, 2.371373773e-01f, 1.778279394e-01f, 1.333521307e-01f, 1.000000015e-01f, 7.498941571e-02f, 5.623413250e-02f, 4.216965288e-02f, 3.162277490e-02f, 2.371373773e-02f, 1.778279431e-02f, 1.333521493e-02f, 9.999999776e-03f, 7.498941850e-03f, 5.623413250e-03f, 4.216964822e-03f, 3.162277630e-03f, 2.371373586e-03f, 1.778279431e-03f, 1.333521446e-03f, 1.000000047e-03f, 7.498942432e-04f, 5.623413017e-04f, 4.216965172e-04f, 3.162277571e-04f, 2.371373703e-04f, 1.778279402e-04f, 1.333521504e-04f};
__device__ const float INV32[16] = {1.000000000e+00f, 5.623413324e-01f, 3.162277639e-01f, 1.778279394e-01f, 1.000000015e-01f, 5.623413250e-02f, 3.162277490e-02f, 1.778279431e-02f, 9.999999776e-03f, 5.623413250e-03f, 3.162277630e-03f, 1.778279431e-03f, 1.000000047e-03f, 5.623413017e-04f, 3.162277571e-04f, 1.778279402e-04f};

#define LDS_WAIT() asm volatile("s_waitcnt lgkmcnt(0)" ::: "memory")
#define VM_WAIT() asm volatile("s_waitcnt vmcnt(0)" ::: "memory")
#define RLX_AGENT __ATOMIC_RELAXED, __HIP_MEMORY_SCOPE_AGENT
__device__ __forceinline__ unsigned f2bf(float f) { unsigned u = __builtin_bit_cast(unsigned, f); return (u + 0x7fffu + ((u >> 16) & 1u)) >> 16; }
__device__ __forceinline__ unsigned pk2(float lo, float hi) { return f2bf(lo) | (f2bf(hi) << 16); }
typedef __bf16 bf16x2_t __attribute__((ext_vector_type(2)));
__device__ __forceinline__ unsigned cvtpk(float lo, float hi) { f32x2 v = {lo, hi}; bf16x2_t b = __builtin_convertvector(v, bf16x2_t); return __builtin_bit_cast(unsigned, b); }
__device__ __forceinline__ float bf2f(unsigned short b) { return __builtin_bit_cast(float, (unsigned)b << 16); }
__device__ __forceinline__ float bflo(unsigned w) { return __builtin_bit_cast(float, w << 16); }
__device__ __forceinline__ float bfhi(unsigned w) { return __builtin_bit_cast(float, w & 0xffff0000u); }
__device__ __forceinline__ int crow(int r, int hi) { return (r & 3) + 8 * (r >> 2) + 4 * hi; }
__device__ __forceinline__ float wave_sum(float v) {
#pragma unroll
    for (int o = 1; o < 64; o <<= 1) v += __shfl_xor(v, o);
    return v;
}
__device__ __forceinline__ float xhalf(float v) {
    auto rr = __builtin_amdgcn_permlane32_swap(__float_as_uint(v), __float_as_uint(v), false, false);
    return (__builtin_amdgcn_mbcnt_hi(~0u, __builtin_amdgcn_mbcnt_lo(~0u, 0u)) & 32u) ? __uint_as_float(rr[0]) : __uint_as_float(rr[1]);
}

namespace pg8 {
constexpr int BM = 256, BK = 64, HALF = 128, HTB = HALF * BK * 2, STAGE_BYTES = 8 * HTB, NXCD = 8, WGM = 8;
__host__ __device__ __forceinline__ int lds_byte(int r, int c) { const int st = (r >> 4) * 2 + (c >> 5), rr = r & 15, cc = c & 31, ob = rr * 64 + cc * 2; return st * 1024 + (ob ^ (((ob >> 9) & 1) << 5)); }
__host__ __device__ __forceinline__ void stage_rc(int b, int& R, int& C) { const int st = b / 1024, sb = b % 1024, swz = sb ^ (((sb >> 9) & 1) << 5); R = (st >> 1) * 16 + swz / 64; C = (st & 1) * 32 + (swz % 64) / 2; }
__host__ __device__ __forceinline__ int perm32(int rho) { const int n = rho >> 4, i = rho & 15; return 8 * (i >> 2) + 4 * n + (i & 3); }

struct Unit { int pm, pn; };

struct StaticOrder {
    int nM, nN, nwg, G, c;
    __device__ void init(int M, int N, int G_, int c_) { nM = M / BM; nN = N / BM; nwg = nM * nN; G = G_; c = c_; }
    __device__ bool next(int i, Unit& u) const {
        const long L = (long)i * G + c; if (L >= nwg) return false;
        int wgid = (int)L; { const int q = nwg / NXCD, r = nwg % NXCD, xcd = wgid % NXCD, off = wgid / NXCD; wgid = (xcd < r ? xcd * (q + 1) : r * (q + 1) + (xcd - r) * q) + off; }
        const int nig = WGM * nN, gid = wgid / nig, fm = gid * WGM, gsz = (nM - fm) < WGM ? (nM - fm) : WGM;
        u.pm = fm + ((wgid % nig) % gsz); u.pn = (wgid % nig) / gsz; return true;
    }
    __device__ __forceinline__ int a_row(const Unit& u, int r) const { return u.pm * BM + r; }
};

template <class Epi, class Sched, bool ALIGN_EPI, bool SP2>
__device__ __forceinline__ void gemm_phase(const int tid, LAS unsigned char* lds, const bf16_t* A, const bf16_t* Bt, const int K, const Sched& S, const Epi& E) {
    const int wid = __builtin_amdgcn_readfirstlane(tid >> 6), lane = tid & 63, wr = wid >> 2, wc = wid & 3, fr = lane & 15, fq = lane >> 4;
    const int nt = K / BK;
    unsigned voffB[2];
#pragma unroll
    for (int i = 0; i < 2; ++i) { int R, C; stage_rc(tid * 16 + i * 8192, R, C); const int Rb = Epi::PERM ? ((R & ~31) + perm32(R & 31)) : R;
        voffB[i] = (unsigned)(Rb * K + C) * 2u; }
    const size_t kstep = (size_t)(BK * 2);
    const size_t hstep = (size_t)HALF * K * 2;
    const size_t tstep = 2 * hstep;
    const unsigned ldsw = (unsigned)wid * 1024u;
    const int aoff = lds_byte(wr * 64 + fr, fq * 8), boff = lds_byte(wc * 32 + fr, fq * 8);
#define PG8_SA(b, h) (((b) * 2 + (h)) * HTB)
#define PG8_SB(b, h) ((4 + (b) * 2 + (h)) * HTB)
#define PG8_STAGE(bufoff, gbase, voff) do { _Pragma("unroll") for (int _i = 0; _i < 2; ++_i) \
        __builtin_amdgcn_global_load_lds((const unsigned*)((const char*)(gbase) + (voff)[_i]), (LAS unsigned*)(lds + (bufoff) + ldsw + _i * 8192), 16, 0, 0); } while (0)
#define PG8_AVOFF(dst, u) do { _Pragma("unroll") for (int _i = 0; _i < 2; ++_i) { int _R, _C; stage_rc(tid * 16 + _i * 8192, _R, _C); _Pragma("unroll") for (int _h = 0; _h < 2; ++_h) \
        dst[_h][_i] = (unsigned)((unsigned)S.a_row(u, _h * HALF + _R) * (unsigned)K + (unsigned)_C) * 2u; } } while (0)
#define PG8_LDA(dst, b, h) do { _Pragma("unroll") for (int m = 0; m < 4; ++m) _Pragma("unroll") for (int k = 0; k < 2; ++k) dst[m][k] = *(const LAS bf16x8*)(lds + PG8_SA(b, h) + aoff + m * 2048 + k * 1024); } while (0)
#define PG8_LDB(dst, b, h) do { _Pragma("unroll") for (int n = 0; n < 2; ++n) _Pragma("unroll") for (int k = 0; k < 2; ++k) dst[n][k] = *(const LAS bf16x8*)(lds + PG8_SB(b, h) + boff + n * 2048 + k * 1024); } while (0)
#define PG8_MMA(ai, bj, At, Bt_) do { __builtin_amdgcn_s_setprio(1); _Pragma("unroll") for (int m = 0; m < 4; ++m) _Pragma("unroll") for (int n = 0; n < 2; ++n) _Pragma("unroll") for (int k = 0; k < 2; ++k) \
        acc[ai][bj][m][n] = __builtin_amdgcn_mfma_f32_16x16x32_bf16(Bt_[n][k], At[m][k], acc[ai][bj][m][n], 0, 0, 0); __builtin_amdgcn_s_setprio(0); } while (0)
#define PG8_WAIT_V(n) asm volatile("s_waitcnt vmcnt(" #n ")" ::: "memory")
#define PG8_WAIT_L(n) asm volatile("s_waitcnt lgkmcnt(" #n ")" ::: "memory")
#define PG8_BAR __builtin_amdgcn_s_barrier()
#define PG8_SCHED __builtin_amdgcn_sched_barrier(0)
    Unit cur, nxt; int ui = 0;
    if (!S.next(0, cur)) return;
    f32x4 acc[2][2][4][2];
#pragma unroll
    for (int a = 0; a < 2; ++a)
#pragma unroll
        for (int b = 0; b < 2; ++b)
#pragma unroll
            for (int m = 0; m < 4; ++m)
#pragma unroll
                for (int n = 0; n < 2; ++n) acc[a][b][m][n] = (f32x4){0.f, 0.f, 0.f, 0.f};
    bf16x8 At[4][2], B0[2][2], B1[2][2];
    unsigned vc[2][2], vn[2][2];
    PG8_AVOFF(vc, cur);
    const char* cB = (const char*)Bt + (size_t)cur.pn * tstep;
    const char* gA = (const char*)A;
    if constexpr (SP2) {
        PG8_STAGE(PG8_SB(0, 0), cB, voffB); PG8_STAGE(PG8_SB(0, 1), cB + hstep, voffB); PG8_STAGE(PG8_SA(0, 0), gA, vc[0]); PG8_STAGE(PG8_SA(0, 1), gA, vc[1]);
        if (wr == 1) PG8_BAR;
        PG8_WAIT_V(2); PG8_BAR;
        PG8_STAGE(PG8_SB(1, 0), cB + kstep, voffB); PG8_STAGE(PG8_SA(1, 0), gA + kstep, vc[0]); PG8_STAGE(PG8_SB(1, 1), cB + hstep + kstep, voffB);
        PG8_WAIT_V(6); PG8_BAR;
    } else {
        PG8_STAGE(PG8_SB(0, 0), cB, voffB); PG8_STAGE(PG8_SA(0, 0), gA, vc[0]); PG8_STAGE(PG8_SB(0, 1), cB + hstep, voffB); PG8_STAGE(PG8_SA(0, 1), gA, vc[1]);
        if (wr == 1) PG8_BAR;
        PG8_WAIT_V(4); PG8_BAR;
        PG8_STAGE(PG8_SB(1, 0), cB + kstep, voffB); PG8_STAGE(PG8_SA(1, 0), gA + kstep, vc[0]); PG8_STAGE(PG8_SB(1, 1), cB + hstep + kstep, voffB);
        PG8_WAIT_V(6); PG8_BAR;
    }
    for (;;) {
        const bool has_next = S.next(ui + 1, nxt);
        const char* nB = has_next ? (const char*)Bt + (size_t)nxt.pn * tstep : cB;
        for (int t = 0; t < nt; t += 2) {
            const bool last = (t == nt - 2);
            if (t == (nt >= 4 ? nt - 4 : 0)) {
                if (has_next) { PG8_AVOFF(vn, nxt); } else {
#pragma unroll
                    for (int h = 0; h < 2; ++h)
#pragma unroll
                        for (int i = 0; i < 2; ++i) vn[h][i] = vc[h][i]; } }
            const char* a1 = gA + (size_t)(t + 1) * kstep;
            const char* a2 = last ? gA : gA + (size_t)(t + 2) * kstep; const char* b2 = last ? nB : cB + (size_t)(t + 2) * kstep;
            const char* a3 = a2 + kstep; const char* b3 = b2 + kstep;
            unsigned v2[2][2];
#pragma unroll
            for (int h = 0; h < 2; ++h)
#pragma unroll
                for (int i = 0; i < 2; ++i) v2[h][i] = last ? vn[h][i] : vc[h][i];
            if constexpr (SP2) {
            PG8_LDB(B0, 0, 0); PG8_LDB(B1, 0, 1); PG8_SCHED; PG8_LDA(At, 0, 0); PG8_STAGE(PG8_SA(1, 1), a1, vc[1]);
            PG8_WAIT_V(8); PG8_WAIT_L(0); PG8_BAR; PG8_MMA(0, 0, At, B0); PG8_MMA(0, 1, At, B1); PG8_BAR; PG8_SCHED;
            PG8_LDA(At, 0, 1); PG8_STAGE(PG8_SB(0, 0), b2, voffB); PG8_STAGE(PG8_SB(0, 1), b2 + hstep, voffB); PG8_STAGE(PG8_SA(0, 0), a2, v2[0]);
            PG8_WAIT_V(8); PG8_WAIT_L(0); PG8_BAR; PG8_MMA(1, 0, At, B0); PG8_MMA(1, 1, At, B1); PG8_BAR; PG8_SCHED;
            PG8_LDB(B0, 1, 0); PG8_LDB(B1, 1, 1); PG8_SCHED; PG8_LDA(At, 1, 0); PG8_STAGE(PG8_SA(0, 1), a2, v2[1]);
            PG8_WAIT_V(8); PG8_WAIT_L(0); PG8_BAR; PG8_MMA(0, 0, At, B0); PG8_MMA(0, 1, At, B1); PG8_BAR; PG8_SCHED;
            PG8_LDA(At, 1, 1); PG8_STAGE(PG8_SB(1, 0), b3, voffB); PG8_STAGE(PG8_SB(1, 1), b3 + hstep, voffB); PG8_STAGE(PG8_SA(1, 0), a3, v2[0]);
            PG8_WAIT_V(8); PG8_WAIT_L(0); PG8_BAR; PG8_MMA(1, 0, At, B0); PG8_MMA(1, 1, At, B1); PG8_BAR; PG8_SCHED;
            } else {
            PG8_LDB(B0, 0, 0); PG8_SCHED; PG8_LDA(At, 0, 0); PG8_STAGE(PG8_SA(1, 1), a1, vc[1]);
            PG8_WAIT_L(8); PG8_BAR; PG8_WAIT_L(0); PG8_MMA(0, 0, At, B0); PG8_BAR; PG8_SCHED;
            PG8_LDB(B1, 0, 1); PG8_STAGE(PG8_SB(0, 0), b2, voffB);
            PG8_BAR; PG8_WAIT_L(0); PG8_MMA(0, 1, At, B1); PG8_BAR;
            PG8_LDA(At, 0, 1); PG8_STAGE(PG8_SA(0, 0), a2, v2[0]);
            PG8_BAR; PG8_WAIT_L(0); PG8_MMA(1, 0, At, B0); PG8_BAR; PG8_SCHED;
            PG8_STAGE(PG8_SB(0, 1), b2 + hstep, voffB);
            PG8_WAIT_V(6); PG8_BAR; PG8_MMA(1, 1, At, B1); PG8_BAR;
            PG8_LDB(B0, 1, 0); PG8_SCHED; PG8_LDA(At, 1, 0); PG8_STAGE(PG8_SA(0, 1), a2, v2[1]);
            PG8_WAIT_L(8); PG8_BAR; PG8_WAIT_L(0); PG8_MMA(0, 0, At, B0); PG8_BAR; PG8_SCHED;
            PG8_LDB(B1, 1, 1); PG8_STAGE(PG8_SB(1, 0), b3, voffB);
            PG8_BAR; PG8_WAIT_L(0); PG8_MMA(0, 1, At, B1); PG8_BAR;
            PG8_LDA(At, 1, 1); PG8_STAGE(PG8_SA(1, 0), a3, v2[0]);
            PG8_BAR; PG8_WAIT_L(0); PG8_MMA(1, 0, At, B0); PG8_BAR; PG8_SCHED;
            PG8_STAGE(PG8_SB(1, 1), b3 + hstep, voffB);
            PG8_WAIT_V(6); PG8_BAR; PG8_MMA(1, 1, At, B1); PG8_BAR;
            }
        }
        if constexpr (ALIGN_EPI) { if (wr == 0) PG8_BAR; }
        E(acc, cur, wr, wc, fr, fq);
        if (!has_next) break;
#pragma unroll
        for (int a = 0; a < 2; ++a)
#pragma unroll
            for (int b = 0; b < 2; ++b)
#pragma unroll
                for (int m = 0; m < 4; ++m)
#pragma unroll
                    for (int n = 0; n < 2; ++n) acc[a][b][m][n] = (f32x4){0.f, 0.f, 0.f, 0.f};
        cur = nxt; cB = nB; ++ui;
#pragma unroll
        for (int h = 0; h < 2; ++h)
#pragma unroll
            for (int i = 0; i < 2; ++i) vc[h][i] = vn[h][i];
        if constexpr (ALIGN_EPI) { if (wr == 1) PG8_BAR; }
    }
    PG8_WAIT_V(0);
    if constexpr (!ALIGN_EPI) { if (wr == 0) PG8_BAR; }
    PG8_BAR;
#undef PG8_SA
#undef PG8_SB
#undef PG8_STAGE
#undef PG8_AVOFF
#undef PG8_LDA
#undef PG8_LDB
#undef PG8_MMA
#undef PG8_WAIT_V
#undef PG8_WAIT_L
#undef PG8_BAR
#undef PG8_SCHED
}
}

#define XB_TMO      128
#define XB_XCNT(j)  (256  + 64 * (j))
#define XB_XSUB(j)  (1280 + 64 * (j))
#define XB_XGEN(j)  (2304 + 64 * (j))
#define XB_TOP      3328
#define XB_TOPGEN   3392
#define XCD_BAR_WORDS 3456
#define XB_SPIN_CAP (1u << 20)
__device__ __forceinline__ unsigned xb_ld(unsigned* p)              { return __hip_atomic_load(p, __ATOMIC_RELAXED, __HIP_MEMORY_SCOPE_AGENT); }
__device__ __forceinline__ unsigned xb_add(unsigned* p, unsigned v) { return __hip_atomic_fetch_add(p, v, __ATOMIC_RELAXED, __HIP_MEMORY_SCOPE_AGENT); }
__device__ __forceinline__ unsigned xb_xcc_id() { return (unsigned)__builtin_amdgcn_s_getreg((3 << 11) | 20) & 0xFu; }
#define XB_SPIN(cond, bar) do { unsigned _sp = 0; while (cond) { __builtin_amdgcn_s_sleep(1); \
    if ((++_sp & 255u) == 0u) { if (xb_ld(&(bar)[XB_TMO])) break; if (_sp > XB_SPIN_CAP) { atomicAdd(&(bar)[XB_TMO], 1u); break; } } } } while (0)
struct XcdBarrier { unsigned* bar; unsigned x; volatile LAS unsigned* st; };
__device__ __forceinline__ XcdBarrier xcd_barrier_post(unsigned* bar, volatile LAS unsigned* st, bool leader) {
    XcdBarrier b; b.bar = bar; b.x = xb_xcc_id(); b.st = st;
    if (leader) (void)xb_add(&bar[XB_XCNT(b.x)], 1u);
    return b;
}
__device__ __forceinline__ void xcd_barrier_complete(unsigned* bar, unsigned x, unsigned& nloc, unsigned& nx) {
    const unsigned G = gridDim.x * gridDim.y * gridDim.z;
    unsigned sum, cnt, mine, sp = 0u;
    for (;;) {
        sum = 0u; cnt = 0u; mine = 0u;
#pragma unroll
        for (unsigned j = 0; j < 16; ++j) { const unsigned c = xb_ld(&bar[XB_XCNT(j)]); sum += c; cnt += (c > 0u) ? 1u : 0u; mine = (j == x) ? c : mine; }
        if (sum == G) break;
        __builtin_amdgcn_s_sleep(1);
        if ((++sp & 255u) == 0u) { if (xb_ld(&bar[XB_TMO])) break; if (sp > XB_SPIN_CAP) { atomicAdd(&bar[XB_TMO], 1u); break; } }
    }
    nloc = mine > 0u ? mine : 1u; nx = cnt > 0u ? cnt : 1u;
}
__device__ __forceinline__ void xcd_barrier(const XcdBarrier& b, bool leader) {
    asm volatile("s_waitcnt vmcnt(0)" ::: "memory");
    __syncthreads();
    if (leader) {
        unsigned* bar = b.bar;
        __builtin_amdgcn_s_waitcnt(0);
        unsigned nloc = b.st[0], nx = b.st[1];
        if (nloc == 0u) { xcd_barrier_complete(bar, b.x, nloc, nx); b.st[0] = nloc; b.st[1] = nx; }
        const unsigned old = xb_add(&bar[XB_XSUB(b.x)], 1u);
        const unsigned gen = old / nloc;
        if (old + 1u == (gen + 1u) * nloc) {
            __builtin_amdgcn_fence(__ATOMIC_RELEASE, "agent");
            asm volatile("s_waitcnt vmcnt(0)" ::: "memory");
            const unsigned og = xb_add(&bar[XB_TOP], 1u);
            const unsigned tg = og / nx;
            if (og + 1u == (tg + 1u) * nx) xb_add(&bar[XB_TOPGEN], 1u);
            else XB_SPIN(xb_ld(&bar[XB_TOPGEN]) == tg, bar);
            __builtin_amdgcn_fence(__ATOMIC_ACQUIRE, "agent");
            xb_add(&bar[XB_XGEN(b.x)], 1u);
            asm volatile("s_waitcnt vmcnt(0)" ::: "memory");
        } else {
            XB_SPIN(xb_ld(&bar[XB_XGEN(b.x)]) == gen, bar);
            __builtin_amdgcn_fence(__ATOMIC_ACQUIRE, "agent");
            asm volatile("s_waitcnt vmcnt(0)" ::: "memory");
        }
    }
    __syncthreads();
}

struct Args {
    const float* x; const float* w_in; const float* q_norm; const float* w_uq; const float* kv_norm; const float* w_ukv; const float* w_out;
    const float* ln1_g; const float* ln1_b; const float* router_w; const float* router_b; const float* w1; const float* w3; const float* w2;
    const float* ln2_g; const float* ln2_b;
    float* out; unsigned char* ws;
    int ph_lo, ph_hi;
};
struct Frame {
    LAS unsigned char* lds;
    volatile LAS unsigned* LC;
    gu32* ctl;
    unsigned char* ws;
    int tid, lane, wave, vcu, G;
};

template <class Map>
__device__ __forceinline__ void transpose_item(const float* W, int K, int N, bf16_t* WT, const float* kscale, LAS float* scr, int item, int lane, Map map) {
    const int nblk = N / 32, kb = item / nblk, nb = item % nblk, k0 = 64 * kb, n0 = 32 * nb;
    { const int c4 = (lane & 7) * 4; f32x4 v[8];
#pragma unroll
      for (int i = 0; i < 8; ++i) { const int kk = (lane >> 3) + 8 * i; v[i] = *(const GAS f32x4*)(W + (size_t)(k0 + kk) * N + n0 + c4); }
#pragma unroll
      for (int i = 0; i < 8; ++i) { const int kk = (lane >> 3) + 8 * i; f32x4 w = v[i]; if (kscale) w = w * kscale[k0 + kk];
          LAS float* d = scr + kk * 33 + c4; d[0] = w[0]; d[1] = w[1]; d[2] = w[2]; d[3] = w[3]; } }
    LDS_WAIT(); asm volatile("" ::: "memory");
    const int c = lane & 7;
#pragma unroll
    for (int j = 0; j < 4; ++j) { const int n = (lane >> 3) + 8 * j; const LAS float* s = scr + (8 * c) * 33 + n;
        u32x4 o; o.x = pk2(s[0], s[33]); o.y = pk2(s[66], s[99]); o.z = pk2(s[132], s[165]); o.w = pk2(s[198], s[231]);
        const int row = map(n0 + n);
        *(GAS u32x4*)(WT + (size_t)row * K + k0 + 8 * c) = o; }
    LDS_WAIT(); asm volatile("" ::: "memory");
}
__device__ __forceinline__ void router_item(const float* W, const float* g, bf16_t* WH, bf16_t* WL, LAS float* scr, int item, int lane) {
    const int K = 1024, N = 64, nblk = 2, kb = item / nblk, nb = item % nblk, k0 = 64 * kb, n0 = 32 * nb;
    { const int c4 = (lane & 7) * 4; f32x4 v[8];
#pragma unroll
      for (int i = 0; i < 8; ++i) { const int kk = (lane >> 3) + 8 * i; v[i] = *(const GAS f32x4*)(W + (size_t)(k0 + kk) * N + n0 + c4); }
#pragma unroll
      for (int i = 0; i < 8; ++i) { const int kk = (lane >> 3) + 8 * i; f32x4 w = v[i]; if (g) w = w * g[k0 + kk];
          LAS float* d = scr + kk * 33 + c4; d[0] = w[0]; d[1] = w[1]; d[2] = w[2]; d[3] = w[3]; } }
    LDS_WAIT(); asm volatile("" ::: "memory");
    const int c = lane & 7;
#pragma unroll
    for (int j = 0; j < 4; ++j) { const int n = (lane >> 3) + 8 * j; const LAS float* s = scr + (8 * c) * 33 + n;
        unsigned h[8], l[8];
#pragma unroll
        for (int q = 0; q < 8; ++q) { const float v = s[q * 33]; h[q] = f2bf(v); l[q] = f2bf(v - __builtin_bit_cast(float, h[q] << 16)); }
        u32x4 oh, ol; oh.x = h[0] | (h[1] << 16); oh.y = h[2] | (h[3] << 16); oh.z = h[4] | (h[5] << 16); oh.w = h[6] | (h[7] << 16);
        ol.x = l[0] | (l[1] << 16); ol.y = l[2] | (l[3] << 16); ol.z = l[4] | (l[5] << 16); ol.w = l[6] | (l[7] << 16);
        *(GAS u32x4*)(WH + (size_t)(n0 + n) * K + k0 + 8 * c) = oh; *(GAS u32x4*)(WL + (size_t)(n0 + n) * K + k0 + 8 * c) = ol; }
    LDS_WAIT(); asm volatile("" ::: "memory");
}
struct MapId { int off; __device__ __forceinline__ int operator()(int n) const { return off + n; } };
struct MapWin { __device__ __forceinline__ int operator()(int n) const {
    if (n < 384) return n;
    if (n < 416) { const int e = n - 384, nn = e >> 4, fq = (e >> 2) & 3, j = e & 3; return 384 + 8 * fq + 4 * nn + j; }
    const int m = n - 416, seg = m / 384, r = m % 384, hh = r >> 6, e = r & 63, base = 512 + seg * 384 + hh * 64;
    if (seg == 2 || seg == 5) return base + e;
    const int nn = e >> 5, wcl = (e >> 4) & 1, fq = (e >> 2) & 3, j = e & 3; return base + 32 * wcl + 8 * fq + 4 * nn + j; } };
struct MapW13 { int e, which; __device__ __forceinline__ int operator()(int n) const { return e * 512 + 256 * (n >> 7) + 128 * which + (n & 127); } };

__device__ __forceinline__ void sincos_d(double a, float& s, float& c) {
    const double TWO_PI = 6.283185307179586476925, INV = 0.15915494309189533577;
    const double k = __builtin_rint(a * INV); const double r = a - k * TWO_PI; const double r2 = r * r;
    double ts = r, ss = r, tc = 1.0, cs = 1.0;
    for (int n = 1; n <= 14; ++n) { tc *= -r2 / (double)((2 * n - 1) * (2 * n)); cs += tc; ts *= -r2 / (double)((2 * n) * (2 * n + 1)); ss += ts; }
    s = (float)ss; c = (float)cs;
}

__device__ __forceinline__ void p0_prologue(Frame& F, const Args& a) {
    LAS float* scr = (LAS float*)(F.lds + F.wave * 16384);
    const int gw = F.vcu * NWAVES + F.wave, NGW = F.G * NWAVES, lane = F.lane;
    unsigned char* ws = F.ws;
    constexpr int I_WIN = 16 * 85, I_WUQ = 4 * 12, I_WUKV = 2 * 16, I_WOUT = 16 * 32, I_RW = 16 * 2, I_MOE = 128;
    constexpr int PER_L = I_WIN + I_WUQ + I_WUKV + I_WOUT + I_RW;
    constexpr int N_SMALL = 2 * PER_L, N_MOE = 2 * 64 * 3 * I_MOE, NITEMS = N_SMALL + N_MOE;
    for (int it = gw; it < NITEMS; it += NGW) {
        if (it >= N_SMALL) {
            int r = it - N_SMALL; const int item = r % I_MOE; r /= I_MOE; const int which = r % 3; r /= 3; const int e = r % 64, l = r / 64;
            bf16_t* W13t = (bf16_t*)(ws + WS_MOE + (size_t)l * MOE_L); bf16_t* W2t = (bf16_t*)(ws + WS_MOE + (size_t)l * MOE_L + 64 * MiB);
            const size_t eoff = ((size_t)l * 64 + e) * (size_t)(1024 * 256);
            if (which == 0) transpose_item(a.w1 + eoff, 1024, 256, W13t, nullptr, scr, item, lane, MapW13{e, 0});
            else if (which == 1) transpose_item(a.w3 + eoff, 1024, 256, W13t, nullptr, scr, item, lane, MapW13{e, 1});
            else transpose_item(a.w2 + eoff, 256, 1024, W2t, nullptr, scr, item, lane, MapId{e * 1024});
            continue;
        }
        const int l = it / PER_L; int r = it % PER_L;
        if (r < I_WIN) { transpose_item(a.w_in + (size_t)l * 1024 * N_IN, 1024, N_IN, (bf16_t*)(ws + WS_WIN + (size_t)l * WIN_L), nullptr, scr, r, lane, MapWin{}); continue; } r -= I_WIN;
        if (r < I_WUQ) { transpose_item(a.w_uq + (size_t)l * 256 * 384, 256, 384, (bf16_t*)(ws + WS_WUQ) + (size_t)l * 384 * 256, a.q_norm + l * 256, scr, r, lane, MapId{0}); continue; } r -= I_WUQ;
        if (r < I_WUKV) { transpose_item(a.w_ukv + (size_t)l * 128 * 512, 128, 512, (bf16_t*)(ws + WS_WUKV) + (size_t)l * 512 * 128, a.kv_norm + l * 128, scr, r, lane, MapId{0}); continue; } r -= I_WUKV;
        if (r < I_WOUT) { transpose_item(a.w_out + (size_t)l * 1024 * 1024, 1024, 1024, (bf16_t*)(ws + WS_WOUT) + (size_t)l * 1024 * 1024, nullptr, scr, r, lane, MapId{0}); continue; } r -= I_WOUT;
        router_item(a.router_w, nullptr, (bf16_t*)(ws + WS_RW) + (size_t)(l * 2) * 65536, (bf16_t*)(ws + WS_RW) + (size_t)(l * 2 + 1) * 65536, scr, r, lane);
    }
    { const int gt = gw * 64 + lane, NT_ = NGW * 64;
      for (int i = gt; i < 2 * 96 * 128; i += NT_) { const int l = i / (96 * 128), r = i % (96 * 128);
          *(GAS u32x4*)(ws + WS_WIN + (size_t)l * WIN_L + (size_t)416 * 2048 + (size_t)r * 16) = (u32x4){0u, 0u, 0u, 0u}; }
      for (int i = gt; i < 4096 * 32; i += NT_) { const int pos = i >> 5, f = i & 31; const float ang = (float)pos * INV64[f]; float s, c; sincos_d((double)ang, s, c);
          ((GAS f32x2*)(ws + WS_T64))[i] = (f32x2){c, s}; }
      for (int i = gt; i < 4096 * 16; i += NT_) { const int pos = i >> 4, f = i & 15; const float ang = (float)pos * INV32[f]; float s, c; sincos_d((double)ang, s, c);
          ((GAS f32x2*)(ws + WS_T32))[i] = (f32x2){c, s}; }
    }
    for (int it = gw; it < 256; it += NGW) { const int e = it & 63, which = (it >> 6) & 1, l = it >> 7;
        const float* v = (which ? a.ln1_b : a.ln1_g) + l * 1024; float s = 0.f;
        for (int i = 0; i < 16; ++i) { const int c = lane + 64 * i; s += v[c] * a.router_w[c * 64 + e]; }
        s = wave_sum(s); if (lane == 0) ((GAS float*)(ws + WS_GB))[it] = s; }
    { bf16_t* xb = (bf16_t*)(ws + WS_XB);
      for (int it = gw; it < T * DM / 2048; it += NGW) { const size_t o = (size_t)it * 2048 + lane * 8;
          f32x4 v0[4], v1[4];
#pragma unroll
          for (int j = 0; j < 4; ++j) { v0[j] = *(const GAS f32x4*)(a.x + o + 512 * j); v1[j] = *(const GAS f32x4*)(a.x + o + 512 * j + 4); }
#pragma unroll
          for (int j = 0; j < 4; ++j) { u32x4 w; w.x = pk2(v0[j].x, v0[j].y); w.y = pk2(v0[j].z, v0[j].w); w.z = pk2(v1[j].x, v1[j].y); w.w = pk2(v1[j].z, v1[j].w);
              *(GAS u32x4*)(xb + o + 512 * j) = w; } } }
}

__device__ __forceinline__ u32x4 pack8(const f32x4& a, const f32x4& b) { u32x4 w; w.x = cvtpk(a[0], a[1]); w.y = cvtpk(a[2], a[3]); w.z = cvtpk(b[0], b[1]); w.w = cvtpk(b[2], b[3]); return w; }
__device__ __forceinline__ u32x2 pack4(const f32x4& a) { u32x2 w; w.x = cvtpk(a[0], a[1]); w.y = cvtpk(a[2], a[3]); return w; }

struct EpiP1 {
    static constexpr bool PERM = true;
    bf16_t *CQ, *CKV, *KR, *QKV; const f32x2* T64; const f32x2* T32; float* KM;
    __device__ __forceinline__ void operator()(const f32x4 (&acc)[2][2][4][2], const pg8::Unit& u, int wr, int wc, int fr, int fq) const {
        asm volatile("" : "+v"(fr), "+v"(fq));
        const int rowb = u.pm * 256 + wr * 64 + fr;
        if (u.pn == 0) {
#pragma unroll
            for (int ai = 0; ai < 2; ++ai)
#pragma unroll
                for (int m = 0; m < 4; ++m) { const size_t row = rowb + ai * 128 + m * 16;
#pragma unroll
                    for (int bj = 0; bj < 2; ++bj) *(GAS u32x4*)(CQ + row * 256 + bj * 128 + wc * 32 + 8 * fq) = pack8(acc[ai][bj][m][0], acc[ai][bj][m][1]); }
        } else if (u.pn == 1) {
#pragma unroll
            for (int ai = 0; ai < 2; ++ai)
#pragma unroll
                for (int m = 0; m < 4; ++m) { const size_t row = rowb + ai * 128 + m * 16;
                    *(GAS u32x4*)(CKV + row * 128 + wc * 32 + 8 * fq) = pack8(acc[ai][0][m][0], acc[ai][0][m][1]);
                    if (wc == 0) { const int pos = (int)(row & 4095);
                        const f32x4 t0 = *(const GAS f32x4*)(T32 + pos * 16 + 4 * fq), t1 = *(const GAS f32x4*)(T32 + pos * 16 + 4 * fq + 2);
                        const f32x4 x1 = acc[ai][1][m][0], x2 = acc[ai][1][m][1];
                        const f32x4 c = {t0[0], t0[2], t1[0], t1[2]}, s = {t0[1], t0[3], t1[1], t1[3]};
                        const f32x4 o1 = x1 * c - x2 * s, o2 = x2 * c + x1 * s;
                        *(GAS u32x2*)(KR + row * 32 + 4 * fq) = pack4(o1); *(GAS u32x2*)(KR + row * 32 + 16 + 4 * fq) = pack4(o2); } asm volatile("" ::: "memory"); }
        } else {
#pragma unroll
            for (int bj = 0; bj < 2; ++bj) {
                const int gh = (u.pn - 2) * 4 + 2 * bj + (wc >> 1), seg = gh / 6, hh = gh % 6, wcl = wc & 1;
                bf16_t* dst = QKV + (size_t)seg * SEG_ELEMS;
                if (seg == 2 || seg == 5) {
#pragma unroll
                    for (int ai = 0; ai < 2; ++ai)
#pragma unroll
                        for (int m = 0; m < 4; ++m) { const size_t row = rowb + ai * 128 + m * 16;
                            *(GAS u32x4*)(dst + row * 384 + hh * 64 + 32 * wcl + 8 * fq) = pack8(acc[ai][bj][m][0], acc[ai][bj][m][1]); }
                } else {
                    const int e0 = 16 * wcl + 4 * fq; f32x4 s1 = {0.f, 0.f, 0.f, 0.f}, s2 = {0.f, 0.f, 0.f, 0.f};
                    const float qs = (seg == 0 || seg == 3) ? 0.125f * LOG2E : 1.0f;
#pragma unroll
                    for (int ai = 0; ai < 2; ++ai)
#pragma unroll
                        for (int m = 0; m < 4; ++m) { const size_t row = rowb + ai * 128 + m * 16; const int pos = (int)(row & 4095);
                            const f32x4 t0 = *(const GAS f32x4*)(T64 + pos * 32 + e0), t1 = *(const GAS f32x4*)(T64 + pos * 32 + e0 + 2);
                            const f32x4 x1 = acc[ai][bj][m][0], x2 = acc[ai][bj][m][1];
                            const f32x4 c = {t0[0], t0[2], t1[0], t1[2]}, s = {t0[1], t0[3], t1[1], t1[3]};
                            const f32x4 o1 = (x1 * c - x2 * s) * qs, o2 = (x2 * c + x1 * s) * qs;
                            *(GAS u32x2*)(dst + row * 384 + hh * 64 + e0) = pack4(o1); *(GAS u32x2*)(dst + row * 384 + hh * 64 + 32 + e0) = pack4(o2);
                            s1 += o1; s2 += o2; asm volatile("" ::: "memory"); }
                    if (seg == 1) {
#pragma unroll
                        for (int j = 0; j < 4; ++j) {
#pragma unroll
                            for (int o = 1; o < 16; o <<= 1) { s1[j] += __shfl_xor(s1[j], o); s2[j] += __shfl_xor(s2[j], o); } }
                        if (fr == 0) { float* km = KM + (((size_t)(u.pm >> 4) * 6 + hh) * 16 + (u.pm & 15)) * 64 + e0;
#pragma unroll
                            for (int j = 0; j < 4; ++j) { atomicAdd(km + j, s1[j]); atomicAdd(km + 32 + j, s2[j]); } }
                    }
                }
            }
        }
    }
};

struct EpiP3 {
    static constexpr bool PERM = false;
    const float* res; float* out; float* PS;
    __device__ __forceinline__ void operator()(const f32x4 (&acc)[2][2][4][2], const pg8::Unit& u, int wr, int wc, int fr, int fq) const {
        const int col0 = u.pn * 256 + wc * 32 + 4 * fq;
#pragma unroll
        for (int ai = 0; ai < 2; ++ai)
#pragma unroll
            for (int m = 0; m < 4; ++m) { const size_t row = u.pm * 256 + ai * 128 + wr * 64 + m * 16 + fr; float s = 0.f, q = 0.f;
#pragma unroll
                for (int bj = 0; bj < 2; ++bj)
#pragma unroll
                    for (int n = 0; n < 2; ++n) { const size_t off = row * 1024 + col0 + bj * 128 + n * 16;
                        const f32x4 r = *(const GAS f32x4*)(res + off); const f32x4 v = r * ALPHA + acc[ai][bj][m][n]; *(GAS f32x4*)(out + off) = v;
                        s += (v[0] + v[1]) + (v[2] + v[3]); q += (v[0] * v[0] + v[1] * v[1]) + (v[2] * v[2] + v[3] * v[3]); }
                s += __shfl_xor(s, 16); q += __shfl_xor(q, 16); s += __shfl_xor(s, 32); q += __shfl_xor(q, 32);
                if (fq == 0) *(GAS f32x2*)(PS + ((row * 4 + u.pn) * 4 + wc) * 2) = (f32x2){s, q};
                asm volatile("" ::: "memory"); }
    }
};

struct MoeSched {
    const LAS int* tb; const LAS int* cnt; const int* tokslot; int NCT, G, c, ntiles; bool gather;
    __device__ __forceinline__ bool next(int i, pg8::Unit& u) const {
        const long L = (long)i * G + c; if (L >= (long)ntiles * NCT) return false;
        const int tau = (int)(L / NCT), ct = (int)(L % NCT);
        int lo = 0, hi = 64;
        while (hi - lo > 1) { const int mid = (lo + hi) >> 1; if (tb[mid] <= tau) lo = mid; else hi = mid; }
        u.pm = tau; u.pn = lo * NCT + ct; return true;
    }
    __device__ __forceinline__ int a_row(const pg8::Unit& u, int r) const {
        if (!gather) return u.pm * 256 + r;
        const int e = u.pn / NCT, slot = (u.pm - tb[e]) * 256 + r;
        return slot < cnt[e] ? (tokslot[(size_t)e * CAP + slot] >> 1) : 0;
    }
};
__device__ __forceinline__ float silu_f(float x) { return x * __builtin_amdgcn_rcpf(1.f + __builtin_amdgcn_exp2f(-x * LOG2E)); }
struct EpiP5 {
    static constexpr bool PERM = true;
    bf16_t* H;
    __device__ __forceinline__ void operator()(const f32x4 (&acc)[2][2][4][2], const pg8::Unit& u, int wr, int wc, int fr, int fq) const {
        const int ct = u.pn & 1;
#pragma unroll
        for (int ai = 0; ai < 2; ++ai)
#pragma unroll
            for (int m = 0; m < 4; ++m) { const size_t row = (size_t)u.pm * 256 + ai * 128 + wr * 64 + m * 16 + fr;
                f32x4 v[2];
#pragma unroll
                for (int n = 0; n < 2; ++n)
#pragma unroll
                    for (int j = 0; j < 4; ++j) v[n][j] = silu_f(acc[ai][0][m][n][j]) * acc[ai][1][m][n][j];
                *(GAS u32x4*)(H + row * 256 + ct * 128 + wc * 32 + 8 * fq) = pack8(v[0], v[1]); }
    }
};
struct EpiP6 {
    static constexpr bool PERM = true;
    bf16_t* Y; const LAS int* tb; const LAS int* cnt; const int* tokslot; const float* gate;
    __device__ __forceinline__ void operator()(const f32x4 (&acc)[2][2][4][2], const pg8::Unit& u, int wr, int wc, int fr, int fq) const {
        const int e = u.pn >> 2, ct = u.pn & 3, bs = (u.pm - tb[e]) * 256, ne = cnt[e];
#pragma unroll
        for (int ai = 0; ai < 2; ++ai)
#pragma unroll
            for (int m = 0; m < 4; ++m) { const int slot = bs + ai * 128 + wr * 64 + m * 16 + fr;
                if (slot < ne) { const size_t idx = (size_t)e * CAP + slot; const size_t dst = (size_t)tokslot[idx]; const float g = gate[idx];
#pragma unroll
                    for (int bj = 0; bj < 2; ++bj) *(GAS u32x4*)(Y + dst * 1024 + ct * 256 + bj * 128 + wc * 32 + 8 * fq) = pack8(acc[ai][bj][m][0] * g, acc[ai][bj][m][1] * g); } }
    }
};

#define MFMA32(a, b, c) __builtin_amdgcn_mfma_f32_32x32x16_bf16(a, b, c, 0, 0, 0)
__device__ __forceinline__ float ssq8(const bf16x8& v) { float s = 0.f;
#pragma unroll
    for (int j = 0; j < 8; ++j) { const float f = bf2f((unsigned short)v[j]); s += f * f; } return s; }

constexpr float MLA_QSCALE = 0.10206207261596575f * LOG2E;
__device__ __forceinline__ void p1b_mla(Frame& F, int l) {
    unsigned char* ws = F.ws;
    const bf16_t* CQ = (const bf16_t*)(ws + WS_CQ); const bf16_t* CKV = (const bf16_t*)(ws + WS_CKV); const bf16_t* KR = (const bf16_t*)(ws + WS_KR);
    const bf16_t* Wuq = (const bf16_t*)(ws + WS_WUQ) + (size_t)l * 384 * 256; const bf16_t* Wukv = (const bf16_t*)(ws + WS_WUKV) + (size_t)l * 512 * 128;
    bf16_t* QA = (bf16_t*)(ws + WS_QA); bf16_t* KA = (bf16_t*)(ws + WS_KA); bf16_t* VA = (bf16_t*)(ws + WS_VA);
    const f32x2* T32 = (const f32x2*)(ws + WS_T32);
    const int gw = F.vcu * NWAVES + F.wave, NGW = F.G * NWAVES, lane = F.lane, r32 = lane & 31, hi = lane >> 5;
    for (int tw = gw; tw < 2 * (T / 32); tw += NGW) {
        const int it = tw >> 1, path = tw & 1;
        const size_t tok = (size_t)it * 32 + r32; const int pos = (int)(tok & 4095);
        if (path == 0) {
            bf16x8 bq[16]; float ss = 0.f;
#pragma unroll
            for (int ks = 0; ks < 16; ++ks) { bq[ks] = *(const GAS bf16x8*)(CQ + tok * 256 + 16 * ks + 8 * hi); ss += ssq8(bq[ks]); }
            ss += xhalf(ss);
            const float rq = MLA_QSCALE / sqrtf(ss * (1.0f / 256.0f) + RMS_EPS);
            f32x4 cs[2][2];
#pragma unroll
            for (int g = 0; g < 2; ++g) { cs[g][0] = *(const GAS f32x4*)(T32 + pos * 16 + 8 * g + 4 * hi); cs[g][1] = *(const GAS f32x4*)(T32 + pos * 16 + 8 * g + 4 * hi + 2); }
            bf16x8 wa[16];
            { const bf16_t* wrow = Wuq + (size_t)r32 * 256 + 8 * hi;
#pragma unroll
              for (int ks = 0; ks < 16; ++ks) wa[ks] = *(const GAS bf16x8*)(wrow + 16 * ks); }
#pragma unroll 1
            for (int fb = 0; fb < 12; ++fb) {
                bf16x8 wb[16];
                { const bf16_t* wrow = Wuq + (size_t)(32 * (fb + 1 < 12 ? fb + 1 : fb) + r32) * 256 + 8 * hi;
#pragma unroll
                  for (int ks = 0; ks < 16; ++ks) wb[ks] = *(const GAS bf16x8*)(wrow + 16 * ks); }
                f32x16 acc = {};
#pragma unroll
                for (int ks = 0; ks < 16; ++ks) acc = MFMA32(wa[ks], bq[ks], acc);
#pragma unroll
                for (int r = 0; r < 16; ++r) acc[r] *= rq;
                const int head = fb / 3, part = fb % 3;
                if (part == 2) {
#pragma unroll
                    for (int r = 0; r < 8; ++r) { const int g = r >> 2, j = r & 3; const float c = cs[g][j >> 1][(j & 1) * 2], s = cs[g][j >> 1][(j & 1) * 2 + 1];
                        const float x1 = acc[r], x2 = acc[r + 8]; acc[r] = x1 * c - x2 * s; acc[r + 8] = x2 * c + x1 * s; }
                }
                bf16_t* dst = QA + tok * 384 + head * 96 + part * 32 + 4 * hi;
#pragma unroll
                for (int g = 0; g < 4; ++g) { u32x2 w; w.x = cvtpk(acc[4 * g], acc[4 * g + 1]); w.y = cvtpk(acc[4 * g + 2], acc[4 * g + 3]); *(GAS u32x2*)(dst + 8 * g) = w; }
#pragma unroll
                for (int ks = 0; ks < 16; ++ks) wa[ks] = wb[ks];
            }
        } else {
            bf16x8 bk[8]; float ss = 0.f;
#pragma unroll
            for (int ks = 0; ks < 8; ++ks) { bk[ks] = *(const GAS bf16x8*)(CKV + tok * 128 + 16 * ks + 8 * hi); ss += ssq8(bk[ks]); }
            ss += xhalf(ss);
            const float rk = 1.0f / sqrtf(ss * (1.0f / 128.0f) + RMS_EPS);
            bf16x8 wa[8];
            { const bf16_t* wrow = Wukv + (size_t)r32 * 128 + 8 * hi;
#pragma unroll
              for (int ks = 0; ks < 8; ++ks) wa[ks] = *(const GAS bf16x8*)(wrow + 16 * ks); }
#pragma unroll 1
            for (int fb = 0; fb < 16; ++fb) {
                bf16x8 wb[8];
                { const bf16_t* wrow = Wukv + (size_t)(32 * (fb + 1 < 16 ? fb + 1 : fb) + r32) * 128 + 8 * hi;
#pragma unroll
                  for (int ks = 0; ks < 8; ++ks) wb[ks] = *(const GAS bf16x8*)(wrow + 16 * ks); }
                f32x16 acc = {};
#pragma unroll
                for (int ks = 0; ks < 8; ++ks) acc = MFMA32(wa[ks], bk[ks], acc);
#pragma unroll
                for (int r = 0; r < 16; ++r) acc[r] *= rk;
                const int head = fb >> 2, part = fb & 3;
                bf16_t* dst = (part < 2) ? (KA + tok * 384 + head * 96 + part * 32 + 4 * hi) : (VA + tok * 256 + head * 64 + (part - 2) * 32 + 4 * hi);
#pragma unroll
                for (int g = 0; g < 4; ++g) { u32x2 w; w.x = cvtpk(acc[4 * g], acc[4 * g + 1]); w.y = cvtpk(acc[4 * g + 2], acc[4 * g + 3]); *(GAS u32x2*)(dst + 8 * g) = w; }
#pragma unroll
                for (int ks = 0; ks < 8; ++ks) wa[ks] = wb[ks];
            }
            const u32x4 k0 = *(const GAS u32x4*)(KR + tok * 32 + 16 * hi), k1 = *(const GAS u32x4*)(KR + tok * 32 + 16 * hi + 8);
#pragma unroll
            for (int h = 0; h < 4; ++h) { *(GAS u32x4*)(KA + tok * 384 + h * 96 + 64 + 16 * hi) = k0; *(GAS u32x4*)(KA + tok * 384 + h * 96 + 64 + 16 * hi + 8) = k1; }
        }
    }
}

typedef const LAS char* lds_cptr;
typedef short v4i16_t __attribute__((ext_vector_type(4)));
__device__ __forceinline__ s16x4 vtr(lds_cptr p) { return __builtin_bit_cast(s16x4, __builtin_amdgcn_ds_read_tr16_b64_v4i16((LAS v4i16_t*)p)); }
#define MX3(a, b, c) __builtin_fmaxf(__builtin_fmaxf((a), (b)), (c))
__device__ __forceinline__ float rowmax32(const f32x16& p0, const f32x16& p1) {
    float a = MX3(p0[0], p0[1], p1[0]), b = MX3(p0[2], p0[3], p1[1]); a = MX3(a, p1[2], p1[3]);
#pragma unroll
    for (int r = 4; r < 16; r += 4) { a = MX3(a, p0[r], p0[r + 1]); b = MX3(b, p0[r + 2], p0[r + 3]); a = MX3(a, p1[r], p1[r + 1]); b = MX3(b, p1[r + 2], p1[r + 3]); }
    const float m = __builtin_fmaxf(a, b); auto rr = __builtin_amdgcn_permlane32_swap(__float_as_uint(m), __float_as_uint(m), false, false);
    return __builtin_fmaxf(__uint_as_float(rr[0]), __uint_as_float(rr[1]));
}
struct AttnSt { f32x16 o0, o1; float m, l; };
constexpr float NEG_BIG = -1e30f, M_FLOOR = -1e29f;
__device__ __forceinline__ void attn_init(AttnSt& st) { st.o0 = f32x16{}; st.o1 = f32x16{}; st.m = M_FLOOR; st.l = 0.f; }

template <int DK>
__device__ __forceinline__ void qk_tile(f32x16& p0, f32x16& p1, lds_cptr K, const bf16x8* qr, int r32, int hi) {
    p0 = f32x16{}; p1 = f32x16{};
    const lds_cptr kb = K + hi * 1024 + r32 * 16;
#pragma unroll
    for (int d0 = 0; d0 < DK / 16; ++d0) {
        const bf16x8 b0 = *(const LAS bf16x8*)(kb + d0 * 2048), b1 = *(const LAS bf16x8*)(kb + d0 * 2048 + 512);
        p0 = MFMA32(b0, qr[d0], p0); p1 = MFMA32(b1, qr[d0], p1); }
}
__device__ __forceinline__ void softmax_step(f32x16& p0, f32x16& p1, AttnSt& st, LAS float* wsf, int r32, int hi, u32x4 (&pw)[4]) {
    const float rm = rowmax32(p0, p1);
    const float mnew = __builtin_fmaxf(st.m, rm);
    const float alpha = __builtin_amdgcn_exp2f(st.m - mnew);
    if (__any(mnew > st.m)) {
        if (hi == 0) wsf[r32] = alpha;
#pragma unroll
        for (int r = 0; r < 16; ++r) { const float a = wsf[crow(r, hi)]; st.o0[r] *= a; st.o1[r] *= a; }
    }
    st.m = mnew;
    float s = 0.f;
#pragma unroll
    for (int r = 0; r < 16; ++r) { p0[r] = __builtin_amdgcn_exp2f(p0[r] - mnew); p1[r] = __builtin_amdgcn_exp2f(p1[r] - mnew); s += p0[r] + p1[r]; }
    st.l = st.l * alpha + s;
    pw[0] = (u32x4){cvtpk(p0[0], p0[1]), cvtpk(p0[2], p0[3]), cvtpk(p0[4], p0[5]), cvtpk(p0[6], p0[7])};
    pw[1] = (u32x4){cvtpk(p0[8], p0[9]), cvtpk(p0[10], p0[11]), cvtpk(p0[12], p0[13]), cvtpk(p0[14], p0[15])};
    pw[2] = (u32x4){cvtpk(p1[0], p1[1]), cvtpk(p1[2], p1[3]), cvtpk(p1[4], p1[5]), cvtpk(p1[6], p1[7])};
    pw[3] = (u32x4){cvtpk(p1[8], p1[9]), cvtpk(p1[10], p1[11]), cvtpk(p1[12], p1[13]), cvtpk(p1[14], p1[15])};
}
__device__ __forceinline__ void pv_tile(AttnSt& st, lds_cptr V, const u32x4 (&pw)[4], int lane) {
    const int hi = lane >> 5;
    const lds_cptr vp = V + ((lane >> 4) & 1) * 32 + (lane & 3) * 8 + (4 * hi + ((lane & 15) >> 2)) * 64;
#pragma unroll
    for (int ks = 0; ks < 4; ++ks) {
        const s16x4 l0 = vtr(vp + ks * 1024), h0 = vtr(vp + ks * 1024 + 512), l1 = vtr(vp + 4096 + ks * 1024), h1 = vtr(vp + 4096 + ks * 1024 + 512);
        const bf16x8 f0 = {l0[0], l0[1], l0[2], l0[3], h0[0], h0[1], h0[2], h0[3]}, f1 = {l1[0], l1[1], l1[2], l1[3], h1[0], h1[1], h1[2], h1[3]};
        const bf16x8 pa = __builtin_bit_cast(bf16x8, pw[ks]);
        st.o0 = MFMA32(pa, f0, st.o0); st.o1 = MFMA32(pa, f1, st.o1); }
}
__device__ __forceinline__ void attn_finish(AttnSt& st, LAS float* wsf, int r32, int hi, float (&rli)[16], float& lse2) {
    const float lt = st.l + xhalf(st.l);
    lse2 = st.m + __builtin_amdgcn_logf(lt);
    if (hi == 0) wsf[32 + r32] = lt;
#pragma unroll
    for (int r = 0; r < 16; ++r) rli[r] = __builtin_amdgcn_rcpf(wsf[32 + crow(r, hi)]);
}

constexpr int AL_K0 = 0, AL_K1 = 12288, AL_V0 = 24576, AL_V1 = 32768, AL_WSF = 65536, AL_OST = 67584;
constexpr int AL_M = 67584, AL_ML = 67584 + 65536;

template <int DK>
__device__ __forceinline__ void attn_shared_unit(Frame& F, const bf16_t* Qp, int qpitch, const bf16_t* Kp, int kpitch, const bf16_t* Vp, int vpitch, bf16_t* Op,
                                                 int q0, int NT, float sc, bool moba, const float* km) {
    const int tid = F.tid, lane = F.lane, wid = F.wave, r32 = lane & 31, hi = lane >> 5;
    LAS unsigned char* lds = F.lds; LAS float* wsf = (LAS float*)(lds + AL_WSF) + wid * 64;
    bf16x8 qr[DK / 16];
    { const bf16_t* qrow = Qp + (size_t)(q0 + wid * 32 + r32) * qpitch + 8 * hi;
#pragma unroll
      for (int d0 = 0; d0 < DK / 16; ++d0) qr[d0] = *(const GAS bf16x8*)(qrow + 16 * d0); }
    unsigned selmask = 0xffffffffu;
    if (moba) {
        const int nb = q0 >> 8;
        if (nb <= 3) selmask = (1u << nb) - 1u;
        else {
            float v1 = -3e38f, v2 = -3e38f, v3 = -3e38f; int i1 = 0, i2 = 0, i3 = 0;
#pragma unroll
            for (int j = 0; j < 15; ++j) {
                if (j < nb) {
                    float g = 0.f;
#pragma unroll
                    for (int d0 = 0; d0 < 4; ++d0) { const float* kp = km + j * 64 + 16 * d0 + 8 * hi; const f32x4 a = *(const GAS f32x4*)kp, b = *(const GAS f32x4*)(kp + 4);
                        const bf16x8 qv = qr[d0];
#define QF(e) bf2f((unsigned short)qv[e])
                        g += QF(0) * a[0] + QF(1) * a[1] + QF(2) * a[2] + QF(3) * a[3] + QF(4) * b[0] + QF(5) * b[1] + QF(6) * b[2] + QF(7) * b[3];
#undef QF
                    }
                    g += xhalf(g);
                    if (g > v1) { v3 = v2; i3 = i2; v2 = v1; i2 = i1; v1 = g; i1 = j; }
                    else if (g > v2) { v3 = v2; i3 = i2; v2 = g; i2 = j; }
                    else if (g > v3) { v3 = g; i3 = j; }
                }
            }
            selmask = (1u << i1) | (1u << i2) | (1u << i3);
        }
    }
    const int krow = tid & 63, kch = tid >> 6, vdh = tid >> 8, vrow = (tid >> 2) & 63, vc4 = tid & 3;
    const bf16_t* ksrc = Kp + (size_t)krow * kpitch + kch * 8;
    const bf16_t* vsrc = Vp + (size_t)vrow * vpitch + vdh * 32 + vc4 * 8;
    const int kdst = kch * 1024 + krow * 16, vdst = vdh * 4096 + vrow * 64 + vc4 * 16;
    const bool k2 = (DK > 64) && (tid < (DK - 64) * 8);
    u32x4 kreg0, kreg1 = {0u, 0u, 0u, 0u}, vreg;
    kreg0 = *(const GAS u32x4*)ksrc; if (k2) kreg1 = *(const GAS u32x4*)(ksrc + 64); vreg = *(const GAS u32x4*)vsrc;
    *(LAS u32x4*)(lds + AL_K0 + kdst) = kreg0; if (k2) *(LAS u32x4*)(lds + AL_K0 + kdst + 8192) = kreg1; *(LAS u32x4*)(lds + AL_V0 + vdst) = vreg;
    __syncthreads();
    AttnSt st; attn_init(st);
    const int qrel = wid * 32 + r32;
#pragma unroll 1
    for (int t = 0; t < NT; ++t) {
        const int cur = t & 1;
        const bool more = (t + 1 < NT);
        if (more) { const size_t ro = (size_t)(t + 1) * 64;
            kreg0 = *(const GAS u32x4*)(ksrc + ro * kpitch); if (k2) kreg1 = *(const GAS u32x4*)(ksrc + ro * kpitch + 64); vreg = *(const GAS u32x4*)(vsrc + ro * vpitch); }
        const int jb = t - (NT - 4);
        const int allowed = (jb >= 0) ? 1 : (int)((selmask >> (t >> 2)) & 1u);
        const bool active = (jb >= 0) ? (64 * jb <= 32 * wid + 31) : (__any(allowed) != 0);
        if (active) {
            const lds_cptr Kb = (lds_cptr)(lds + (cur ? AL_K1 : AL_K0)), Vb = (lds_cptr)(lds + (cur ? AL_V1 : AL_V0));
            f32x16 p0, p1;
            qk_tile<DK>(p0, p1, Kb, qr, r32, hi);
            if (jb >= 0) {
#pragma unroll
                for (int r = 0; r < 16; ++r) { const int kv = 64 * jb + crow(r, hi); p0[r] = (kv > qrel) ? NEG_BIG : p0[r]; p1[r] = (kv + 32 > qrel) ? NEG_BIG : p1[r]; }
            } else if (moba) {
#pragma unroll
                for (int r = 0; r < 16; ++r) { p0[r] = allowed ? p0[r] : NEG_BIG; p1[r] = allowed ? p1[r] : NEG_BIG; }
            }
            u32x4 pw[4];
            softmax_step(p0, p1, st, wsf, r32, hi, pw);
            pv_tile(st, Vb, pw, lane);
        }
        if (more) { const int kb = cur ? AL_K0 : AL_K1, vb = cur ? AL_V0 : AL_V1;
            *(LAS u32x4*)(lds + kb + kdst) = kreg0; if (k2) *(LAS u32x4*)(lds + kb + kdst + 8192) = kreg1; *(LAS u32x4*)(lds + vb + vdst) = vreg; }
        __syncthreads();
    }
    float rli[16], lse2; attn_finish(st, wsf, r32, hi, rli, lse2);
    LAS bf16_t* stg = (LAS bf16_t*)(lds + AL_OST) + wid * 2048;
#pragma unroll
    for (int r = 0; r < 16; ++r) { const int orow = crow(r, hi); const unsigned w_ = cvtpk(st.o0[r] * rli[r], st.o1[r] * rli[r]); stg[orow * 64 + r32] = (bf16_t)(w_ & 0xffffu); stg[orow * 64 + 32 + r32] = (bf16_t)(w_ >> 16); }
#pragma unroll
    for (int i = 0; i < 4; ++i) { const int row = i * 8 + (lane >> 3), ch = lane & 7; const u32x4 v = *(const LAS u32x4*)(stg + row * 64 + ch * 8);
        *(GAS u32x4*)(Op + (size_t)(q0 + wid * 32 + row) * 1024 + ch * 8) = v; }
    __syncthreads();
}

__device__ __forceinline__ void attn_dilated_unit(Frame& F, const bf16_t* Qc, const bf16_t* Kc, const bf16_t* Vc, bf16_t* Op, int p0, float sc) {
    const int tid = F.tid, lane = F.lane, wid = F.wave, r32 = lane & 31, hi = lane >> 5;
    LAS unsigned char* lds = F.lds; LAS float* wsf = (LAS float*)(lds + AL_WSF) + wid * 64;
    LAS float* M = (LAS float*)(lds + AL_M); LAS float* ML = (LAS float*)(lds + AL_ML);
    LAS unsigned char* priv = lds + wid * 8192;
#pragma unroll 1
    for (int br = 0; br < 3; ++br) {
        const int dil = (br == 0) ? 1 : (br == 1 ? 4 : 16);
        int rrq, lq;
        if (br == 0) { rrq = 0; lq = p0 + 32 * wid + r32; }
        else if (br == 1) { rrq = wid >> 1; lq = (p0 >> 2) + 32 * (wid & 1) + r32; }
        else { rrq = 2 * wid + (r32 >> 4); lq = (p0 >> 4) + (r32 & 15); }
        const int qpos = lq * dil + rrq;
        bf16x8 qr[4];
        { const bf16_t* qrow = Qc + (size_t)qpos * 384 + 8 * hi;
#pragma unroll
          for (int d0 = 0; d0 < 4; ++d0) qr[d0] = *(const GAS bf16x8*)(qrow + 16 * d0); }
        AttnSt st; attn_init(st);
        const int nsteps = (br == 2) ? 6 : 3;
#pragma unroll 1
        for (int s = 0; s < nsteps; ++s) {
            int tres, lf;
            if (br == 0) { tres = 0; lf = p0 - 128 + 64 * ((wid >> 1) + s); }
            else if (br == 1) { tres = wid >> 1; lf = (p0 >> 2) - 128 + 64 * s; }
            else { tres = 2 * wid + (s >= 3 ? 1 : 0); lf = (p0 >> 4) - 128 + 64 * (s >= 3 ? s - 3 : s); }
            int kpos = (lf + lane) * dil + tres; kpos = kpos < 0 ? 0 : (kpos > SEQ - 1 ? SEQ - 1 : kpos);
            const bf16_t* krow = Kc + (size_t)kpos * 384; const bf16_t* vrow = Vc + (size_t)kpos * 384;
            u32x4 vv[8];
            { u32x4 kk[8];
#pragma unroll
              for (int c = 0; c < 8; ++c) kk[c] = *(const GAS u32x4*)(krow + 8 * c);
#pragma unroll
              for (int c = 0; c < 8; ++c) *(LAS u32x4*)(priv + c * 1024 + lane * 16) = kk[c]; }
            asm volatile("" ::: "memory");
#pragma unroll
            for (int c = 0; c < 8; ++c) vv[c] = *(const GAS u32x4*)(vrow + 8 * c);
            f32x16 p0s, p1s;
            qk_tile<64>(p0s, p1s, (lds_cptr)priv, qr, r32, hi);
            const bool resok = (tres == rrq);
#pragma unroll
            for (int r = 0; r < 16; ++r) {
                const int lk0 = lf + crow(r, hi), lk1 = lk0 + 32; const int d0_ = lq - lk0, d1_ = lq - lk1;
                const bool ok0 = resok && (lk0 >= 0) && (d0_ >= 0) && (d0_ <= 128), ok1 = resok && (lk1 >= 0) && (d1_ >= 0) && (d1_ <= 128);
                p0s[r] = ok0 ? p0s[r] : NEG_BIG; p1s[r] = ok1 ? p1s[r] : NEG_BIG; }
            u32x4 pw[4];
            softmax_step(p0s, p1s, st, wsf, r32, hi, pw);
            asm volatile("" ::: "memory");
#pragma unroll
            for (int c = 0; c < 8; ++c) *(LAS u32x4*)(priv + (c >> 2) * 4096 + lane * 64 + (c & 3) * 16) = vv[c];
            asm volatile("" ::: "memory");
            pv_tile(st, (lds_cptr)priv, pw, lane);
            asm volatile("" ::: "memory");
        }
        float rli[16], lse2; attn_finish(st, wsf, r32, hi, rli, lse2);
#define PROW(q) ((br == 0) ? (32 * wid + (q)) : (br == 1) ? (4 * (32 * (wid & 1) + (q)) + (wid >> 1)) : (16 * ((q) & 15) + 2 * wid + ((q) >> 4)))
        if (br == 0) {
#pragma unroll
            for (int r = 0; r < 16; ++r) { const int row = PROW(crow(r, hi)); M[row * 64 + r32] = st.o0[r] * rli[r]; M[row * 64 + 32 + r32] = st.o1[r] * rli[r]; }
            if (hi == 0) ML[PROW(r32)] = lse2;
        } else {
            if (hi == 0) wsf[r32] = lse2;
#pragma unroll
            for (int r = 0; r < 16; ++r) { const int q = crow(r, hi), row = PROW(q); const float lb = wsf[q], la = ML[row]; const float mx = __builtin_fmaxf(la, lb);
                const float wa = __builtin_amdgcn_exp2f(la - mx), wb = __builtin_amdgcn_exp2f(lb - mx), inv = __builtin_amdgcn_rcpf(wa + wb);
                M[row * 64 + r32] = (wa * M[row * 64 + r32] + wb * (st.o0[r] * rli[r])) * inv; M[row * 64 + 32 + r32] = (wa * M[row * 64 + 32 + r32] + wb * (st.o1[r] * rli[r])) * inv; }
            if (hi == 0) { const int row = PROW(r32); const float la = ML[row], lb = lse2, mx = __builtin_fmaxf(la, lb);
                ML[row] = mx + __builtin_amdgcn_logf(__builtin_amdgcn_exp2f(la - mx) + __builtin_amdgcn_exp2f(lb - mx)); }
        }
#undef PROW
        __syncthreads();
    }
    { const int row = tid >> 1, half = tid & 1; const LAS float* mp = M + row * 64 + 32 * half; bf16_t* op = Op + (size_t)(p0 + row) * 1024 + 32 * half;
#pragma unroll
      for (int i = 0; i < 4; ++i) { const f32x4 a = *(const LAS f32x4*)(mp + 8 * i), b = *(const LAS f32x4*)(mp + 8 * i + 4); *(GAS u32x4*)(op + 8 * i) = pack8(a, b); } }
    __syncthreads();
}

__device__ __forceinline__ void p2_attention(Frame& F0, int l, int rep) {
    Frame& F = F0;
    unsigned char* ws = F.ws;
    const bf16_t* QKV = (const bf16_t*)(ws + WS_QKV); const bf16_t* QA = (const bf16_t*)(ws + WS_QA); const bf16_t* KA = (const bf16_t*)(ws + WS_KA); const bf16_t* VA = (const bf16_t*)(ws + WS_VA);
    bf16_t* O = (bf16_t*)(ws + WS_XB);
    const float* KM = (const float*)(F.ctl + CW_KMEAN) + (size_t)l * (8 * 6 * 16 * 64);
    unsigned* queue = (unsigned*)(F.ctl + CW_QUEUE + 64 * (l + 2 * rep));
    for (;;) {
        __syncthreads();
        if (F.tid == 0) F.LC[LC_BCAST] = atomicAdd(queue, 1u);
        __syncthreads();
        const int u = __builtin_amdgcn_readfirstlane((int)F.LC[LC_BCAST]);
        if (u >= 2048) break;
        Frame Fu = F0; { int t_ = F0.tid; asm volatile("" : "+v"(t_)); Fu.tid = t_; Fu.lane = t_ & 63; Fu.wave = __builtin_amdgcn_readfirstlane(t_ >> 6); }
        Frame& F = Fu;
        if (u < 1280) {
            const int c = 15 - u / 80, v = u % 80;
            if (v < 32) { const int b = v >> 2, h = v & 3; const size_t rb = (size_t)b * SEQ;
                attn_shared_unit<96>(F, QA + rb * 384 + h * 96, 384, KA + rb * 384 + h * 96, 384, VA + rb * 256 + h * 64, 256, O + rb * 1024 + h * 64,
                                     256 * c, 4 * (c + 1), 1.0f, false, nullptr);
            } else { const int bh = v - 32, b = bh / 6, h = bh % 6; const size_t rb = (size_t)b * SEQ;
                attn_shared_unit<64>(F, QKV + rb * 384 + h * 64, 384, QKV + SEG_ELEMS + rb * 384 + h * 64, 384, QKV + 2 * SEG_ELEMS + rb * 384 + h * 64, 384, O + rb * 1024 + 256 + h * 64,
                                     256 * c, 4 * (c + 1), 0.125f * LOG2E, true, KM + (size_t)(b * 6 + h) * 16 * 64);
            }
        } else {
            const int v = u - 1280, bh = v >> 4, b = bh / 6, h = bh % 6, pb = v & 15; const size_t rb = (size_t)b * SEQ;
            attn_dilated_unit(F, QKV + 3 * SEG_ELEMS + rb * 384 + h * 64, QKV + 4 * SEG_ELEMS + rb * 384 + h * 64, QKV + 5 * SEG_ELEMS + rb * 384 + h * 64,
                              O + rb * 1024 + 640 + h * 64, 256 * pb, 0.125f * LOG2E);
        }
    }
}

__device__ __forceinline__ void p4_router(Frame& F, const Args& a, int l, int rep) {
    unsigned char* ws = F.ws;
    const float* y1 = a.out;
    const bf16_t* RWh = (const bf16_t*)(ws + WS_RW) + (size_t)(l * 2) * 65536; const bf16_t* RWl = RWh + 65536;
    const float* PS = (const float*)(ws + WS_PS);
    unsigned* cnt = (unsigned*)(F.ctl + CW_CNT + 4096 * (l + 2 * rep));
    int* tokslot = (int*)(ws + (rep ? WS_H : WS_TOKSLOT)); float* gate = (float*)(ws + (rep ? WS_H + 8 * MiB : WS_GATE));
    bf16_t* x1b = (bf16_t*)(ws + WS_XB); float* stats = (float*)(ws + WS_STATS);
    const float* g1 = a.ln1_g + l * 1024; const float* b1 = a.ln1_b + l * 1024;
    const int lane = F.lane, wave = F.wave, r32 = lane & 31, hi = lane >> 5, pr = wave >> 1, half = wave & 1;
    LAS unsigned char* wl = F.lds + wave * 9472;
    LAS bf16_t* hiT = (LAS bf16_t*)wl; LAS bf16_t* loT = (LAS bf16_t*)(wl + 4608); LAS f32x2* stT = (LAS f32x2*)(wl + 9216);
    LAS float* xch = (LAS float*)(F.lds + 81920 + pr * 8192);
    LAS float* rbias = (LAS float*)(F.lds + 120000);
    if (F.tid < 64) rbias[F.tid] = a.router_b[F.tid];
    __syncthreads();
    const int rsub = lane >> 4, c4 = (lane & 15) * 4;
    for (int it = F.vcu * 4 + pr; it < T / 32; it += F.G * 4) {
        const size_t t0 = (size_t)it * 32;
        if (lane < 32) { const float* ps = PS + (t0 + lane) * 32; float s = 0.f, q = 0.f;
#pragma unroll
            for (int i = 0; i < 8; ++i) { const f32x4 v = *(const GAS f32x4*)(ps + 4 * i); s += v[0] + v[2]; q += v[1] + v[3]; }
            const float mu = s * (1.0f / 1024.0f); const float var = __builtin_fmaxf(q * (1.0f / 1024.0f) - mu * mu, 0.f); const float rstd = 1.0f / sqrtf(var + LN_EPS);
            stT[lane] = (f32x2){mu, rstd};
            if (half == 0) *(GAS f32x2*)(stats + 2 * (t0 + lane)) = (f32x2){mu, rstd}; }
        f32x2 st8[8];
#pragma unroll
        for (int i = 0; i < 8; ++i) st8[i] = stT[4 * i + rsub];
        const int cb = half * 512;
        const float* ybase = y1 + (t0 + rsub) * 1024 + cb + c4;
        f32x4 ycur[8], ynext[8];
#pragma unroll
        for (int i = 0; i < 8; ++i) ycur[i] = *(const GAS f32x4*)(ybase + (size_t)(4 * i) * 1024);
        f32x16 a0 = {}, a1 = {};
        const bf16_t* wh = RWh + (size_t)r32 * 1024 + cb + 8 * hi; const bf16_t* wlp = RWl + (size_t)r32 * 1024 + cb + 8 * hi;
#pragma unroll 1
        for (int c = 0; c < 8; ++c) {
            if (c + 1 < 8) {
#pragma unroll
                for (int i = 0; i < 8; ++i) ynext[i] = *(const GAS f32x4*)(ybase + (size_t)(4 * i) * 1024 + 64 * (c + 1)); }
            const f32x4 gv = *(const GAS f32x4*)(g1 + cb + 64 * c + c4), bv = *(const GAS f32x4*)(b1 + cb + 64 * c + c4);
#pragma unroll
            for (int i = 0; i < 8; ++i) { const int row = 4 * i + rsub; const f32x4 xv = (ycur[i] - st8[i][0]) * st8[i][1] * gv + bv;
                *(GAS u32x2*)(x1b + (t0 + row) * 1024 + cb + 64 * c + c4) = pack4(xv);
                unsigned h[4], lo[4];
#pragma unroll
                for (int q = 0; q < 4; ++q) { h[q] = f2bf(xv[q]); lo[q] = f2bf(xv[q] - __builtin_bit_cast(float, h[q] << 16)); }
                *(LAS u32x2*)(hiT + row * 72 + c4) = (u32x2){h[0] | (h[1] << 16), h[2] | (h[3] << 16)};
                *(LAS u32x2*)(loT + row * 72 + c4) = (u32x2){lo[0] | (lo[1] << 16), lo[2] | (lo[3] << 16)}; }
            asm volatile("" ::: "memory");
            bf16x8 yh[4], yl[4];
#pragma unroll
            for (int ks = 0; ks < 4; ++ks) { yh[ks] = *(const LAS bf16x8*)(hiT + r32 * 72 + 16 * ks + 8 * hi); yl[ks] = *(const LAS bf16x8*)(loT + r32 * 72 + 16 * ks + 8 * hi); }
            asm volatile("s_waitcnt lgkmcnt(0)" ::: "memory");
#pragma unroll
            for (int ks = 0; ks < 4; ++ks) {
                const int ko = 64 * c + 16 * ks;
                const bf16x8 h0 = *(const GAS bf16x8*)(wh + ko), h1 = *(const GAS bf16x8*)(wh + 32 * 1024 + ko);
                const bf16x8 l0 = *(const GAS bf16x8*)(wlp + ko), l1 = *(const GAS bf16x8*)(wlp + 32 * 1024 + ko);
                a0 = MFMA32(h0, yh[ks], a0); a0 = MFMA32(h0, yl[ks], a0); a0 = MFMA32(l0, yh[ks], a0);
                a1 = MFMA32(h1, yh[ks], a1); a1 = MFMA32(h1, yl[ks], a1); a1 = MFMA32(l1, yh[ks], a1); }
#pragma unroll
            for (int i = 0; i < 8; ++i) ycur[i] = ynext[i];
        }
        if (half == 1) {
#pragma unroll
            for (int r = 0; r < 16; ++r) { xch[r * 64 + lane] = a0[r]; xch[(16 + r) * 64 + lane] = a1[r]; } }
        __syncthreads();
        if (half == 0) {
#pragma unroll
            for (int r = 0; r < 16; ++r) { a0[r] += xch[r * 64 + lane]; a1[r] += xch[(16 + r) * 64 + lane]; }
            const size_t tok = t0 + r32;
            float bestg = -3e38f, bs1 = 0.f, bs2 = 0.f; int be1 = 0, be2 = 1;
#pragma unroll
            for (int gi = 0; gi < 8; ++gi) {
                const int blk = gi >> 2, q = gi & 3;
                float B1 = -3e38f, B2 = -3e38f, S1 = 0.f, S2 = 0.f; int I1 = 0, I2 = 0;
#pragma unroll
                for (int j = 0; j < 4; ++j) {
                    const int e = 32 * blk + 8 * q + 4 * hi + j;
                    const float logit = (blk == 0) ? a0[4 * q + j] : a1[4 * q + j];
                    const float s = 1.0f / (1.0f + __expf(-logit)); const float sb = s + rbias[e];
                    const int idx = 4 * hi + j;
                    if (sb > B1) { B2 = B1; S2 = S1; I2 = I1; B1 = sb; S1 = s; I1 = idx; } else if (sb > B2) { B2 = sb; S2 = s; I2 = idx; }
                }
                const float pB1 = xhalf(B1), pB2 = xhalf(B2), pS1 = xhalf(S1), pS2 = xhalf(S2); const int pI1 = __builtin_bit_cast(int, xhalf(__builtin_bit_cast(float, I1))), pI2 = __builtin_bit_cast(int, xhalf(__builtin_bit_cast(float, I2)));
                const bool mine_first = (B1 > pB1) || (B1 == pB1 && I1 < pI1);
                float T1, T2, U1, U2; int J1, J2;
                if (mine_first) { T1 = B1; U1 = S1; J1 = I1; const bool sec_mine = (B2 > pB1) || (B2 == pB1 && I2 < pI1); if (sec_mine) { T2 = B2; U2 = S2; J2 = I2; } else { T2 = pB1; U2 = pS1; J2 = pI1; } }
                else { T1 = pB1; U1 = pS1; J1 = pI1; const bool sec_p = (pB2 > B1) || (pB2 == B1 && pI2 < I1); if (sec_p) { T2 = pB2; U2 = pS2; J2 = pI2; } else { T2 = B1; U2 = S1; J2 = I1; } }
                const float gs = T1 + T2;
                if (gs > bestg) { bestg = gs; bs1 = U1; bs2 = U2; be1 = 8 * gi + J1; be2 = 8 * gi + J2; }
            }
            const float ginv = 1.0f / (bs1 + bs2);
            if (hi == 0) {
                const unsigned s1 = atomicAdd(cnt + 64 * be1, 1u), s2 = atomicAdd(cnt + 64 * be2, 1u);
                const size_t i1 = (size_t)be1 * CAP + s1, i2 = (size_t)be2 * CAP + s2;
                tokslot[i1] = (int)(2 * tok); gate[i1] = bs1 * ginv; tokslot[i2] = (int)(2 * tok + 1); gate[i2] = bs2 * ginv;
            }
        }
        __syncthreads();
    }
}

__device__ __forceinline__ void p7_ln2(Frame& F, const Args& a, int l, bool dummy) {
    unsigned char* ws = F.ws;
    float* y1 = a.out; const float* stats = (const float*)(ws + WS_STATS); const bf16_t* Y = (const bf16_t*)(ws + WS_Y); bf16_t* xb = (bf16_t*)(ws + WS_XB);
    const float* g1 = a.ln1_g + l * 1024; const float* b1 = a.ln1_b + l * 1024; const float* g2 = a.ln2_g + l * 1024; const float* b2 = a.ln2_b + l * 1024;
    const int gw = F.vcu * NWAVES + F.wave, NGW = F.G * NWAVES, lane = F.lane;
    f32x4 g1v[4], b1v[4], g2v[4], b2v[4];
#pragma unroll
    for (int j = 0; j < 4; ++j) { const int c = 4 * lane + 256 * j; g1v[j] = *(const GAS f32x4*)(g1 + c); b1v[j] = *(const GAS f32x4*)(b1 + c); g2v[j] = *(const GAS f32x4*)(g2 + c); b2v[j] = *(const GAS f32x4*)(b2 + c); }
    for (int row = gw; row < T; row += NGW) {
        const f32x2 st = *(const GAS f32x2*)(stats + 2 * (size_t)row);
        f32x4 z[4]; float s = 0.f;
#pragma unroll
        for (int j = 0; j < 4; ++j) { const int c = 4 * lane + 256 * j;
            const f32x4 yv = *(const GAS f32x4*)(y1 + (size_t)row * 1024 + c);
            const u32x2 e0 = *(const GAS u32x2*)(Y + (size_t)(2 * row) * 1024 + c), e1 = *(const GAS u32x2*)(Y + (size_t)(2 * row + 1) * 1024 + c);
            const f32x4 x1 = (yv - st[0]) * st[1] * g1v[j] + b1v[j];
            const f32x4 f0 = {bflo(e0.x), bfhi(e0.x), bflo(e0.y), bfhi(e0.y)}, f1 = {bflo(e1.x), bfhi(e1.x), bflo(e1.y), bfhi(e1.y)};
            z[j] = x1 * ALPHA + f0 + f1; s += (z[j][0] + z[j][1]) + (z[j][2] + z[j][3]); }
        const float mean = wave_sum(s) * (1.0f / 1024.0f); float s2 = 0.f;
#pragma unroll
        for (int j = 0; j < 4; ++j) { z[j] = z[j] - mean; s2 += (z[j][0] * z[j][0] + z[j][1] * z[j][1]) + (z[j][2] * z[j][2] + z[j][3] * z[j][3]); }
        const float rstd = 1.0f / sqrtf(wave_sum(s2) * (1.0f / 1024.0f) + LN_EPS);
#pragma unroll
        for (int j = 0; j < 4; ++j) { const int c = 4 * lane + 256 * j; const f32x4 o = z[j] * rstd * g2v[j] + b2v[j];
            if (!dummy) { *(GAS f32x4*)(y1 + (size_t)row * 1024 + c) = o; *(GAS u32x2*)(xb + (size_t)row * 1024 + c) = pack4(o); } }
    }
}
#ifndef REPEAT_K
#define REPEAT_K -1
#endif
#ifndef REPEAT_N
#define REPEAT_N 1
#endif

constexpr int N_PHASES = 1 + 8 * DEPTH;
#ifndef MK_N_LAUNCHES
#define MK_N_LAUNCHES 1
#endif

__device__ __forceinline__ void moe_tables(Frame& F, int l) {
    const unsigned* cntg = (const unsigned*)(F.ctl + CW_CNT + 4096 * l);
    if (F.tid < 64) F.LC[LC_CNT + F.tid] = __hip_atomic_load(cntg + 64 * F.tid, RLX_AGENT);
    __syncthreads();
    if (F.tid == 0) { unsigned run = 0; for (int e = 0; e < 64; ++e) { F.LC[LC_TB + e] = run; run += (F.LC[LC_CNT + e] + 255u) >> 8; } F.LC[LC_TB + 64] = run; }
    __syncthreads();
}

__global__ void __launch_bounds__(NTHREADS, 2) mega_fwd(Args a_in) {
    extern __shared__ __attribute__((aligned(16))) unsigned char lds_raw[];
    Frame F;
    F.lds = (LAS unsigned char*)lds_raw;
    F.LC = (volatile LAS unsigned*)(F.lds + LDSCTL_OFF);
    F.ws = a_in.ws; F.ctl = (gu32*)(a_in.ws + WS_CTL);
    F.tid = threadIdx.x; F.lane = F.tid & 63; F.wave = __builtin_amdgcn_readfirstlane(F.tid >> 6);
    F.G = gridDim.x; { const int bx = blockIdx.x; F.vcu = (F.G % 8 == 0) ? (bx % 8) * (F.G / 8) + bx / 8 : bx; }
    for (int u = F.tid; u < (LDS_BYTES - LDSCTL_OFF) / 4; u += NTHREADS) F.LC[u] = 0u;
    __syncthreads();
    XcdBarrier bar; bar.bar = (unsigned*)(F.ctl + CW_BAR); bar.x = 0; bar.st = nullptr;
    if (MK_N_LAUNCHES == 1) bar = xcd_barrier_post((unsigned*)(F.ctl + CW_BAR), F.LC + LC_BAR, F.tid == 0);
    const int lo = a_in.ph_lo, hi = a_in.ph_hi;
    const int wave_sgpr = __builtin_amdgcn_readfirstlane((int)threadIdx.x >> 6);
#define LAUNDER(p) asm volatile("" : "+s"(p))
    int ph = lo, rep = 0; bool first = true;
    while (ph < hi) {
        if (!first) { int ln0_; asm volatile("v_mbcnt_lo_u32_b32 %0, -1, 0\n\tv_mbcnt_hi_u32_b32 %0, -1, %0" : "=v"(ln0_)); xcd_barrier(bar, wave_sgpr == 0 && ln0_ == 0); }
        first = false;
        Args a = a_in;
        LAUNDER(a.x); LAUNDER(a.w_in); LAUNDER(a.q_norm); LAUNDER(a.w_uq); LAUNDER(a.kv_norm); LAUNDER(a.w_ukv); LAUNDER(a.w_out); LAUNDER(a.ln1_g); LAUNDER(a.ln1_b);
        LAUNDER(a.router_w); LAUNDER(a.router_b); LAUNDER(a.w1); LAUNDER(a.w3); LAUNDER(a.w2); LAUNDER(a.ln2_g); LAUNDER(a.ln2_b); LAUNDER(a.out); LAUNDER(a.ws);
        unsigned char* ws = a.ws; F.ws = ws; F.ctl = (gu32*)(ws + WS_CTL);
        { int ln_; asm volatile("v_mbcnt_lo_u32_b32 %0, -1, 0\n\tv_mbcnt_hi_u32_b32 %0, -1, %0" : "=v"(ln_)); int w_ = wave_sgpr; LAUNDER(w_); F.tid = w_ * 64 + ln_; F.lane = ln_; F.wave = w_; }
        const int l = (ph - 1) >> 3, k = (ph == 0) ? 8 : ((ph - 1) & 7);
        if (k == 8) {
            p0_prologue(F, a);
        } else if (k == 0) {
            pg8::StaticOrder S; S.init(T, N_INP, F.G, (int)blockIdx.x);
            EpiP1 E{(bf16_t*)(ws + WS_CQ), (bf16_t*)(ws + WS_CKV), (bf16_t*)(ws + WS_KR), (bf16_t*)(ws + WS_QKV), (const f32x2*)(ws + WS_T64), (const f32x2*)(ws + WS_T32),
                    (float*)(F.ctl + CW_KMEAN) + (size_t)l * (8 * 6 * 16 * 64)};
            pg8::gemm_phase<EpiP1, pg8::StaticOrder, true, true>(F.tid, F.lds, (const bf16_t*)(ws + WS_XB), (const bf16_t*)(ws + WS_WIN + (size_t)l * WIN_L), DM, S, E);
        } else if (k == 1) {
            p1b_mla(F, l);
        } else if (k == 2) {
            p2_attention(F, l, rep);
        } else if (k == 3) {
            pg8::StaticOrder S; S.init(T, DM, F.G, (int)blockIdx.x);
            EpiP3 E{l == 0 ? a.x : (const float*)a.out, a.out, (float*)(ws + WS_PS)};
            pg8::gemm_phase<EpiP3, pg8::StaticOrder, true, true>(F.tid, F.lds, (const bf16_t*)(ws + WS_XB), (const bf16_t*)(ws + WS_WOUT) + (size_t)l * DM * DM, DM, S, E);
        } else if (k == 4) {
            p4_router(F, a, l, rep);
        } else if (k == 5) {
            moe_tables(F, l);
            const LAS int* tb = (const LAS int*)(F.lds + LDSCTL_OFF) + LC_TB; const LAS int* cn = (const LAS int*)(F.lds + LDSCTL_OFF) + LC_CNT;
            MoeSched S{tb, cn, (const int*)(ws + WS_TOKSLOT), 2, F.G, (int)blockIdx.x, tb[64], true};
            EpiP5 E{(bf16_t*)(ws + WS_H)};
            pg8::gemm_phase<EpiP5, MoeSched, true, true>(F.tid, F.lds, (const bf16_t*)(ws + WS_XB), (const bf16_t*)(ws + WS_MOE + (size_t)l * MOE_L), DM, S, E);
        } else if (k == 6) {
            moe_tables(F, l);
            const LAS int* tb = (const LAS int*)(F.lds + LDSCTL_OFF) + LC_TB; const LAS int* cn = (const LAS int*)(F.lds + LDSCTL_OFF) + LC_CNT;
            MoeSched S{tb, cn, (const int*)(ws + WS_TOKSLOT), 4, F.G, (int)blockIdx.x, tb[64], false};
            EpiP6 E{(bf16_t*)(ws + WS_Y), tb, cn, (const int*)(ws + WS_TOKSLOT), (const float*)(ws + WS_GATE)};
            pg8::gemm_phase<EpiP6, MoeSched, true, true>(F.tid, F.lds, (const bf16_t*)(ws + WS_H), (const bf16_t*)(ws + WS_MOE + (size_t)l * MOE_L + 64 * MiB), DEXP, S, E);
        } else {
            p7_ln2(F, a, l, (REPEAT_K == 7) && rep == 0);
        }
        const int nrep = (REPEAT_K >= 0 && k == REPEAT_K && (REPEAT_K != 3 || l == 0)) ? 1 + REPEAT_N : 1;
        if (++rep >= nrep) { rep = 0; ++ph; }
    }
}

extern "C" void kernel_launch(void* const* d_in, const int* in_sizes, int n_in, void* d_out, int out_size, void* d_ws, size_t ws_size, hipStream_t stream) {
    static int grid = 0;
    if (grid == 0) {
        if (n_in != 16 || out_size != T * DM || ws_size < WS_END) { fprintf(stderr, "kernel_launch: unexpected shapes (n_in %d out %d ws %zu need %zu)\n", n_in, out_size, ws_size, (size_t)WS_END); grid = -1; return; }
        int dev = 0, cus = 0, per_cu = 0;
        if (hipGetDevice(&dev) != hipSuccess || hipDeviceGetAttribute(&cus, hipDeviceAttributeMultiprocessorCount, dev) != hipSuccess) { grid = -1; return; }
        if (hipFuncSetAttribute((const void*)mega_fwd, hipFuncAttributeMaxDynamicSharedMemorySize, LDS_BYTES) != hipSuccess) { grid = -1; return; }
        if (hipOccupancyMaxActiveBlocksPerMultiprocessor(&per_cu, (const void*)mega_fwd, NTHREADS, LDS_BYTES) != hipSuccess || per_cu < 1) { fprintf(stderr, "kernel_launch: occupancy query says %d blocks/CU\n", per_cu); per_cu = 1; }
        (void)hipGetLastError();
        grid = cus;
    }
    if (grid < 0) return;
    if (hipMemsetAsync((char*)d_ws + WS_CTL, 0, CTL_BYTES, stream) != hipSuccess) return;
    Args a{};
    a.x = (const float*)d_in[0]; a.w_in = (const float*)d_in[1]; a.q_norm = (const float*)d_in[2]; a.w_uq = (const float*)d_in[3]; a.kv_norm = (const float*)d_in[4];
    a.w_ukv = (const float*)d_in[5]; a.w_out = (const float*)d_in[6]; a.ln1_g = (const float*)d_in[7]; a.ln1_b = (const float*)d_in[8]; a.router_w = (const float*)d_in[9];
    a.router_b = (const float*)d_in[10]; a.w1 = (const float*)d_in[11]; a.w3 = (const float*)d_in[12]; a.w2 = (const float*)d_in[13]; a.ln2_g = (const float*)d_in[14]; a.ln2_b = (const float*)d_in[15];
    a.out = (float*)d_out; a.ws = (unsigned char*)d_ws;
#if MK_N_LAUNCHES == 1
    a.ph_lo = 0; a.ph_hi = N_PHASES;
    hipLaunchKernelGGL(mega_fwd, dim3(grid), dim3(NTHREADS), LDS_BYTES, stream, a);
#else
    for (int ph = 0; ph < N_PHASES; ++ph) { a.ph_lo = ph; a.ph_hi = ph + 1; hipLaunchKernelGGL(mega_fwd, dim3(grid), dim3(NTHREADS), LDS_BYTES, stream, a); }
#endif
}
```

```cpp
#include <hip/hip_runtime.h>
#ifndef REPEAT_K
#define REPEAT_K -1
#endif
#ifndef REPEAT_N
#define REPEAT_N 1
#endif
#ifndef ABL
#define ABL 0
#endif
#ifndef PROBE_ATT
#define PROBE_ATT 7
#endif
#include <cstdio>
#include <cstdint>

#define LAS __attribute__((address_space(3)))
#define GAS __attribute__((address_space(1)))
typedef unsigned short bf16_t;
typedef short bf16x8 __attribute__((ext_vector_type(8)));
typedef short s16x4 __attribute__((ext_vector_type(4)));
typedef float f32x2 __attribute__((ext_vector_type(2)));
typedef float f32x4 __attribute__((ext_vector_type(4)));
typedef float f32x16 __attribute__((ext_vector_type(16)));
typedef unsigned u32x2 __attribute__((ext_vector_type(2)));
typedef unsigned u32x4 __attribute__((ext_vector_type(4)));
typedef GAS unsigned gu32;

constexpr int BATCH = 8, SEQ = 4096, DM = 1024, T = BATCH * SEQ, DEPTH = 2;
constexpr int N_IN = 2720, N_INP = 2816;
constexpr int NEXP = 64, DEXP = 256, CAP = T;
constexpr float ALPHA = 1.4142135623730951f;
constexpr float LN_EPS = 1e-5f, RMS_EPS = 1e-6f;
constexpr float LOG2E = 1.4426950408889634f;
constexpr int NWAVES = 8, NTHREADS = 512;

constexpr size_t MiB = 1u << 20;
constexpr size_t WS_CTL = 0, CTL_BYTES = 2 * MiB;
constexpr size_t WS_T64 = 2 * MiB;
constexpr size_t WS_T32 = 3 * MiB;
constexpr size_t WS_GB = 3 * MiB + 512 * 1024;
constexpr size_t WS_WIN = 4 * MiB;
constexpr size_t WIN_L = (size_t)N_INP * DM * 2;
constexpr size_t WS_WOUT = 15 * MiB;
constexpr size_t WS_WUQ = 19 * MiB;
constexpr size_t WS_WUKV = 19 * MiB + 512 * 1024;
constexpr size_t WS_RW = 20 * MiB;
constexpr size_t WS_STATS = 21 * MiB;
constexpr size_t WS_PS = 528 * MiB;
constexpr size_t WS_TOKSLOT = 22 * MiB;
constexpr size_t WS_GATE = 30 * MiB;
constexpr size_t WS_XB = 38 * MiB;
constexpr size_t WS_A = 102 * MiB;
constexpr size_t WS_QKV = WS_A;
constexpr size_t SEG_ELEMS = (size_t)T * 384;
constexpr size_t WS_QA = WS_A + 144 * MiB;
constexpr size_t WS_KA = WS_A + 168 * MiB;
constexpr size_t WS_VA = WS_A + 192 * MiB;
constexpr size_t WS_CQ = WS_A + 208 * MiB;
constexpr size_t WS_CKV = WS_A + 224 * MiB;
constexpr size_t WS_KR = WS_A + 232 * MiB;
constexpr size_t WS_Y = WS_A;
constexpr size_t WS_H = WS_A + 144 * MiB;
constexpr size_t WS_MOE = 336 * MiB;
constexpr size_t MOE_L = 96 * MiB;
constexpr size_t WS_END = WS_MOE + 2 * MOE_L + 4 * MiB;
constexpr int CW_BAR = 4096;
constexpr int CW_QUEUE = 8192;
constexpr int CW_CNT = 16384;
constexpr int CW_KMEAN = 65536;
constexpr int CW_MOBA = 196608;
static_assert((CW_MOBA + 2 * 768 * 64) * 4 <= (int)CTL_BYTES, "ctl");
constexpr int MOBA_CAP = 3840;
constexpr size_t WS_MLIST = WS_TOKSLOT;

constexpr int LDS_BYTES = 147456;
constexpr int LDSCTL_OFF = 146432;
constexpr int LC_BAR = 0, LC_BCAST = 2, LC_TB = 16, LC_CNT = 96;

__device__ const float INV64[32] = {1.000000000e+00f, 7.498942614e-01f, 5.623413324e-01f, 4.216965139e-01f, 3.162277639e-01f, 2.371373773e-01f, 1.778279394e-01f, 1.333521307e-01f, 1.000000015e-01f, 7.498941571e-02f, 5.623413250e-02f, 4.216965288e-02f, 3.162277490e-02f, 2.371373773e-02f, 1.778279431e-02f, 1.333521493e-02f, 9.999999776e-03f, 7.498941850e-03f, 5.623413250e-03f, 4.216964822e-03f, 3.162277630e-03f, 2.371373586e-03f, 1.778279431e-03f, 1.333521446e-03f, 1.000000047e-03f, 7.498942432e-04f, 5.623413017e-04f, 4.216965172e-04f, 3.162277571e-04f, 2.371373703e-04f, 1.778279402e-04f, 1.333521504e-04f};
__device__ const float INV32[16] = {1.000000000e+00f, 5.623413324e-01f, 3.162277639e-01f, 1.778279394e-01f, 1.000000015e-01f, 5.623413250e-02f, 3.162277490e-02f, 1.778279431e-02f, 9.999999776e-03f, 5.623413250e-03f, 3.162277630e-03f, 1.778279431e-03f, 1.000000047e-03f, 5.623413017e-04f, 3.162277571e-04f, 1.778279402e-04f};

#define LDS_WAIT() asm volatile("s_waitcnt lgkmcnt(0)" ::: "memory")
#define VM_WAIT() asm volatile("s_waitcnt vmcnt(0)" ::: "memory")
#define RLX_AGENT __ATOMIC_RELAXED, __HIP_MEMORY_SCOPE_AGENT
__device__ __forceinline__ unsigned f2bf(float f) { unsigned u = __builtin_bit_cast(unsigned, f); return (u + 0x7fffu + ((u >> 16) & 1u)) >> 16; }
typedef __bf16 bf16x2_t __attribute__((ext_vector_type(2)));
__device__ __forceinline__ unsigned cvtpk(float lo, float hi) { f32x2 v = {lo, hi}; bf16x2_t b = __builtin_convertvector(v, bf16x2_t); return __builtin_bit_cast(unsigned, b); }
__device__ __forceinline__ unsigned pk2(float lo, float hi) { return cvtpk(lo, hi); }
__device__ __forceinline__ float bf2f(unsigned short b) { return __builtin_bit_cast(float, (unsigned)b << 16); }
__device__ __forceinline__ float bflo(unsigned w) { return __builtin_bit_cast(float, w << 16); }
__device__ __forceinline__ float bfhi(unsigned w) { return __builtin_bit_cast(float, w & 0xffff0000u); }
__device__ __forceinline__ int crow(int r, int hi) { return (r & 3) + 8 * (r >> 2) + 4 * hi; }
__device__ __forceinline__ int lane_now() { int l; asm volatile("v_mbcnt_lo_u32_b32 %0, -1, 0\n\tv_mbcnt_hi_u32_b32 %0, -1, %0" : "=v"(l)); return l; }
template <int MASK> __device__ __forceinline__ float swz_xor(float v) {
    return __uint_as_float((unsigned)__builtin_amdgcn_ds_swizzle((int)__float_as_uint(v), (MASK << 10) | 0x1f));
}
__device__ __forceinline__ float xsum32(float v) {
    const unsigned u = __float_as_uint(v); auto rr = __builtin_amdgcn_permlane32_swap(u, u, false, false); return __uint_as_float(rr[0]) + __uint_as_float(rr[1]);
}
__device__ __forceinline__ float wave_sum(float v) {
    v += swz_xor<1>(v); v += swz_xor<2>(v); v += swz_xor<4>(v); v += swz_xor<8>(v); v += swz_xor<16>(v);
    return xsum32(v);
}
__device__ __forceinline__ float xhalf(float v) {
    const unsigned u = __float_as_uint(v);
    auto rr = __builtin_amdgcn_permlane32_swap(u, u, false, false);
    return __uint_as_float(rr[0] ^ rr[1] ^ u);
}

namespace pg8 {
constexpr int BM = 256, BK = 64, HALF = 128, HTB = HALF * BK * 2, STAGE_BYTES = 8 * HTB, NXCD = 8, WGM = 8;
__host__ __device__ __forceinline__ int lds_byte(int r, int c) { const int st = (r >> 4) * 2 + (c >> 5), rr = r & 15, cc = c & 31, ob = rr * 64 + cc * 2; return st * 1024 + (ob ^ (((ob >> 9) & 1) << 5)); }
__host__ __device__ __forceinline__ void stage_rc(int b, int& R, int& C) { const int st = b / 1024, sb = b % 1024, swz = sb ^ (((sb >> 9) & 1) << 5); R = (st >> 1) * 16 + swz / 64; C = (st & 1) * 32 + (swz % 64) / 2; }
__host__ __device__ __forceinline__ int perm32(int rho) { const int n = rho >> 4, i = rho & 15; return 8 * (i >> 2) + 4 * n + (i & 3); }

struct Unit { int pm, pn; };

struct StaticOrder {
    int nM, nN, nwg, G, c;
    __device__ void init(int M, int N, int G_, int c_) { nM = M / BM; nN = N / BM; nwg = nM * nN; G = G_; c = c_; }
    __device__ bool next(int i, Unit& u) const {
        const long L = (long)i * G + c; if (L >= nwg) return false;
        int wgid = (int)L; { const int q = nwg / NXCD, r = nwg % NXCD, xcd = wgid % NXCD, off = wgid / NXCD; wgid = (xcd < r ? xcd * (q + 1) : r * (q + 1) + (xcd - r) * q) + off; }
        const int nig = WGM * nN, gid = wgid / nig, fm = gid * WGM, gsz = (nM - fm) < WGM ? (nM - fm) : WGM;
        u.pm = fm + ((wgid % nig) % gsz); u.pn = (wgid % nig) / gsz; return true;
    }
    __device__ __forceinline__ int a_row(const Unit& u, int r) const { return u.pm * BM + r; }
};

template <class Epi, class Sched, bool ALIGN_EPI, bool SP2>
__device__ __forceinline__ void gemm_phase(const int wid, LAS unsigned char* lds, const bf16_t* A, const bf16_t* Bt, const int K, const Sched& S, const Epi& E) {
    const int lane = lane_now(), tid = wid * 64 + lane, wr = wid >> 2, wc = wid & 3, fr = lane & 15, fq = lane >> 4;
    const int nt = K / BK;
    unsigned voffB[2];
#pragma unroll
    for (int i = 0; i < 2; ++i) { int R, C; stage_rc(tid * 16 + i * 8192, R, C); const int Rb = Epi::PERM ? ((R & ~31) + perm32(R & 31)) : R;
        voffB[i] = (unsigned)(Rb * K + C) * 2u; }
    const size_t kstep = (size_t)(BK * 2);
    const size_t hstep = (size_t)HALF * K * 2;
    const size_t tstep = 2 * hstep;
    const unsigned ldsw = (unsigned)wid * 1024u;
    const int aoff = lds_byte(wr * 64 + fr, fq * 8), boff = lds_byte(wc * 32 + fr, fq * 8);
#define PG8_SA(b, h) (((b) * 2 + (h)) * HTB)
#define PG8_SB(b, h) ((4 + (b) * 2 + (h)) * HTB)
#define PG8_STAGE(bufoff, gbase, voff) do { _Pragma("unroll") for (int _i = 0; _i < 2; ++_i) \
        __builtin_amdgcn_global_load_lds((const unsigned*)((const char*)(gbase) + (voff)[_i]), (LAS unsigned*)(lds + (bufoff) + ldsw + _i * 8192), 16, 0, 0); } while (0)
#define PG8_AVOFF(dst, u) do { const int _tid = wid * 64 + lane_now(); _Pragma("unroll") for (int _i = 0; _i < 2; ++_i) { int _R, _C; stage_rc(_tid * 16 + _i * 8192, _R, _C); _Pragma("unroll") for (int _h = 0; _h < 2; ++_h) \
        dst[_h][_i] = (unsigned)((unsigned)S.a_row(u, _h * HALF + _R) * (unsigned)K + (unsigned)_C) * 2u; } } while (0)
#define PG8_LDA(dst, b, h) do { _Pragma("unroll") for (int m = 0; m < 4; ++m) _Pragma("unroll") for (int k = 0; k < 2; ++k) dst[m][k] = *(const LAS bf16x8*)(lds + PG8_SA(b, h) + aoff + m * 2048 + k * 1024); } while (0)
#define PG8_LDB(dst, b, h) do { _Pragma("unroll") for (int n = 0; n < 2; ++n) _Pragma("unroll") for (int k = 0; k < 2; ++k) dst[n][k] = *(const LAS bf16x8*)(lds + PG8_SB(b, h) + boff + n * 2048 + k * 1024); } while (0)
#define PG8_MMA(ai, bj, At, Bt_) do { __builtin_amdgcn_s_setprio(1); _Pragma("unroll") for (int m = 0; m < 4; ++m) _Pragma("unroll") for (int n = 0; n < 2; ++n) _Pragma("unroll") for (int k = 0; k < 2; ++k) \
        acc[ai][bj][m][n] = __builtin_amdgcn_mfma_f32_16x16x32_bf16(Bt_[n][k], At[m][k], acc[ai][bj][m][n], 0, 0, 0); __builtin_amdgcn_s_setprio(0); } while (0)
#define PG8_WAIT_V(n) asm volatile("s_waitcnt vmcnt(" #n ")" ::: "memory")
#define PG8_WAIT_L(n) asm volatile("s_waitcnt lgkmcnt(" #n ")" ::: "memory")
#define PG8_BAR __builtin_amdgcn_s_barrier()
#define PG8_SCHED __builtin_amdgcn_sched_barrier(0)
    Unit cur, nxt; int ui = 0;
    if (!S.next(0, cur)) return;
    f32x4 acc[2][2][4][2];
#pragma unroll
    for (int a = 0; a < 2; ++a)
#pragma unroll
        for (int b = 0; b < 2; ++b)
#pragma unroll
            for (int m = 0; m < 4; ++m)
#pragma unroll
                for (int n = 0; n < 2; ++n) acc[a][b][m][n] = (f32x4){0.f, 0.f, 0.f, 0.f};
    bf16x8 At[4][2], B0[2][2], B1[2][2];
    unsigned vc[2][2], vn[2][2];
    PG8_AVOFF(vc, cur);
    const char* cB = (const char*)Bt + (size_t)cur.pn * tstep;
    const char* gA = (const char*)A;
    if constexpr (SP2) {
        PG8_STAGE(PG8_SB(0, 0), cB, voffB); PG8_STAGE(PG8_SB(0, 1), cB + hstep, voffB); PG8_STAGE(PG8_SA(0, 0), gA, vc[0]); PG8_STAGE(PG8_SA(0, 1), gA, vc[1]);
        if (wr == 1) PG8_BAR;
        PG8_WAIT_V(2); PG8_BAR;
        PG8_STAGE(PG8_SB(1, 0), cB + kstep, voffB); PG8_STAGE(PG8_SA(1, 0), gA + kstep, vc[0]); PG8_STAGE(PG8_SB(1, 1), cB + hstep + kstep, voffB);
        PG8_WAIT_V(6); PG8_BAR;
    } else {
        PG8_STAGE(PG8_SB(0, 0), cB, voffB); PG8_STAGE(PG8_SA(0, 0), gA, vc[0]); PG8_STAGE(PG8_SB(0, 1), cB + hstep, voffB); PG8_STAGE(PG8_SA(0, 1), gA, vc[1]);
        if (wr == 1) PG8_BAR;
        PG8_WAIT_V(4); PG8_BAR;
        PG8_STAGE(PG8_SB(1, 0), cB + kstep, voffB); PG8_STAGE(PG8_SA(1, 0), gA + kstep, vc[0]); PG8_STAGE(PG8_SB(1, 1), cB + hstep + kstep, voffB);
        PG8_WAIT_V(6); PG8_BAR;
    }
    for (;;) {
        const bool has_next = S.next(ui + 1, nxt);
        const char* nB = has_next ? (const char*)Bt + (size_t)nxt.pn * tstep : cB;
        for (int t = 0; t < nt; t += 2) {
            const bool last = (t == nt - 2);
            if (t == (nt >= 4 ? nt - 4 : 0)) {
                if (has_next) { PG8_AVOFF(vn, nxt); } else {
#pragma unroll
                    for (int h = 0; h < 2; ++h)
#pragma unroll
                        for (int i = 0; i < 2; ++i) vn[h][i] = vc[h][i]; } }
            const char* a1 = gA + (size_t)(t + 1) * kstep;
            const char* a2 = last ? gA : gA + (size_t)(t + 2) * kstep; const char* b2 = last ? nB : cB + (size_t)(t + 2) * kstep;
            const char* a3 = a2 + kstep; const char* b3 = b2 + kstep;
            unsigned v2[2][2];
#pragma unroll
            for (int h = 0; h < 2; ++h)
#pragma unroll
                for (int i = 0; i < 2; ++i) v2[h][i] = last ? vn[h][i] : vc[h][i];
            if constexpr (SP2) {
            PG8_LDB(B0, 0, 0); PG8_LDB(B1, 0, 1); PG8_SCHED; PG8_LDA(At, 0, 0); PG8_STAGE(PG8_SA(1, 1), a1, vc[1]);
            PG8_WAIT_V(8); PG8_WAIT_L(0); PG8_BAR; PG8_MMA(0, 0, At, B0); PG8_MMA(0, 1, At, B1); PG8_BAR; PG8_SCHED;
            PG8_LDA(At, 0, 1); PG8_STAGE(PG8_SB(0, 0), b2, voffB); PG8_STAGE(PG8_SB(0, 1), b2 + hstep, voffB); PG8_STAGE(PG8_SA(0, 0), a2, v2[0]);
            PG8_WAIT_V(8); PG8_WAIT_L(0); PG8_BAR; PG8_MMA(1, 0, At, B0); PG8_MMA(1, 1, At, B1); PG8_BAR; PG8_SCHED;
            PG8_LDB(B0, 1, 0); PG8_LDB(B1, 1, 1); PG8_SCHED; PG8_LDA(At, 1, 0); PG8_STAGE(PG8_SA(0, 1), a2, v2[1]);
            PG8_WAIT_V(8); PG8_WAIT_L(0); PG8_BAR; PG8_MMA(0, 0, At, B0); PG8_MMA(0, 1, At, B1); PG8_BAR; PG8_SCHED;
            PG8_LDA(At, 1, 1); PG8_STAGE(PG8_SB(1, 0), b3, voffB); PG8_STAGE(PG8_SB(1, 1), b3 + hstep, voffB); PG8_STAGE(PG8_SA(1, 0), a3, v2[0]);
            PG8_WAIT_V(8); PG8_WAIT_L(0); PG8_BAR; PG8_MMA(1, 0, At, B0); PG8_MMA(1, 1, At, B1); PG8_BAR; PG8_SCHED;
            } else {
            PG8_LDB(B0, 0, 0); PG8_SCHED; PG8_LDA(At, 0, 0); PG8_STAGE(PG8_SA(1, 1), a1, vc[1]);
            PG8_WAIT_L(8); PG8_BAR; PG8_WAIT_L(0); PG8_MMA(0, 0, At, B0); PG8_BAR; PG8_SCHED;
            PG8_LDB(B1, 0, 1); PG8_STAGE(PG8_SB(0, 0), b2, voffB);
            PG8_BAR; PG8_WAIT_L(0); PG8_MMA(0, 1, At, B1); PG8_BAR;
            PG8_LDA(At, 0, 1); PG8_STAGE(PG8_SA(0, 0), a2, v2[0]);
            PG8_BAR; PG8_WAIT_L(0); PG8_MMA(1, 0, At, B0); PG8_BAR; PG8_SCHED;
            PG8_STAGE(PG8_SB(0, 1), b2 + hstep, voffB);
            PG8_WAIT_V(6); PG8_BAR; PG8_MMA(1, 1, At, B1); PG8_BAR;
            PG8_LDB(B0, 1, 0); PG8_SCHED; PG8_LDA(At, 1, 0); PG8_STAGE(PG8_SA(0, 1), a2, v2[1]);
            PG8_WAIT_L(8); PG8_BAR; PG8_WAIT_L(0); PG8_MMA(0, 0, At, B0); PG8_BAR; PG8_SCHED;
            PG8_LDB(B1, 1, 1); PG8_STAGE(PG8_SB(1, 0), b3, voffB);
            PG8_BAR; PG8_WAIT_L(0); PG8_MMA(0, 1, At, B1); PG8_BAR;
            PG8_LDA(At, 1, 1); PG8_STAGE(PG8_SA(1, 0), a3, v2[0]);
            PG8_BAR; PG8_WAIT_L(0); PG8_MMA(1, 0, At, B0); PG8_BAR; PG8_SCHED;
            PG8_STAGE(PG8_SB(1, 1), b3 + hstep, voffB);
            PG8_WAIT_V(6); PG8_BAR; PG8_MMA(1, 1, At, B1); PG8_BAR;
            }
        }
        if constexpr (ALIGN_EPI) { if (wr == 0) PG8_BAR; }
        E(acc, cur, wr, wc);
        if (!has_next) break;
#pragma unroll
        for (int a = 0; a < 2; ++a)
#pragma unroll
            for (int b = 0; b < 2; ++b)
#pragma unroll
                for (int m = 0; m < 4; ++m)
#pragma unroll
                    for (int n = 0; n < 2; ++n) acc[a][b][m][n] = (f32x4){0.f, 0.f, 0.f, 0.f};
        cur = nxt; cB = nB; ++ui;
#pragma unroll
        for (int h = 0; h < 2; ++h)
#pragma unroll
            for (int i = 0; i < 2; ++i) vc[h][i] = vn[h][i];
        if constexpr (ALIGN_EPI) { if (wr == 1) PG8_BAR; }
    }
    PG8_WAIT_V(0);
    if constexpr (!ALIGN_EPI) { if (wr == 0) PG8_BAR; }
    PG8_BAR;
#undef PG8_SA
#undef PG8_SB
#undef PG8_STAGE
#undef PG8_AVOFF
#undef PG8_LDA
#undef PG8_LDB
#undef PG8_MMA
#undef PG8_WAIT_V
#undef PG8_WAIT_L
#undef PG8_BAR
#undef PG8_SCHED
}
}

#define XB_TMO      128
#define XB_XCNT(j)  (256  + 64 * (j))
#define XB_XSUB(j)  (1280 + 64 * (j))
#define XB_XGEN(j)  (2304 + 64 * (j))
#define XB_TOP      3328
#define XB_TOPGEN   3392
#define XCD_BAR_WORDS 3456
#define XB_SPIN_CAP (1u << 20)
__device__ __forceinline__ unsigned xb_ld(unsigned* p)              { return __hip_atomic_load(p, __ATOMIC_RELAXED, __HIP_MEMORY_SCOPE_AGENT); }
__device__ __forceinline__ unsigned xb_add(unsigned* p, unsigned v) { return __hip_atomic_fetch_add(p, v, __ATOMIC_RELAXED, __HIP_MEMORY_SCOPE_AGENT); }
__device__ __forceinline__ unsigned xb_xcc_id() { return (unsigned)__builtin_amdgcn_s_getreg((3 << 11) | 20) & 0xFu; }
#define XB_SPIN(cond, bar) do { unsigned _sp = 0; while (cond) { __builtin_amdgcn_s_sleep(1); \
    if ((++_sp & 255u) == 0u) { if (xb_ld(&(bar)[XB_TMO])) break; if (_sp > XB_SPIN_CAP) { atomicAdd(&(bar)[XB_TMO], 1u); break; } } } } while (0)
struct XcdBarrier { unsigned* bar; unsigned x; volatile LAS unsigned* st; };
__device__ __forceinline__ XcdBarrier xcd_barrier_post(unsigned* bar, volatile LAS unsigned* st, bool leader) {
    XcdBarrier b; b.bar = bar; b.x = xb_xcc_id(); b.st = st;
    if (leader) (void)xb_add(&bar[XB_XCNT(b.x)], 1u);
    return b;
}
__device__ __forceinline__ void xcd_barrier_complete(unsigned* bar, unsigned x, unsigned& nloc, unsigned& nx) {
    const unsigned G = gridDim.x * gridDim.y * gridDim.z;
    unsigned sum, cnt, mine, sp = 0u;
    for (;;) {
        sum = 0u; cnt = 0u; mine = 0u;
#pragma unroll 1
        for (unsigned j = 0; j < 16; ++j) { const unsigned c = xb_ld(&bar[XB_XCNT(j)]); sum += c; cnt += (c > 0u) ? 1u : 0u; mine = (j == x) ? c : mine; }
        if (sum == G) break;
        __builtin_amdgcn_s_sleep(1);
        if ((++sp & 255u) == 0u) { if (xb_ld(&bar[XB_TMO])) break; if (sp > XB_SPIN_CAP) { atomicAdd(&bar[XB_TMO], 1u); break; } }
    }
    nloc = mine > 0u ? mine : 1u; nx = cnt > 0u ? cnt : 1u;
}
__device__ __forceinline__ void xcd_barrier(const XcdBarrier& b, bool leader) {
    asm volatile("s_waitcnt vmcnt(0)" ::: "memory");
    __syncthreads();
    if (leader) {
        unsigned* bar = b.bar;
        __builtin_amdgcn_s_waitcnt(0);
        unsigned nloc = b.st[0], nx = b.st[1];
        if (nloc == 0u) { xcd_barrier_complete(bar, b.x, nloc, nx); b.st[0] = nloc; b.st[1] = nx; }
        const unsigned old = xb_add(&bar[XB_XSUB(b.x)], 1u);
        const unsigned gen = old / nloc;
        if (old + 1u == (gen + 1u) * nloc) {
            __builtin_amdgcn_fence(__ATOMIC_RELEASE, "agent");
            asm volatile("s_waitcnt vmcnt(0)" ::: "memory");
            const unsigned og = xb_add(&bar[XB_TOP], 1u);
            const unsigned tg = og / nx;
            if (og + 1u == (tg + 1u) * nx) xb_add(&bar[XB_TOPGEN], 1u);
            else XB_SPIN(xb_ld(&bar[XB_TOPGEN]) == tg, bar);
            __builtin_amdgcn_fence(__ATOMIC_ACQUIRE, "agent");
            xb_add(&bar[XB_XGEN(b.x)], 1u);
            asm volatile("s_waitcnt vmcnt(0)" ::: "memory");
        } else {
            XB_SPIN(xb_ld(&bar[XB_XGEN(b.x)]) == gen, bar);
            __builtin_amdgcn_fence(__ATOMIC_ACQUIRE, "agent");
            asm volatile("s_waitcnt vmcnt(0)" ::: "memory");
        }
    }
    __syncthreads();
}

struct Args {
    const float* x; const float* w_in; const float* q_norm; const float* w_uq; const float* kv_norm; const float* w_ukv; const float* w_out;
    const float* ln1_g; const float* ln1_b; const float* router_w; const float* router_b; const float* w1; const float* w3; const float* w2;
    const float* ln2_g; const float* ln2_b;
    float* out; unsigned char* ws;
    int ph_lo, ph_hi;
};
struct Frame {
    LAS unsigned char* lds;
    volatile LAS unsigned* LC;
    gu32* ctl;
    unsigned char* ws;
    int wave, vcu, G;
};

template <class Map>
__device__ __forceinline__ void transpose_item(const float* W, int K, int N, bf16_t* WT, const float* kscale, LAS float* scr, int item, int lane, Map map) {
    const int nblk = N / 32, kb = item / nblk, nb = item % nblk, k0 = 64 * kb, n0 = 32 * nb;
    { const int c4 = (lane & 7) * 4; f32x4 v[8];
#pragma unroll
      for (int i = 0; i < 8; ++i) { const int kk = (lane >> 3) + 8 * i; v[i] = *(const GAS f32x4*)(W + (size_t)(k0 + kk) * N + n0 + c4); }
#pragma unroll
      for (int i = 0; i < 8; ++i) { const int kk = (lane >> 3) + 8 * i; f32x4 w = v[i]; if (kscale) w = w * kscale[k0 + kk];
          LAS float* d = scr + kk * 33 + c4; d[0] = w[0]; d[1] = w[1]; d[2] = w[2]; d[3] = w[3]; } }
    LDS_WAIT(); asm volatile("" ::: "memory");
    const int c = lane & 7;
#pragma unroll
    for (int j = 0; j < 4; ++j) { const int n = (lane >> 3) + 8 * j; const LAS float* s = scr + (8 * c) * 33 + n;
        u32x4 o; o.x = pk2(s[0], s[33]); o.y = pk2(s[66], s[99]); o.z = pk2(s[132], s[165]); o.w = pk2(s[198], s[231]);
        const int row = map(n0 + n);
        *(GAS u32x4*)(WT + (size_t)row * K + k0 + 8 * c) = o; }
    LDS_WAIT(); asm volatile("" ::: "memory");
}
__device__ __forceinline__ void router_item(const float* W, const float* g, bf16_t* WH, bf16_t* WL, LAS float* scr, int item, int lane) {
    const int K = 1024, N = 64, nblk = 2, kb = item / nblk, nb = item % nblk, k0 = 64 * kb, n0 = 32 * nb;
    { const int c4 = (lane & 7) * 4; f32x4 v[8];
#pragma unroll
      for (int i = 0; i < 8; ++i) { const int kk = (lane >> 3) + 8 * i; v[i] = *(const GAS f32x4*)(W + (size_t)(k0 + kk) * N + n0 + c4); }
#pragma unroll
      for (int i = 0; i < 8; ++i) { const int kk = (lane >> 3) + 8 * i; f32x4 w = v[i]; if (g) w = w * g[k0 + kk];
          LAS float* d = scr + kk * 33 + c4; d[0] = w[0]; d[1] = w[1]; d[2] = w[2]; d[3] = w[3]; } }
    LDS_WAIT(); asm volatile("" ::: "memory");
    const int c = lane & 7;
#pragma unroll
    for (int j = 0; j < 4; ++j) { const int n = (lane >> 3) + 8 * j; const LAS float* s = scr + (8 * c) * 33 + n;
        unsigned h[8], l[8];
#pragma unroll
        for (int q = 0; q < 8; ++q) { const float v = s[q * 33]; h[q] = f2bf(v); l[q] = f2bf(v - __builtin_bit_cast(float, h[q] << 16)); }
        u32x4 oh, ol; oh.x = h[0] | (h[1] << 16); oh.y = h[2] | (h[3] << 16); oh.z = h[4] | (h[5] << 16); oh.w = h[6] | (h[7] << 16);
        ol.x = l[0] | (l[1] << 16); ol.y = l[2] | (l[3] << 16); ol.z = l[4] | (l[5] << 16); ol.w = l[6] | (l[7] << 16);
        *(GAS u32x4*)(WH + (size_t)(n0 + n) * K + k0 + 8 * c) = oh; *(GAS u32x4*)(WL + (size_t)(n0 + n) * K + k0 + 8 * c) = ol; }
    LDS_WAIT(); asm volatile("" ::: "memory");
}
struct MapId { int off; __device__ __forceinline__ int operator()(int n) const { return off + n; } };
struct MapWin { __device__ __forceinline__ int operator()(int n) const {
    if (n < 384) return n;
    if (n < 416) { const int e = n - 384, nn = e >> 4, fq = (e >> 2) & 3, j = e & 3; return 384 + 8 * fq + 4 * nn + j; }
    const int m = n - 416, seg = m / 384, r = m % 384, hh = r >> 6, e = r & 63, base = 512 + seg * 384 + hh * 64;
    if (seg == 2 || seg == 5) return base + e;
    const int nn = e >> 5, wcl = (e >> 4) & 1, fq = (e >> 2) & 3, j = e & 3; return base + 32 * wcl + 8 * fq + 4 * nn + j; } };
struct MapW13 { int e, which; __device__ __forceinline__ int operator()(int n) const { return e * 512 + 256 * (n >> 7) + 128 * which + (n & 127); } };

__device__ __forceinline__ void sincos_d(double a, float& s, float& c) {
    const double INV = 0.15915494309189533577;
    const double t = a * INV; const float rf = (float)(t - __builtin_rint(t));
    s = __builtin_amdgcn_sinf(rf); c = __builtin_amdgcn_cosf(rf);
}

constexpr int MOE_ITEMS_L = 64 * 3 * 128;
constexpr int MOE_P0_FROM = 12288, MOE_L1_A = 11264, MOE_L1_B = 13312;
static_assert(DEPTH == 2, "the idle-tail conversion plan is written for two layers");
__device__ __forceinline__ void moe_convert_item(const Args& a, unsigned char* ws, int l, int r, LAS float* scr, int lane) {
    const int item = r % 128; r /= 128; const int which = r % 3, e = r / 3;
    bf16_t* W13t = (bf16_t*)(ws + WS_MOE + (size_t)l * MOE_L); bf16_t* W2t = (bf16_t*)(ws + WS_MOE + (size_t)l * MOE_L + 64 * MiB);
    const size_t eoff = ((size_t)l * 64 + e) * (size_t)(1024 * 256);
    if (which == 0) transpose_item(a.w1 + eoff, 1024, 256, W13t, nullptr, scr, item, lane, MapW13{e, 0});
    else if (which == 1) transpose_item(a.w3 + eoff, 1024, 256, W13t, nullptr, scr, item, lane, MapW13{e, 1});
    else transpose_item(a.w2 + eoff, 256, 1024, W2t, nullptr, scr, item, lane, MapId{e * 1024});
}
__device__ __forceinline__ void moe_convert_tail(Frame& F, const Args& a, int l, int lo, int hi, int nunits, int c) {
    const int rounds = (nunits + F.G - 1) / F.G, busy_last = nunits - (rounds - 1) * F.G;
    int first = busy_last, npart = F.G - busy_last;
    if (npart <= 0) { first = 0; npart = F.G; }
    if (c < first) return;
    LAS float* scr = (LAS float*)(F.lds + F.wave * 16384); const int lane = lane_now();
    for (int r = lo + (c - first) * NWAVES + F.wave; r < hi; r += npart * NWAVES) moe_convert_item(a, F.ws, l, r, scr, lane);
}

__device__ __forceinline__ void p0_prologue(Frame& F, const Args& a) {
    LAS float* scr = (LAS float*)(F.lds + F.wave * 16384);
    const int gw = F.vcu * NWAVES + F.wave, NGW = F.G * NWAVES, lane = lane_now();
    unsigned char* ws = F.ws;
    constexpr int I_WIN = 16 * 85, I_WUQ = 4 * 12, I_WUKV = 2 * 16, I_WOUT = 16 * 32, I_RW = 16 * 2, I_MOE = 128;
    constexpr int PER_L = I_WIN + I_WUQ + I_WUKV + I_WOUT + I_RW;
    constexpr int N_SMALL = 2 * PER_L, N_MOE = MOE_ITEMS_L - MOE_P0_FROM, NITEMS = N_SMALL + N_MOE;
    for (int it = gw; it < NITEMS; it += NGW) {
        if (it >= N_SMALL) { moe_convert_item(a, ws, 0, MOE_P0_FROM + it - N_SMALL, scr, lane); continue; }
        const int l = it / PER_L; int r = it % PER_L;
        if (r < I_WIN) { transpose_item(a.w_in + (size_t)l * 1024 * N_IN, 1024, N_IN, (bf16_t*)(ws + WS_WIN + (size_t)l * WIN_L), nullptr, scr, r, lane, MapWin{}); continue; } r -= I_WIN;
        if (r < I_WUQ) { transpose_item(a.w_uq + (size_t)l * 256 * 384, 256, 384, (bf16_t*)(ws + WS_WUQ) + (size_t)l * 384 * 256, a.q_norm + l * 256, scr, r, lane, MapId{0}); continue; } r -= I_WUQ;
        if (r < I_WUKV) { transpose_item(a.w_ukv + (size_t)l * 128 * 512, 128, 512, (bf16_t*)(ws + WS_WUKV) + (size_t)l * 512 * 128, a.kv_norm + l * 128, scr, r, lane, MapId{0}); continue; } r -= I_WUKV;
        if (r < I_WOUT) { transpose_item(a.w_out + (size_t)l * 1024 * 1024, 1024, 1024, (bf16_t*)(ws + WS_WOUT) + (size_t)l * 1024 * 1024, nullptr, scr, r, lane, MapId{0}); continue; } r -= I_WOUT;
        router_item(a.router_w, nullptr, (bf16_t*)(ws + WS_RW) + (size_t)(l * 2) * 65536, (bf16_t*)(ws + WS_RW) + (size_t)(l * 2 + 1) * 65536, scr, r, lane);
    }
    { const int gt = gw * 64 + lane, NT_ = NGW * 64;
      for (int i = gt; i < 2 * 96 * 128; i += NT_) { const int l = i / (96 * 128), r = i % (96 * 128);
          unsigned z_ = 0u; asm volatile("" : "+v"(z_)); *(GAS u32x4*)(ws + WS_WIN + (size_t)l * WIN_L + (size_t)416 * 2048 + (size_t)r * 16) = (u32x4){z_, z_, z_, z_}; }
      for (int i = gt; i < 4096 * 32; i += NT_) { const int pos = i >> 5, f = i & 31; const float ang = (float)pos * INV64[f]; float s, c; sincos_d((double)ang, s, c);
          ((GAS f32x2*)(ws + WS_T64))[i] = (f32x2){c, s}; }
      for (int i = gt; i < 4096 * 16; i += NT_) { const int pos = i >> 4, f = i & 15; const float ang = (float)pos * INV32[f]; float s, c; sincos_d((double)ang, s, c);
          ((GAS f32x2*)(ws + WS_T32))[i] = (f32x2){c, s}; }
    }
#ifdef TIMING_SEG
    if (gw == 0 && lane < 2) ((GAS unsigned*)(ws + WS_GB + 4096))[lane] = 0u;
#endif
    { bf16_t* xb = (bf16_t*)(ws + WS_XB);
      for (int it = gw; it < T * DM / 2048; it += NGW) { const size_t o = (size_t)it * 2048 + lane * 8;
          f32x4 v0[4], v1[4];
#pragma unroll
          for (int j = 0; j < 4; ++j) { v0[j] = *(const GAS f32x4*)(a.x + o + 512 * j); v1[j] = *(const GAS f32x4*)(a.x + o + 512 * j + 4); }
#pragma unroll
          for (int j = 0; j < 4; ++j) { u32x4 w; w.x = pk2(v0[j].x, v0[j].y); w.y = pk2(v0[j].z, v0[j].w); w.z = pk2(v1[j].x, v1[j].y); w.w = pk2(v1[j].z, v1[j].w);
              *(GAS u32x4*)(xb + o + 512 * j) = w; } } }
}

__device__ __forceinline__ u32x4 pack8(const f32x4& a, const f32x4& b) { u32x4 w; w.x = cvtpk(a[0], a[1]); w.y = cvtpk(a[2], a[3]); w.z = cvtpk(b[0], b[1]); w.w = cvtpk(b[2], b[3]); return w; }
__device__ __forceinline__ u32x2 pack4(const f32x4& a) { u32x2 w; w.x = cvtpk(a[0], a[1]); w.y = cvtpk(a[2], a[3]); return w; }

struct EpiP1 {
    static constexpr bool PERM = true;
    bf16_t *CQ, *CKV, *KR, *QKV; const f32x2* T64; const f32x2* T32; float* KM;
    __device__ __forceinline__ void operator()(const f32x4 (&acc)[2][2][4][2], const pg8::Unit& u, int wr, int wc) const {
        const int ln_ = lane_now(), fr = ln_ & 15, fq = ln_ >> 4;
        const int rowb = u.pm * 256 + wr * 64 + fr;
        if (u.pn == 0) {
#pragma unroll
            for (int ai = 0; ai < 2; ++ai)
#pragma unroll
                for (int m = 0; m < 4; ++m) { const size_t row = rowb + ai * 128 + m * 16;
#pragma unroll
                    for (int bj = 0; bj < 2; ++bj) *(GAS u32x4*)(CQ + row * 256 + bj * 128 + wc * 32 + 8 * fq) = pack8(acc[ai][bj][m][0], acc[ai][bj][m][1]); }
        } else if (u.pn == 1) {
#pragma unroll
            for (int ai = 0; ai < 2; ++ai)
#pragma unroll
                for (int m = 0; m < 4; ++m) { const size_t row = rowb + ai * 128 + m * 16;
                    *(GAS u32x4*)(CKV + row * 128 + wc * 32 + 8 * fq) = pack8(acc[ai][0][m][0], acc[ai][0][m][1]);
                    if (wc == 0) { const int pos = (int)(row & 4095);
                        const f32x4 t0 = *(const GAS f32x4*)(T32 + pos * 16 + 4 * fq), t1 = *(const GAS f32x4*)(T32 + pos * 16 + 4 * fq + 2);
                        const f32x4 x1 = acc[ai][1][m][0], x2 = acc[ai][1][m][1];
                        const f32x4 c = {t0[0], t0[2], t1[0], t1[2]}, s = {t0[1], t0[3], t1[1], t1[3]};
                        const f32x4 o1 = x1 * c - x2 * s, o2 = x2 * c + x1 * s;
                        *(GAS u32x2*)(KR + row * 32 + 4 * fq) = pack4(o1); *(GAS u32x2*)(KR + row * 32 + 16 + 4 * fq) = pack4(o2); } asm volatile("" ::: "memory"); }
        } else {
#pragma unroll
            for (int bj = 0; bj < 2; ++bj) {
                const int gh = (u.pn - 2) * 4 + 2 * bj + (wc >> 1), seg = gh / 6, hh = gh % 6, wcl = wc & 1;
                bf16_t* dst = QKV + (size_t)seg * SEG_ELEMS;
                if (seg == 2 || seg == 5) {
#pragma unroll
                    for (int ai = 0; ai < 2; ++ai)
#pragma unroll
                        for (int m = 0; m < 4; ++m) { const size_t row = rowb + ai * 128 + m * 16;
                            *(GAS u32x4*)(dst + row * 384 + hh * 64 + 32 * wcl + 8 * fq) = pack8(acc[ai][bj][m][0], acc[ai][bj][m][1]); }
                } else {
                    const int e0 = 16 * wcl + 4 * fq; f32x4 s1 = {0.f, 0.f, 0.f, 0.f}, s2 = {0.f, 0.f, 0.f, 0.f};
                    const float qs = (seg == 0 || seg == 3) ? 0.125f * LOG2E : 1.0f;
#pragma unroll
                    for (int ai = 0; ai < 2; ++ai) {
                        const int pos0 = (int)((rowb + ai * 128) & 4095);
                        const f32x4 t0 = *(const GAS f32x4*)(T64 + pos0 * 32 + e0), t1 = *(const GAS f32x4*)(T64 + pos0 * 32 + e0 + 2);
                        const f32x4 d0 = *(const GAS f32x4*)(T64 + 16 * 32 + e0), d1 = *(const GAS f32x4*)(T64 + 16 * 32 + e0 + 2);
                        f32x4 c = {t0[0], t0[2], t1[0], t1[2]}, s = {t0[1], t0[3], t1[1], t1[3]};
                        const f32x4 C = {d0[0], d0[2], d1[0], d1[2]}, S = {d0[1], d0[3], d1[1], d1[3]};
#pragma unroll
                        for (int m = 0; m < 4; ++m) { const size_t row = rowb + ai * 128 + m * 16;
                            const f32x4 x1 = acc[ai][bj][m][0], x2 = acc[ai][bj][m][1];
                            const f32x4 o1 = (x1 * c - x2 * s) * qs, o2 = (x2 * c + x1 * s) * qs;
                            *(GAS u32x4*)(dst + row * 384 + hh * 64 + 32 * wcl + 8 * fq) = pack8(o1, o2);
                            s1 += o1; s2 += o2;
                            if (m < 3) { const f32x4 cn = c * C - s * S; s = s * C + c * S; c = cn; }
                            asm volatile("" ::: "memory"); }
                    }
                    if (seg == 1) {
#pragma unroll
                        for (int j = 0; j < 4; ++j) {
                            s1[j] += swz_xor<1>(s1[j]); s2[j] += swz_xor<1>(s2[j]); s1[j] += swz_xor<2>(s1[j]); s2[j] += swz_xor<2>(s2[j]);
                            s1[j] += swz_xor<4>(s1[j]); s2[j] += swz_xor<4>(s2[j]); s1[j] += swz_xor<8>(s1[j]); s2[j] += swz_xor<8>(s2[j]); }
                        if (fr == 0) { float* km = KM + (((size_t)(u.pm >> 4) * 6 + hh) * 16 + (u.pm & 15)) * 64 + 32 * wcl + 8 * fq;
#pragma unroll
                            for (int j = 0; j < 4; ++j) { atomicAdd(km + j, s1[j]); atomicAdd(km + 4 + j, s2[j]); } }
                    }
                }
            }
        }
    }
};

struct EpiP3 {
    static constexpr bool PERM = false;
    const float* res; float* out; float* PS;
    __device__ __forceinline__ void operator()(const f32x4 (&acc)[2][2][4][2], const pg8::Unit& u, int wr, int wc) const {
        const int ln_ = lane_now(), fr = ln_ & 15, fq = ln_ >> 4;
        const int col0 = u.pn * 256 + wc * 32 + 4 * fq;
#pragma unroll
        for (int ai = 0; ai < 2; ++ai)
#pragma unroll
            for (int m = 0; m < 4; ++m) { const size_t row = u.pm * 256 + ai * 128 + wr * 64 + m * 16 + fr; float s = 0.f, q = 0.f;
#pragma unroll
                for (int bj = 0; bj < 2; ++bj)
#pragma unroll
                    for (int n = 0; n < 2; ++n) { const size_t off = row * 1024 + col0 + bj * 128 + n * 16;
                        const f32x4 r = *(const GAS f32x4*)(res + off); const f32x4 v = r * ALPHA + acc[ai][bj][m][n]; *(GAS f32x4*)(out + off) = v;
                        s += (v[0] + v[1]) + (v[2] + v[3]); q += (v[0] * v[0] + v[1] * v[1]) + (v[2] * v[2] + v[3] * v[3]); }
                s += swz_xor<16>(s); q += swz_xor<16>(q); s = xsum32(s); q = xsum32(q);
                if (fq == 0) *(GAS f32x2*)(PS + ((row * 4 + u.pn) * 4 + wc) * 2) = (f32x2){s, q};
                asm volatile("" ::: "memory"); }
    }
};

struct MoeSched {
    const LAS int* tb; const LAS int* cnt; const int* tokslot; int NCT, G, c, ntiles; bool gather;
    __device__ __forceinline__ bool next(int i, pg8::Unit& u) const {
        const long L = (long)i * G + c; if (L >= (long)ntiles * NCT) return false;
        const int tau = (int)(L / NCT), ct = (int)(L % NCT);
        int lo = 0, hi = 64;
        while (hi - lo > 1) { const int mid = (lo + hi) >> 1; if (tb[mid] <= tau) lo = mid; else hi = mid; }
        u.pm = tau; u.pn = lo * NCT + ct; return true;
    }
    __device__ __forceinline__ int a_row(const pg8::Unit& u, int r) const {
        if (!gather) return u.pm * 256 + r;
        const int e = u.pn / NCT, slot = (u.pm - tb[e]) * 256 + r;
        return slot < cnt[e] ? (tokslot[(size_t)e * CAP + slot] >> 1) : 0;
    }
};
__device__ __forceinline__ float silu_f(float x) { return x * __builtin_amdgcn_rcpf(1.f + __builtin_amdgcn_exp2f(-x * LOG2E)); }
struct EpiP5 {
    static constexpr bool PERM = true;
    bf16_t* H;
    __device__ __forceinline__ void operator()(const f32x4 (&acc)[2][2][4][2], const pg8::Unit& u, int wr, int wc) const {
        const int ln_ = lane_now(), fr = ln_ & 15, fq = ln_ >> 4;
        const int ct = u.pn & 1;
#pragma unroll
        for (int ai = 0; ai < 2; ++ai)
#pragma unroll
            for (int m = 0; m < 4; ++m) { const size_t row = (size_t)u.pm * 256 + ai * 128 + wr * 64 + m * 16 + fr;
                f32x4 v[2];
#pragma unroll
                for (int n = 0; n < 2; ++n)
#pragma unroll
                    for (int j = 0; j < 4; ++j) v[n][j] = silu_f(acc[ai][0][m][n][j]) * acc[ai][1][m][n][j];
                *(GAS u32x4*)(H + row * 256 + ct * 128 + wc * 32 + 8 * fq) = pack8(v[0], v[1]); }
    }
};
struct EpiP6 {
    static constexpr bool PERM = true;
    bf16_t* Y; const LAS int* tb; const LAS int* cnt; const int* tokslot; const float* gate;
    __device__ __forceinline__ void operator()(const f32x4 (&acc)[2][2][4][2], const pg8::Unit& u, int wr, int wc) const {
        const int ln_ = lane_now(), fr = ln_ & 15, fq = ln_ >> 4;
        const int e = u.pn >> 2, ct = u.pn & 3, bs = (u.pm - tb[e]) * 256, ne = cnt[e];
#pragma unroll
        for (int ai = 0; ai < 2; ++ai)
#pragma unroll
            for (int m = 0; m < 4; ++m) { const int slot = bs + ai * 128 + wr * 64 + m * 16 + fr;
                if (slot < ne) { const size_t idx = (size_t)e * CAP + slot; const size_t dst = (size_t)tokslot[idx]; const float g = gate[idx];
#pragma unroll
                    for (int bj = 0; bj < 2; ++bj) *(GAS u32x4*)(Y + dst * 1024 + ct * 256 + bj * 128 + wc * 32 + 8 * fq) = pack8(acc[ai][bj][m][0] * g, acc[ai][bj][m][1] * g); } }
    }
};

#define MFMA32(a, b, c) __builtin_amdgcn_mfma_f32_32x32x16_bf16(a, b, c, 0, 0, 0)
__device__ __forceinline__ float ssq8(const bf16x8& v) { float s = 0.f;
#pragma unroll
    for (int j = 0; j < 8; ++j) { const float f = bf2f((unsigned short)v[j]); s += f * f; } return s; }

constexpr float MLA_QSCALE = 0.10206207261596575f * LOG2E;
__device__ __forceinline__ void p1b_mla(Frame& F, int l) {
    unsigned char* ws = F.ws;
    const bf16_t* CQ = (const bf16_t*)(ws + WS_CQ); const bf16_t* CKV = (const bf16_t*)(ws + WS_CKV); const bf16_t* KR = (const bf16_t*)(ws + WS_KR);
    const bf16_t* Wuq = (const bf16_t*)(ws + WS_WUQ) + (size_t)l * 384 * 256; const bf16_t* Wukv = (const bf16_t*)(ws + WS_WUKV) + (size_t)l * 512 * 128;
    bf16_t* QA = (bf16_t*)(ws + WS_QA); bf16_t* KA = (bf16_t*)(ws + WS_KA); bf16_t* VA = (bf16_t*)(ws + WS_VA);
    const f32x2* T32 = (const f32x2*)(ws + WS_T32);
    const int lane = lane_now(), wave = F.wave, tid = wave * 64 + lane, r32 = lane & 31, hi = lane >> 5, path = wave >> 2;
    LAS unsigned char* lds = F.lds;
    for (int it0 = F.vcu * 4; it0 < T / 32; it0 += F.G * 4) {
        const int it = it0 + (wave & 3);
        const size_t tok = (size_t)it * 32 + r32; const int pos = (int)(tok & 4095);
        bf16x8 bq[16]; float ss = 0.f;
        if (path == 0) {
#pragma unroll
            for (int ks = 0; ks < 16; ++ks) { bq[ks] = *(const GAS bf16x8*)(CQ + tok * 256 + 16 * ks + 8 * hi); ss += ssq8(bq[ks]); }
        } else {
#pragma unroll
            for (int ks = 0; ks < 8; ++ks) { bq[ks] = *(const GAS bf16x8*)(CKV + tok * 128 + 16 * ks + 8 * hi); ss += ssq8(bq[ks]); }
#pragma unroll
            for (int ks = 8; ks < 16; ++ks) bq[ks] = bq[0];
        }
        ss += xhalf(ss);
        const float rs = (path == 0) ? MLA_QSCALE / sqrtf(ss * (1.0f / 256.0f) + RMS_EPS) : 1.0f / sqrtf(ss * (1.0f / 128.0f) + RMS_EPS);
        f32x4 cs[2][2];
#pragma unroll
        for (int g = 0; g < 2; ++g) { cs[g][0] = *(const GAS f32x4*)(T32 + pos * 16 + 8 * g + 4 * hi); cs[g][1] = *(const GAS f32x4*)(T32 + pos * 16 + 8 * g + 4 * hi + 2); }
        u32x4 wq[2], wk;
#define W_LOAD(sn) do { if ((sn) < 12) { _Pragma("unroll") for (int i_ = 0; i_ < 2; ++i_) { const int p_ = tid + 512 * i_, row_ = p_ >> 5, c_ = p_ & 31; wq[i_] = *(const GAS u32x4*)(Wuq + (size_t)(32 * (sn) + row_) * 256 + c_ * 8); } } \
        { const int row_ = tid >> 4, c_ = tid & 15; wk = *(const GAS u32x4*)(Wukv + (size_t)(32 * (sn) + row_) * 128 + c_ * 8); } } while (0)
#define W_WRITE(sn, b) do { if ((sn) < 12) { _Pragma("unroll") for (int i_ = 0; i_ < 2; ++i_) { const int p_ = tid + 512 * i_, row_ = p_ >> 5, c_ = p_ & 31; *(LAS u32x4*)(lds + (b) * 24576 + row_ * 512 + ((c_ ^ (row_ & 15)) * 16)) = wq[i_]; } } \
        { const int row_ = tid >> 4, c_ = tid & 15; *(LAS u32x4*)(lds + (b) * 24576 + 16384 + row_ * 256 + ((c_ ^ (row_ & 15)) * 16)) = wk; } } while (0)
        W_LOAD(0); W_WRITE(0, 0);
        __syncthreads();
#pragma unroll 1
        for (int sn = 0; sn < 16; ++sn) {
            if (sn + 1 < 16) W_LOAD(sn + 1);
            const LAS unsigned char* wb = lds + (sn & 1) * 24576;
            if (path == 0) {
                if (sn < 12) {
                    f32x16 acc = {};
#pragma unroll
                    for (int ks = 0; ks < 16; ++ks) { const bf16x8 a = *(const LAS bf16x8*)(wb + r32 * 512 + (((2 * ks + hi) ^ (r32 & 15)) * 16)); acc = MFMA32(a, bq[ks], acc); }
#pragma unroll
                    for (int r = 0; r < 16; ++r) acc[r] *= rs;
                    const int head = sn / 3, part = sn % 3;
                    if (part == 2) {
#pragma unroll
                        for (int r = 0; r < 8; ++r) { const int g = r >> 2, j = r & 3; const float c = cs[g][j >> 1][(j & 1) * 2], sv = cs[g][j >> 1][(j & 1) * 2 + 1];
                            const float x1 = acc[r], x2 = acc[r + 8]; acc[r] = x1 * c - x2 * sv; acc[r + 8] = x2 * c + x1 * sv; }
                    }
                    bf16_t* dst = QA + tok * 384 + head * 96 + part * 32 + 4 * hi;
#pragma unroll
                    for (int g = 0; g < 4; ++g) { u32x2 w; w.x = cvtpk(acc[4 * g], acc[4 * g + 1]); w.y = cvtpk(acc[4 * g + 2], acc[4 * g + 3]); *(GAS u32x2*)(dst + 8 * g) = w; }
                }
            } else {
                f32x16 acc = {};
#pragma unroll
                for (int ks = 0; ks < 8; ++ks) { const bf16x8 a = *(const LAS bf16x8*)(wb + 16384 + r32 * 256 + (((2 * ks + hi) ^ (r32 & 15)) * 16)); acc = MFMA32(a, bq[ks], acc); }
#pragma unroll
                for (int r = 0; r < 16; ++r) acc[r] *= rs;
                const int head = sn >> 2, part = sn & 3;
                bf16_t* dst = (part < 2) ? (KA + tok * 384 + head * 96 + part * 32 + 4 * hi) : (VA + tok * 256 + head * 64 + (part - 2) * 32 + 4 * hi);
#pragma unroll
                for (int g = 0; g < 4; ++g) { u32x2 w; w.x = cvtpk(acc[4 * g], acc[4 * g + 1]); w.y = cvtpk(acc[4 * g + 2], acc[4 * g + 3]); *(GAS u32x2*)(dst + 8 * g) = w; }
            }
            if (sn + 1 < 16) { if (sn & 1) W_WRITE(sn + 1, 0); else W_WRITE(sn + 1, 1); }
            __syncthreads();
        }
#undef W_LOAD
#undef W_WRITE
        if (path == 1) {
            const u32x4 k0 = *(const GAS u32x4*)(KR + tok * 32 + 16 * hi), k1 = *(const GAS u32x4*)(KR + tok * 32 + 16 * hi + 8);
#pragma unroll
            for (int h = 0; h < 4; ++h) { *(GAS u32x4*)(KA + tok * 384 + h * 96 + 64 + 16 * hi) = k0; *(GAS u32x4*)(KA + tok * 384 + h * 96 + 64 + 16 * hi + 8) = k1; }
        }
    }
}

__device__ __forceinline__ void p1c_moba_gate(Frame& F, int l) {
    unsigned char* ws = F.ws;
    const bf16_t* Qb = (const bf16_t*)(ws + WS_QKV);
    const float* KM = (const float*)(F.ctl + CW_KMEAN) + (size_t)l * (8 * 6 * 16 * 64);
    unsigned* cnt = (unsigned*)(F.ctl + CW_MOBA) + (size_t)l * 768 * 64;
    int* list = (int*)(ws + WS_MLIST);
    const int gw = F.vcu * NWAVES + F.wave, NGW = F.G * NWAVES, lane = lane_now(), r32 = lane & 31, hi = lane >> 5;
    for (int tw = gw; tw < 48 * 128; tw += NGW) {
        const int bh = tw >> 7, qg = tw & 127, nb = qg >> 3;
        if (nb == 0) continue;
        const int b = bh / 6, h = bh % 6, t = 32 * qg + r32;
        const bf16_t* qrow = Qb + ((size_t)b * SEQ + t) * 384 + h * 64 + 8 * hi;
        int i1 = 0, i2 = 1, i3 = 2;
        if (nb > 3) {
            bf16x8 qr[4];
#pragma unroll
            for (int d0 = 0; d0 < 4; ++d0) qr[d0] = *(const GAS bf16x8*)(qrow + 16 * d0);
            LAS float* kml = (LAS float*)(F.lds + F.wave * 4096);
            { const float* kmg = KM + (size_t)bh * 16 * 64 + 4 * lane; f32x4 t_[4];
#pragma unroll
              for (int i = 0; i < 4; ++i) t_[i] = *(const GAS f32x4*)(kmg + 256 * i);
#pragma unroll
              for (int i = 0; i < 4; ++i) *(LAS f32x4*)(kml + 4 * lane + 256 * i) = t_[i]; }
            asm volatile("" ::: "memory");
            float v1 = -3e38f, v2 = -3e38f, v3 = -3e38f;
#pragma unroll
            for (int j = 0; j < 15; ++j) {
                if (j < nb) {
                    float g = 0.f;
#pragma unroll
                    for (int d0 = 0; d0 < 4; ++d0) { const LAS float* kp = kml + j * 64 + 16 * d0 + 8 * hi; const f32x4 a = *(const LAS f32x4*)kp, bb = *(const LAS f32x4*)(kp + 4);
                        const bf16x8 qv = qr[d0];
#define QF(e) bf2f((unsigned short)qv[e])
                        g += QF(0) * a[0] + QF(1) * a[1] + QF(2) * a[2] + QF(3) * a[3] + QF(4) * bb[0] + QF(5) * bb[1] + QF(6) * bb[2] + QF(7) * bb[3];
#undef QF
                    }
                    g += xhalf(g);
                    if (g > v1) { v3 = v2; i3 = i2; v2 = v1; i2 = i1; v1 = g; i1 = j; }
                    else if (g > v2) { v3 = v2; i3 = i2; v2 = g; i2 = j; }
                    else if (g > v3) { v3 = g; i3 = j; }
                }
            }
        }
        asm volatile("" ::: "memory");
        if (hi == 0) {
            const int ns = nb < 3 ? nb : 3;
#pragma unroll
            for (int sl = 0; sl < 3; ++sl) {
                if (sl < ns) { const int blk = (sl == 0) ? i1 : (sl == 1 ? i2 : i3);
                    const unsigned pos = atomicAdd(cnt + (size_t)(bh * 16 + blk) * 64, 1u);
                    list[(size_t)(bh * 16 + blk) * MOBA_CAP + pos] = (t << 2) | sl; }
            }
        }
    }
}

typedef const LAS char* lds_cptr;
typedef short v4i16_t __attribute__((ext_vector_type(4)));
__device__ __forceinline__ s16x4 vtr(lds_cptr p) { return __builtin_bit_cast(s16x4, __builtin_amdgcn_ds_read_tr16_b64_v4i16((LAS v4i16_t*)p)); }
#define MX3(a, b, c) __builtin_fmaxf(__builtin_fmaxf((a), (b)), (c))
__device__ __forceinline__ float rowmax32(const f32x16& p0, const f32x16& p1) {
    float a = MX3(p0[0], p0[1], p1[0]), b = MX3(p0[2], p0[3], p1[1]); a = MX3(a, p1[2], p1[3]);
#pragma unroll
    for (int r = 4; r < 16; r += 4) { a = MX3(a, p0[r], p0[r + 1]); b = MX3(b, p0[r + 2], p0[r + 3]); a = MX3(a, p1[r], p1[r + 1]); b = MX3(b, p1[r + 2], p1[r + 3]); }
    const float m = __builtin_fmaxf(a, b); auto rr = __builtin_amdgcn_permlane32_swap(__float_as_uint(m), __float_as_uint(m), false, false);
    return __builtin_fmaxf(__uint_as_float(rr[0]), __uint_as_float(rr[1]));
}
struct AttnSt { f32x16 o0, o1, o2; float mhat; int first; };
constexpr float NEG_BIG = -1e30f, SM_THR = 8.0f;
__device__ __forceinline__ void attn_init(AttnSt& st) { st.o0 = f32x16{}; st.o1 = f32x16{}; st.o2 = f32x16{}; st.mhat = 0.f; st.first = 1; }

template <int DK, bool SPLIT = false>
__device__ __forceinline__ void qk_tile(f32x16& p0, f32x16& p1, lds_cptr K, const bf16x8* qr, const float mhat, int r32, int hi) {
    constexpr int RB = (DK > 64) ? 256 : 128;
    f32x16 negm;
#pragma unroll
    for (int r = 0; r < 16; ++r) negm[r] = -mhat;
    const lds_cptr kb = K + r32 * RB; const int sw = r32 & 7;
    if constexpr (SPLIT) {
        bf16x8 kf[DK / 16];
#pragma unroll
        for (int d0 = 0; d0 < DK / 16; ++d0) kf[d0] = *(const LAS bf16x8*)(kb + ((2 * d0 + hi) ^ sw) * 16);
        __builtin_amdgcn_sched_barrier(0);
#pragma unroll
        for (int d0 = 0; d0 < DK / 16; ++d0) p0 = MFMA32(kf[d0], qr[d0], d0 == 0 ? negm : p0);
        __builtin_amdgcn_sched_barrier(0);
#pragma unroll
        for (int d0 = 0; d0 < DK / 16; ++d0) kf[d0] = *(const LAS bf16x8*)(kb + 32 * RB + ((2 * d0 + hi) ^ sw) * 16);
        __builtin_amdgcn_sched_barrier(0);
#pragma unroll
        for (int d0 = 0; d0 < DK / 16; ++d0) p1 = MFMA32(kf[d0], qr[d0], d0 == 0 ? negm : p1);
        return;
    }
    bf16x8 kf0[DK / 16], kf1[DK / 16];
#pragma unroll
    for (int d0 = 0; d0 < DK / 16; ++d0) { const int co = ((2 * d0 + hi) ^ sw) * 16; kf0[d0] = *(const LAS bf16x8*)(kb + co); kf1[d0] = *(const LAS bf16x8*)(kb + 32 * RB + co); }
    __builtin_amdgcn_sched_barrier(0);
#pragma unroll
    for (int d0 = 0; d0 < DK / 16; ++d0) { p0 = MFMA32(kf0[d0], qr[d0], d0 == 0 ? negm : p0); p1 = MFMA32(kf1[d0], qr[d0], d0 == 0 ? negm : p1); }
}
__device__ __forceinline__ void softmax_step(f32x16& p0, f32x16& p1, AttnSt& st, LAS float* wsf, int r32, int hi, u32x4 (&pw)[4]) {
    const float rm = rowmax32(p0, p1);
    const bool first = st.first != 0;
    if (first || __any(rm > SM_THR)) {
        const float dl = first ? ((rm < -1e29f) ? 0.f : rm) : __builtin_fmaxf(rm, 0.f);
        st.mhat += dl;
#pragma unroll
        for (int r = 0; r < 16; ++r) { p0[r] -= dl; p1[r] -= dl; }
        if (!first) {
            const float f = __builtin_amdgcn_exp2f(-dl);
            if (hi == 0) wsf[r32] = f;
#pragma unroll
            for (int r = 0; r < 16; ++r) { const float a = wsf[crow(r, hi)]; st.o0[r] *= a; st.o1[r] *= a; st.o2[r] *= a; }
        }
        st.first = 0;
    }
#pragma unroll
    for (int r = 0; r < 16; ++r) { p0[r] = __builtin_amdgcn_exp2f(p0[r]); p1[r] = __builtin_amdgcn_exp2f(p1[r]); }
    pw[0] = (u32x4){cvtpk(p0[0], p0[1]), cvtpk(p0[2], p0[3]), cvtpk(p0[4], p0[5]), cvtpk(p0[6], p0[7])};
    pw[1] = (u32x4){cvtpk(p0[8], p0[9]), cvtpk(p0[10], p0[11]), cvtpk(p0[12], p0[13]), cvtpk(p0[14], p0[15])};
    pw[2] = (u32x4){cvtpk(p1[0], p1[1]), cvtpk(p1[2], p1[3]), cvtpk(p1[4], p1[5]), cvtpk(p1[6], p1[7])};
    pw[3] = (u32x4){cvtpk(p1[8], p1[9]), cvtpk(p1[10], p1[11]), cvtpk(p1[12], p1[13]), cvtpk(p1[14], p1[15])};
}
struct VFrag { s16x4 l0[4], h0[4], l1[4], h1[4]; };
__device__ __forceinline__ void pv_load(VFrag& vf, lds_cptr V, int lane) {
    const int hi = lane >> 5;
    const lds_cptr vp = V + ((lane >> 4) & 1) * 32 + (lane & 3) * 8 + (4 * hi + ((lane & 15) >> 2)) * 64;
#pragma unroll
    for (int ks = 0; ks < 4; ++ks) { vf.l0[ks] = vtr(vp + ks * 1024); vf.h0[ks] = vtr(vp + ks * 1024 + 512); vf.l1[ks] = vtr(vp + 4096 + ks * 1024); vf.h1[ks] = vtr(vp + 4096 + ks * 1024 + 512); }
    __builtin_amdgcn_sched_barrier(0);
}
__device__ __forceinline__ void pv_mma(AttnSt& st, const VFrag& vf, const u32x4 (&pw)[4]) {
#pragma unroll
    for (int ks = 0; ks < 4; ++ks) {
        const bf16x8 f0 = {vf.l0[ks][0], vf.l0[ks][1], vf.l0[ks][2], vf.l0[ks][3], vf.h0[ks][0], vf.h0[ks][1], vf.h0[ks][2], vf.h0[ks][3]};
        const bf16x8 f1 = {vf.l1[ks][0], vf.l1[ks][1], vf.l1[ks][2], vf.l1[ks][3], vf.h1[ks][0], vf.h1[ks][1], vf.h1[ks][2], vf.h1[ks][3]};
        const bf16x8 pa = __builtin_bit_cast(bf16x8, pw[ks]);
        const bf16x8 ones = {0x3F80, 0x3F80, 0x3F80, 0x3F80, 0x3F80, 0x3F80, 0x3F80, 0x3F80};
        st.o0 = MFMA32(pa, f0, st.o0); st.o1 = MFMA32(pa, f1, st.o1); st.o2 = MFMA32(pa, ones, st.o2); }
}
__device__ __forceinline__ void pv_tile(AttnSt& st, lds_cptr V, const u32x4 (&pw)[4], int lane) { VFrag vf; pv_load(vf, V, lane); pv_mma(st, vf, pw); }
__device__ __forceinline__ void attn_finish(AttnSt& st, LAS float* wsf, int r32, int hi, float (&rli)[16], float& lse2) {
    if (r32 == 0) {
#pragma unroll
        for (int r = 0; r < 16; ++r) wsf[32 + crow(r, hi)] = st.o2[r]; }
#pragma unroll
    for (int r = 0; r < 16; ++r) rli[r] = __builtin_amdgcn_rcpf(st.o2[r]);
    lse2 = st.mhat + __builtin_amdgcn_logf(wsf[32 + r32]);
}

constexpr int AL_K0 = 0, AL_K1 = 16384, AL_V0 = 32768, AL_V1 = 40960, AL_WSF = 65536, AL_OST = 67584;
constexpr int AL_M = 67584, AL_ML = 67584 + 65536;

template <int DK>
__device__ __forceinline__ void attn_shared_unit(Frame& F, const bf16_t* Qp, int qpitch, const bf16_t* Kp, int kpitch, const bf16_t* Vp, int vpitch, bf16_t* Op,
                                                 int q0, int NT, float sc, bool moba, const float* km, const int abl) {
    const int lane = lane_now(), wid = F.wave, tid = wid * 64 + lane, r32 = lane & 31, hi = lane >> 5;
    LAS unsigned char* lds = F.lds; LAS float* wsf = (LAS float*)(lds + AL_WSF) + wid * 64;
    bf16x8 qr[DK / 16];
    { const bf16_t* qrow = Qp + (size_t)(q0 + wid * 32 + r32) * qpitch + 8 * hi;
#pragma unroll
      for (int d0 = 0; d0 < DK / 16; ++d0) qr[d0] = *(const GAS bf16x8*)(qrow + 16 * d0); }
    constexpr int RB = (DK > 64) ? 256 : 128;
    const int krow = tid >> 3, kch = tid & 7, vdh = tid >> 8, vrow = (tid >> 2) & 63, vc4 = tid & 3;
    const int krow2 = (tid >> 2) & 63, kch2 = 8 + (tid & 3);
    const bf16_t* ksrc = Kp + (size_t)krow * kpitch + kch * 8;
    const bf16_t* ksrc2 = Kp + (size_t)krow2 * kpitch + kch2 * 8;
    const bf16_t* vsrc = Vp + (size_t)vrow * vpitch + vdh * 32 + vc4 * 8;
    const int kdst = krow * RB + ((kch ^ (krow & 7)) * 16), kdst2 = krow2 * RB + ((kch2 ^ (krow2 & 7)) * 16), vdst = vdh * 4096 + vrow * 64 + vc4 * 16;
    const bool k2 = (DK > 64) && (tid < 256);
    u32x4 kreg0, kreg1, vreg; { unsigned z_ = 0u; asm volatile("" : "+v"(z_)); kreg1 = (u32x4){z_, z_, z_, z_}; }
    kreg0 = *(const GAS u32x4*)ksrc; if (k2) kreg1 = *(const GAS u32x4*)ksrc2; vreg = *(const GAS u32x4*)vsrc;
    *(LAS u32x4*)(lds + AL_K0 + kdst) = kreg0; if (k2) *(LAS u32x4*)(lds + AL_K0 + kdst2) = kreg1; *(LAS u32x4*)(lds + AL_V0 + vdst) = vreg;
    __syncthreads();
    AttnSt st; attn_init(st);
    const int qrel = wid * 32 + r32;
#pragma unroll 1
    for (int t = 0; t < NT; ++t) {
        const int cur = t & 1;
        const bool more = (t + 1 < NT);
        if (more) { const size_t ro = (size_t)(t + 1) * 64;
            kreg0 = *(const GAS u32x4*)(ksrc + ro * kpitch); if (k2) kreg1 = *(const GAS u32x4*)(ksrc2 + ro * kpitch); vreg = *(const GAS u32x4*)(vsrc + ro * vpitch); }
        const int jb = t - (NT - 4);
        const bool active = (jb < 0) || (64 * jb <= 32 * wid + 31);
        if (active) {
            const lds_cptr Kb = (lds_cptr)(lds + (cur ? AL_K1 : AL_K0)), Vb = (lds_cptr)(lds + (cur ? AL_V1 : AL_V0));
            f32x16 p0, p1;
            qk_tile<DK>(p0, p1, Kb, qr, st.mhat, r32, hi);
            if (jb >= 0) {
#pragma unroll
                for (int r = 0; r < 16; ++r) { const int kv = 64 * jb + crow(r, hi); p0[r] = (kv > qrel) ? NEG_BIG : p0[r]; p1[r] = (kv + 32 > qrel) ? NEG_BIG : p1[r]; }
            }
            VFrag vf; pv_load(vf, Vb, lane);
            u32x4 pw[4];
            softmax_step(p0, p1, st, wsf, r32, hi, pw);
            pv_mma(st, vf, pw);
        }
        if (more) { const int kb = cur ? AL_K0 : AL_K1, vb = cur ? AL_V0 : AL_V1;
            *(LAS u32x4*)(lds + kb + kdst) = kreg0; if (k2) *(LAS u32x4*)(lds + kb + kdst2) = kreg1; *(LAS u32x4*)(lds + vb + vdst) = vreg; }
        __syncthreads();
    }
    float rli[16], lse2; attn_finish(st, wsf, r32, hi, rli, lse2);
    LAS bf16_t* stg = (LAS bf16_t*)(lds + AL_OST) + wid * 2048;
#pragma unroll
    for (int r = 0; r < 16; ++r) { const int orow = crow(r, hi); const unsigned w_ = cvtpk(st.o0[r] * rli[r], st.o1[r] * rli[r]); stg[orow * 64 + r32] = (bf16_t)(w_ & 0xffffu); stg[orow * 64 + 32 + r32] = (bf16_t)(w_ >> 16); }
#pragma unroll
    for (int i = 0; i < 4; ++i) { const int row = i * 8 + (lane >> 3), ch = lane & 7; const u32x4 v = *(const LAS u32x4*)(stg + row * 64 + ch * 8);
        *(GAS u32x4*)(Op + (size_t)(q0 + wid * 32 + row) * 1024 + ch * 8) = v; }
    __syncthreads();
}

__device__ __forceinline__ void dil_step(int sidx, int wid, int p0, int& dil, int& tres, int& lf) {
    if (sidx < 3) { dil = 1; tres = 0; lf = p0 - 128 + 64 * ((wid >> 1) + sidx); }
    else if (sidx < 6) { dil = 4; tres = wid >> 1; lf = (p0 >> 2) - 128 + 64 * (sidx - 3); }
    else { const int s = sidx - 6; dil = 16; tres = 2 * wid + (s >= 3 ? 1 : 0); lf = (p0 >> 4) - 128 + 64 * (s >= 3 ? s - 3 : s); }
}
__device__ __forceinline__ unsigned dil_rowoff(int dil, int tres, int lf, int lane, int i) {
    int kpos = (lf + 8 * i + (lane >> 3)) * dil + tres; kpos = kpos < 0 ? 0 : (kpos > SEQ - 1 ? SEQ - 1 : kpos); return (unsigned)kpos * 384u + (unsigned)(lane & 7) * 8u;
}
__device__ __forceinline__ void dil_query(int br, int wid, int p0, int r32, int& dil, int& rrq, int& lq) {
    if (br == 0) { dil = 1; rrq = 0; lq = p0 + 32 * wid + r32; }
    else if (br == 1) { dil = 4; rrq = wid >> 1; lq = (p0 >> 2) + 32 * (wid & 1) + r32; }
    else { dil = 16; rrq = 2 * wid + (r32 >> 4); lq = (p0 >> 4) + (r32 & 15); }
}
#ifdef TIMING_SEG
#define TSTAMP(i) do { if ((abl & 128) && ((i) == 0 || (i) == 6 || (i) == TIMING_SEG || (i) == TIMING_SEG + 1)) { __builtin_amdgcn_sched_barrier(0); unsigned long long t_; asm volatile("s_memtime %0\n\ts_waitcnt lgkmcnt(0)" : "=s"(t_) :: "memory"); __builtin_amdgcn_sched_barrier(0); \
    const unsigned tl_ = (unsigned)t_; \
    if (tprobe) { if ((i) == 0) atomicAdd(tw + 1, 0u - tl_); if ((i) == TIMING_SEG) atomicAdd(tw, 0u - tl_); if ((i) == TIMING_SEG + 1) atomicAdd(tw, tl_); if ((i) == 6) atomicAdd(tw + 1, tl_); } } } while (0)
#else
#define TSTAMP(i) do {} while (0)
#endif
constexpr int DL_M = 98304, DL_ML = 131072, DL_WSF = 132096;
__device__ __forceinline__ void attn_dilated_unit(Frame& F, const bf16_t* Qc, const bf16_t* Kc, const bf16_t* Vc, bf16_t* Op, float* L14, int p0, const int abl) {
    const int lane = lane_now(), wid = F.wave, tid = wid * 64 + lane, r32 = lane & 31, hi = lane >> 5;
    LAS unsigned char* lds = F.lds; LAS float* wsf = (LAS float*)(lds + DL_WSF) + wid * 64;
    LAS bf16_t* M = (LAS bf16_t*)(lds + DL_M); LAS float* ML = (LAS float*)(lds + DL_ML);
    const int srow = tid >> 3, sch = tid & 7;
    const int skd = srow * 128 + ((sch ^ (srow & 7)) * 16), svd = 8192 + (sch >> 2) * 4096 + srow * 64 + (sch & 3) * 16;
    bf16x8 qr[4];
    { const bf16_t* qrow = Qc + (size_t)(p0 + 32 * wid + r32) * 384 + 8 * hi;
#pragma unroll
      for (int d0 = 0; d0 < 4; ++d0) qr[d0] = *(const GAS bf16x8*)(qrow + 16 * d0); }
    { u32x4 kk[6], vv[6];
#pragma unroll
      for (int i = 0; i < 6; ++i) { int kpos = p0 - 128 + 64 * i + srow; kpos = kpos < 0 ? 0 : kpos; const size_t off = (size_t)kpos * 384 + sch * 8;
          kk[i] = *(const GAS u32x4*)(Kc + off); vv[i] = *(const GAS u32x4*)(Vc + off); }
#pragma unroll
      for (int i = 0; i < 6; ++i) { *(LAS u32x4*)(lds + i * 16384 + skd) = kk[i]; *(LAS u32x4*)(lds + i * 16384 + svd) = vv[i]; } }
    __syncthreads();
    u32x4 k1[4], v1[4];
#pragma unroll
    for (int t = 0; t < 4; ++t) { int kpos = ((p0 >> 2) - 128 + srow) * 4 + t; kpos = kpos < 0 ? 0 : kpos; const size_t off = (size_t)kpos * 384 + sch * 8;
        k1[t] = *(const GAS u32x4*)(Kc + off); v1[t] = *(const GAS u32x4*)(Vc + off); }
    {
        const int lq = p0 + 32 * wid + r32;
        AttnSt st; attn_init(st);
#pragma unroll 1
        for (int s = 0; s < 3; ++s) {
            const int ti = (wid >> 1) + s, lf = p0 - 128 + 64 * ti;
            const lds_cptr Kb = (lds_cptr)(lds + ti * 16384), Vb = Kb + 8192;
            f32x16 p0s, p1s;
            qk_tile<64>(p0s, p1s, Kb, qr, st.mhat, r32, hi);
#pragma unroll
            for (int r = 0; r < 16; ++r) {
                const int lk0 = lf + crow(r, hi), lk1 = lk0 + 32; const int d0_ = lq - lk0, d1_ = lq - lk1;
                const bool ok0 = (lk0 >= 0) && (d0_ >= 0) && (d0_ <= 128), ok1 = (lk1 >= 0) && (d1_ >= 0) && (d1_ <= 128);
                p0s[r] = ok0 ? p0s[r] : NEG_BIG; p1s[r] = ok1 ? p1s[r] : NEG_BIG; }
            VFrag vf; pv_load(vf, Vb, lane);
            u32x4 pw[4];
            softmax_step(p0s, p1s, st, wsf, r32, hi, pw);
            pv_mma(st, vf, pw);
        }
        float rli[16], lse2; attn_finish(st, wsf, r32, hi, rli, lse2);
#pragma unroll
        for (int r = 0; r < 16; ++r) { const int row = 32 * wid + crow(r, hi); const unsigned w_ = cvtpk(st.o0[r] * rli[r], st.o1[r] * rli[r]);
            M[row * 64 + r32] = (bf16_t)(w_ & 0xffffu); M[row * 64 + 32 + r32] = (bf16_t)(w_ >> 16); }
        if (hi == 0) ML[32 * wid + r32] = lse2;
    }
    __syncthreads();
    {
        const int rr = wid >> 1, lq = (p0 >> 2) + 32 * (wid & 1) + r32;
        { const bf16_t* qrow = Qc + (size_t)(lq * 4 + rr) * 384 + 8 * hi;
#pragma unroll
          for (int d0 = 0; d0 < 4; ++d0) qr[d0] = *(const GAS bf16x8*)(qrow + 16 * d0); }
        AttnSt st; attn_init(st);
#pragma unroll 1
        for (int s = 0; s < 3; ++s) {
#pragma unroll
            for (int t = 0; t < 4; ++t) { *(LAS u32x4*)(lds + t * 16384 + skd) = k1[t]; *(LAS u32x4*)(lds + t * 16384 + svd) = v1[t]; }
            __syncthreads();
            if (s < 2) {
#pragma unroll
                for (int t = 0; t < 4; ++t) { int kpos = ((p0 >> 2) - 128 + 64 * (s + 1) + srow) * 4 + t; kpos = kpos < 0 ? 0 : kpos; const size_t off = (size_t)kpos * 384 + sch * 8;
                    k1[t] = *(const GAS u32x4*)(Kc + off); v1[t] = *(const GAS u32x4*)(Vc + off); } }
            const int lf = (p0 >> 2) - 128 + 64 * s;
            const lds_cptr Kb = (lds_cptr)(lds + rr * 16384), Vb = Kb + 8192;
            f32x16 p0s, p1s;
            qk_tile<64>(p0s, p1s, Kb, qr, st.mhat, r32, hi);
#pragma unroll
            for (int r = 0; r < 16; ++r) {
                const int lk0 = lf + crow(r, hi), lk1 = lk0 + 32; const int d0_ = lq - lk0, d1_ = lq - lk1;
                const bool ok0 = (lk0 >= 0) && (d0_ >= 0) && (d0_ <= 128), ok1 = (lk1 >= 0) && (d1_ >= 0) && (d1_ <= 128);
                p0s[r] = ok0 ? p0s[r] : NEG_BIG; p1s[r] = ok1 ? p1s[r] : NEG_BIG; }
            VFrag vf; pv_load(vf, Vb, lane);
            u32x4 pw[4];
            softmax_step(p0s, p1s, st, wsf, r32, hi, pw);
            pv_mma(st, vf, pw);
            __syncthreads();
        }
        float rli[16], lse2; attn_finish(st, wsf, r32, hi, rli, lse2);
#define PROW(q) (4 * (32 * (wid & 1) + (q)) + rr)
        if (hi == 0) wsf[r32] = lse2;
        LAS bf16_t* stg = (LAS bf16_t*)lds + wid * 2048;
#pragma unroll
        for (int r = 0; r < 16; ++r) { const int q = crow(r, hi), row = PROW(q); const float lb = wsf[q], la = ML[row]; const float mx = __builtin_fmaxf(la, lb);
            const float wa = __builtin_amdgcn_exp2f(la - mx), wb = __builtin_amdgcn_exp2f(lb - mx), inv = __builtin_amdgcn_rcpf(wa + wb);
            const float m0 = bf2f(M[row * 64 + r32]), m1 = bf2f(M[row * 64 + 32 + r32]);
            const unsigned w_ = cvtpk((wa * m0 + wb * (st.o0[r] * rli[r])) * inv, (wa * m1 + wb * (st.o1[r] * rli[r])) * inv);
            stg[q * 64 + r32] = (bf16_t)(w_ & 0xffffu); stg[q * 64 + 32 + r32] = (bf16_t)(w_ >> 16); }
        if (hi == 0) { const int row = PROW(r32); const float la = ML[row], lb = lse2, mx = __builtin_fmaxf(la, lb);
            L14[(size_t)(p0 + row) * 6] = mx + __builtin_amdgcn_logf(__builtin_amdgcn_exp2f(la - mx) + __builtin_amdgcn_exp2f(lb - mx)); }
        asm volatile("" ::: "memory");
#pragma unroll
        for (int i = 0; i < 4; ++i) { const int q = i * 8 + (lane >> 3), ch = lane & 7; const u32x4 v = *(const LAS u32x4*)(stg + q * 64 + ch * 8);
            *(GAS u32x4*)(Op + (size_t)(p0 + PROW(q)) * 1024 + ch * 8) = v; }
#undef PROW
    }
    __syncthreads();
}

constexpr int AL_MK = 0, AL_MV = 32768, AL_ENT = 100352;
__device__ __forceinline__ void moba_emit(LAS unsigned char* lds, int wid, int lane, AttnSt& st, int myidx, bf16_t* PBo, float* PBl) {
    const int r32 = lane & 31, hi = lane >> 5;
    LAS float* wsf = (LAS float*)(lds + AL_WSF) + wid * 64; LAS int* ent = (LAS int*)(lds + AL_ENT) + wid * 32;
    float rli[16], lse2; attn_finish(st, wsf, r32, hi, rli, lse2);
    if (hi == 0) { ent[r32] = myidx; if (myidx >= 0) PBl[myidx] = lse2; }
    LAS bf16_t* stg = (LAS bf16_t*)(lds + AL_OST) + wid * 2048;
#pragma unroll
    for (int r = 0; r < 16; ++r) { const int orow = crow(r, hi); const unsigned w_ = cvtpk(st.o0[r] * rli[r], st.o1[r] * rli[r]); stg[orow * 64 + r32] = (bf16_t)(w_ & 0xffffu); stg[orow * 64 + 32 + r32] = (bf16_t)(w_ >> 16); }
    asm volatile("" ::: "memory");
#pragma unroll
    for (int i = 0; i < 4; ++i) { const int row = i * 8 + (lane >> 3), ch = lane & 7; const int idx = ent[row]; const u32x4 v = *(const LAS u32x4*)(stg + row * 64 + ch * 8);
        if (idx >= 0) *(GAS u32x4*)(PBo + (size_t)idx * 64 + ch * 8) = v; }
    asm volatile("" ::: "memory");
}
__device__ __forceinline__ void attn_moba_kb_unit(Frame& F, const bf16_t* Qp, const bf16_t* Kp, const bf16_t* Vp, bf16_t* PBo, float* PBl, int j, const int* list, int n, const int abl) {
    const int lane = lane_now(), wid = F.wave, tid = wid * 64 + lane, r32 = lane & 31, hi = lane >> 5;
    LAS unsigned char* lds = F.lds; LAS float* wsf = (LAS float*)(lds + AL_WSF) + wid * 64;
    { u32x4 kk[4], vv[4];
#pragma unroll
      for (int i = 0; i < 4; ++i) { const int pc = tid + 512 * i, row = pc >> 3, ch = pc & 7; const size_t so = (size_t)(256 * j + row) * 384 + ch * 8;
          kk[i] = *(const GAS u32x4*)(Kp + so); vv[i] = *(const GAS u32x4*)(Vp + so); }
#pragma unroll
      for (int i = 0; i < 4; ++i) { const int pc = tid + 512 * i, row = pc >> 3, ch = pc & 7;
          *(LAS u32x4*)(lds + AL_MK + row * 128 + ((ch ^ (row & 7)) * 16)) = kk[i];
          *(LAS u32x4*)(lds + AL_MV + (row >> 6) * 8192 + (ch >> 2) * 4096 + (row & 63) * 64 + (ch & 3) * 16) = vv[i]; } }
    __syncthreads();
    { const int tq = 256 * j + 32 * wid + r32, qrel = 32 * wid + r32;
      bf16x8 qr[4]; const bf16_t* qrow = Qp + (size_t)tq * 384 + 8 * hi;
#pragma unroll
      for (int d0 = 0; d0 < 4; ++d0) qr[d0] = *(const GAS bf16x8*)(qrow + 16 * d0);
      AttnSt st; attn_init(st);
#pragma unroll 1
      for (int tt = 0; tt <= (wid >> 1); ++tt) {
          f32x16 p0, p1; qk_tile<64>(p0, p1, (lds_cptr)(lds + AL_MK + tt * 8192), qr, st.mhat, r32, hi);
#pragma unroll
          for (int r = 0; r < 16; ++r) { const int kv = 64 * tt + crow(r, hi); p0[r] = (kv > qrel) ? NEG_BIG : p0[r]; p1[r] = (kv + 32 > qrel) ? NEG_BIG : p1[r]; }
          VFrag vf; pv_load(vf, (lds_cptr)(lds + AL_MV + tt * 8192), lane);
          u32x4 pw[4]; softmax_step(p0, p1, st, wsf, r32, hi, pw); pv_mma(st, vf, pw); }
      moba_emit(lds, wid, lane, st, tq * 4 + 3, PBo, PBl); }
    const int ng = (n + 31) >> 5;
#pragma unroll 1
    for (int g = wid; g < ng; g += NWAVES) {
        const int ei = 32 * g + r32; const bool valid = ei < n; const int e = list[valid ? ei : 0];
        const int tq = e >> 2, myidx = valid ? (tq * 4 + (e & 3)) : -1;
        bf16x8 qr[4]; const bf16_t* qrow = Qp + (size_t)tq * 384 + 8 * hi;
#pragma unroll
        for (int d0 = 0; d0 < 4; ++d0) qr[d0] = *(const GAS bf16x8*)(qrow + 16 * d0);
        AttnSt st; attn_init(st);
#pragma unroll 1
        for (int t8 = 0; t8 < ((abl & 256) ? 8 : 4); ++t8) { const int tt = t8 & 3;
            f32x16 p0, p1; qk_tile<64>(p0, p1, (lds_cptr)(lds + AL_MK + tt * 8192), qr, st.mhat, r32, hi);
            VFrag vf; pv_load(vf, (lds_cptr)(lds + AL_MV + tt * 8192), lane);
            u32x4 pw[4]; softmax_step(p0, p1, st, wsf, r32, hi, pw); pv_mma(st, vf, pw); }
        moba_emit(lds, wid, lane, st, myidx, PBo, PBl);
    }
    __syncthreads();
}
constexpr int AL_OSTF = 67584;
__device__ __forceinline__ void d16_load(const bf16_t* Kc, const bf16_t* Vc, int rr, int tid, u32x4 (&kk)[4], u32x4 (&vv)[4]) {
#pragma unroll
    for (int i = 0; i < 4; ++i) { const int pc = tid + 512 * i, row = pc >> 3, ch = pc & 7; const size_t so = (size_t)(16 * row + rr) * 384 + ch * 8;
        kk[i] = *(const GAS u32x4*)(Kc + so); vv[i] = *(const GAS u32x4*)(Vc + so); }
}
__device__ __forceinline__ void attn_d16_unit(Frame& F, const bf16_t* Qc, bf16_t* Op, const float* L14, int rr, u32x4 (&kk)[4], u32x4 (&vv)[4],
                                              const bool has_next, const bf16_t* Kn, const bf16_t* Vn, int rrn) {
    const int lane = lane_now(), wid = F.wave, tid = wid * 64 + lane, r32 = lane & 31, hi = lane >> 5;
    LAS unsigned char* lds = F.lds; LAS float* wsf = (LAS float*)(lds + AL_WSF) + wid * 64;
#pragma unroll
    for (int i = 0; i < 4; ++i) { const int pc = tid + 512 * i, row = pc >> 3, ch = pc & 7;
        *(LAS u32x4*)(lds + AL_MK + row * 128 + ((ch ^ (row & 7)) * 16)) = kk[i];
        *(LAS u32x4*)(lds + AL_MV + (row >> 6) * 8192 + (ch >> 2) * 4096 + (row & 63) * 64 + (ch & 3) * 16) = vv[i]; }
    __syncthreads();
    if (has_next) d16_load(Kn, Vn, rrn, tid, kk, vv);
    const int lq = 32 * wid + r32;
    bf16x8 qr[4]; { const bf16_t* qrow = Qc + (size_t)(16 * lq + rr) * 384 + 8 * hi;
#pragma unroll
      for (int d0 = 0; d0 < 4; ++d0) qr[d0] = *(const GAS bf16x8*)(qrow + 16 * d0); }
    AttnSt st; attn_init(st);
    const int t_lo = (32 * wid - 128) < 0 ? 0 : ((32 * wid - 128) >> 6), t_hi = (32 * wid + 31) >> 6;
#pragma unroll 1
    for (int tt = t_lo; tt <= t_hi; ++tt) {
        f32x16 p0, p1; qk_tile<64>(p0, p1, (lds_cptr)(lds + AL_MK + tt * 8192), qr, st.mhat, r32, hi);
#pragma unroll
        for (int r = 0; r < 16; ++r) { const int d0_ = lq - (64 * tt + crow(r, hi)), d1_ = d0_ - 32;
            p0[r] = (d0_ >= 0 && d0_ <= 128) ? p0[r] : NEG_BIG; p1[r] = (d1_ >= 0 && d1_ <= 128) ? p1[r] : NEG_BIG; }
        VFrag vf; pv_load(vf, (lds_cptr)(lds + AL_MV + tt * 8192), lane);
        u32x4 pw[4]; softmax_step(p0, p1, st, wsf, r32, hi, pw); pv_mma(st, vf, pw); }
    float rli[16], lse2; attn_finish(st, wsf, r32, hi, rli, lse2);
    LAS float* ostf = (LAS float*)(lds + AL_OSTF) + wid * 2048;
    asm volatile("" ::: "memory");
    if (hi == 0) wsf[r32] = lse2;
#pragma unroll
    for (int r = 0; r < 16; ++r) { const int orow = crow(r, hi); ostf[orow * 64 + r32] = st.o0[r] * rli[r]; ostf[orow * 64 + 32 + r32] = st.o1[r] * rli[r]; }
    asm volatile("" ::: "memory");
#pragma unroll
    for (int i = 0; i < 4; ++i) { const int row = i * 8 + (lane >> 3), ch = lane & 7; const size_t tq = (size_t)16 * (32 * wid + row) + rr;
        const float lb = wsf[row], la = L14[tq * 6]; const float mx = __builtin_fmaxf(la, lb);
        const float wa = __builtin_amdgcn_exp2f(la - mx), wb = __builtin_amdgcn_exp2f(lb - mx), inv = 1.0f / (wa + wb), ca = wa * inv, cb = wb * inv;
        const f32x4 b0 = *(const LAS f32x4*)(ostf + row * 64 + ch * 8), b1 = *(const LAS f32x4*)(ostf + row * 64 + ch * 8 + 4);
        bf16_t* op = Op + tq * 1024 + ch * 8; const u32x4 v = *(const GAS u32x4*)op;
        u32x4 o; o.x = cvtpk(ca * bflo(v.x) + cb * b0[0], ca * bfhi(v.x) + cb * b0[1]); o.y = cvtpk(ca * bflo(v.y) + cb * b0[2], ca * bfhi(v.y) + cb * b0[3]);
        o.z = cvtpk(ca * bflo(v.z) + cb * b1[0], ca * bfhi(v.z) + cb * b1[1]); o.w = cvtpk(ca * bflo(v.w) + cb * b1[2], ca * bfhi(v.w) + cb * b1[3]);
        *(GAS u32x4*)op = o; }
    __syncthreads();
}
__device__ __forceinline__ void p2c_d16(Frame& F) {
    unsigned char* ws = F.ws; const bf16_t* QKV = (const bf16_t*)(ws + WS_QKV); bf16_t* O = (bf16_t*)(ws + WS_XB); const float* L14 = (const float*)(ws + WS_PS);
    const int tid = F.wave * 64 + lane_now();
    u32x4 kk[4], vv[4];
#define D16_PTR(u_, seg_) (QKV + (seg_) * SEG_ELEMS + (size_t)(((u_) >> 4) / 6) * SEQ * 384 + (((u_) >> 4) % 6) * 64)
    if (F.vcu < 768) d16_load(D16_PTR(F.vcu, 4), D16_PTR(F.vcu, 5), F.vcu & 15, tid, kk, vv);
    for (int u = F.vcu; u < 768; u += F.G) { const int bh = u >> 4, rr = u & 15, b = bh / 6, h = bh % 6; const size_t rb = (size_t)b * SEQ;
        const int un = u + F.G; const bool has_next = un < 768; const int uc = has_next ? un : u;
        attn_d16_unit(F, D16_PTR(u, 3), O + rb * 1024 + 640 + h * 64, L14 + rb * 6 + h, rr, kk, vv, has_next, D16_PTR(uc, 4), D16_PTR(uc, 5), uc & 15); }
#undef D16_PTR
}

__device__ __forceinline__ void moba_merge_task(const bf16_t* PBo, const float* PBl, bf16_t* O, int task) {
    const int ch = task & 7, t = (task >> 3) & 4095, bh = task >> 15, b = bh / 6, h = bh % 6;
    const int nb = t >> 8, nv = nb < 3 ? nb : 3;
    const size_t base = ((size_t)bh * 4096 + t) * 4;
    const f32x4 ls = *(const GAS f32x4*)(PBl + base);
    u32x4 v[4];
#pragma unroll
    for (int sl = 0; sl < 4; ++sl) v[sl] = *(const GAS u32x4*)(PBo + (base + ((sl == 3 || sl < nv) ? sl : 3)) * 64 + ch * 8);
    float mx = ls[3];
    if (nv > 0) mx = __builtin_fmaxf(mx, ls[0]); if (nv > 1) mx = __builtin_fmaxf(mx, ls[1]); if (nv > 2) mx = __builtin_fmaxf(mx, ls[2]);
    float w[4]; w[0] = nv > 0 ? __builtin_amdgcn_exp2f(ls[0] - mx) : 0.f; w[1] = nv > 1 ? __builtin_amdgcn_exp2f(ls[1] - mx) : 0.f; w[2] = nv > 2 ? __builtin_amdgcn_exp2f(ls[2] - mx) : 0.f; w[3] = __builtin_amdgcn_exp2f(ls[3] - mx);
    const float inv = 1.0f / (w[0] + w[1] + w[2] + w[3]);
    float acc[8] = {0.f, 0.f, 0.f, 0.f, 0.f, 0.f, 0.f, 0.f};
#pragma unroll
    for (int sl = 0; sl < 4; ++sl) { const float ww = w[sl] * inv;
        acc[0] += ww * bflo(v[sl].x); acc[1] += ww * bfhi(v[sl].x); acc[2] += ww * bflo(v[sl].y); acc[3] += ww * bfhi(v[sl].y); acc[4] += ww * bflo(v[sl].z); acc[5] += ww * bfhi(v[sl].z); acc[6] += ww * bflo(v[sl].w); acc[7] += ww * bfhi(v[sl].w); }
    u32x4 o; o.x = cvtpk(acc[0], acc[1]); o.y = cvtpk(acc[2], acc[3]); o.z = cvtpk(acc[4], acc[5]); o.w = cvtpk(acc[6], acc[7]);
    *(GAS u32x4*)(O + ((size_t)b * SEQ + t) * 1024 + 256 + h * 64 + ch * 8) = o;
}
__device__ __forceinline__ void p2c_moba_merge(Frame& F, const bf16_t* PBo, const float* PBl) {
    bf16_t* O = (bf16_t*)(F.ws + WS_XB);
    const int gt = (F.vcu * NWAVES + F.wave) * 64 + lane_now(), NT_ = F.G * NWAVES * 64;
    constexpr int NTASK = 48 * 4096 * 8;
    int task = gt;
    for (; task + 3 * NT_ < NTASK; task += 4 * NT_) {
        moba_merge_task(PBo, PBl, O, task); moba_merge_task(PBo, PBl, O, task + NT_); moba_merge_task(PBo, PBl, O, task + 2 * NT_); moba_merge_task(PBo, PBl, O, task + 3 * NT_); }
    for (; task < NTASK; task += NT_) moba_merge_task(PBo, PBl, O, task);
}

__device__ __forceinline__ void p2_attention(Frame& F0, int l, int rep, const int abl, bf16_t* PBo, float* PBl) {
    Frame& F = F0;
    unsigned char* ws = F.ws;
    const bf16_t* QKV = (const bf16_t*)(ws + WS_QKV); const bf16_t* QA = (const bf16_t*)(ws + WS_QA); const bf16_t* KA = (const bf16_t*)(ws + WS_KA); const bf16_t* VA = (const bf16_t*)(ws + WS_VA);
    bf16_t* O = (bf16_t*)(ws + WS_XB);
    const float* KM = (const float*)(F.ctl + CW_KMEAN) + (size_t)l * (8 * 6 * 16 * 64);
    unsigned* queue = (unsigned*)(F.ctl + CW_QUEUE + 64 * (l + 2 * rep));
    float* L14 = (float*)(ws + WS_PS);
    const unsigned* mcnt = (const unsigned*)(F.ctl + CW_MOBA) + (size_t)l * 768 * 64; const int* mlist = (const int*)(ws + WS_MLIST);
    for (;;) {
        __syncthreads();
        if (F.wave == 0 && lane_now() == 0) F.LC[LC_BCAST] = atomicAdd(queue, 1u);
        __syncthreads();
        const int uq = __builtin_amdgcn_readfirstlane((int)F.LC[LC_BCAST]);
        if (uq >= 2048) break;
        const int u = (uq < 512 + 384) ? uq : (uq < 512 + 384 + 768) ? (uq - 384 + 768) : (uq - 768);
#if 1
        if (abl >= 0 && rep == 0 && REPEAT_K == 2) { const int kind = (u >= 1280) ? 2 : (u < 512 ? 0 : 1); if (!((PROBE_ATT >> kind) & 1)) continue; }
#endif
        if (u < 512) {
            const int c = 15 - u / 32, v = u % 32, b = v >> 2, h = v & 3; const size_t rb = (size_t)b * SEQ;
            attn_shared_unit<96>(F, QA + rb * 384 + h * 96, 384, KA + rb * 384 + h * 96, 384, VA + rb * 256 + h * 64, 256, O + rb * 1024 + h * 64,
                                 256 * c, 4 * (c + 1), 1.0f, false, nullptr, abl);
        } else if (u < 1280) {
            const int v = u - 512, j = v / 48, bh = v % 48, b = bh / 6, h = bh % 6; const size_t rb = (size_t)b * SEQ;
            const int n = (int)__hip_atomic_load(mcnt + (size_t)(bh * 16 + j) * 64, RLX_AGENT);
            attn_moba_kb_unit(F, QKV + rb * 384 + h * 64, QKV + SEG_ELEMS + rb * 384 + h * 64, QKV + 2 * SEG_ELEMS + rb * 384 + h * 64,
                              PBo + (size_t)bh * 4096 * 4 * 64, PBl + (size_t)bh * 4096 * 4, j, mlist + (size_t)(bh * 16 + j) * MOBA_CAP, n, abl);
        } else {
            const int v = u - 1280, bh = v >> 4, b = bh / 6, h = bh % 6, pb = v & 15; const size_t rb = (size_t)b * SEQ;
            attn_dilated_unit(F, QKV + 3 * SEG_ELEMS + rb * 384 + h * 64, QKV + 4 * SEG_ELEMS + rb * 384 + h * 64, QKV + 5 * SEG_ELEMS + rb * 384 + h * 64,
                              O + rb * 1024 + 640 + h * 64, L14 + rb * 6 + h, 256 * pb, abl);
        }
    }
}

__device__ __forceinline__ void p4_router(Frame& F, const Args& a, int l, int rep) {
    unsigned char* ws = F.ws;
    const float* y1 = a.out;
    const bf16_t* RWh = (const bf16_t*)(ws + WS_RW) + (size_t)(l * 2) * 65536; const bf16_t* RWl = RWh + 65536;
    const float* PS = (const float*)(ws + WS_PS);
    unsigned* cnt = (unsigned*)(F.ctl + CW_CNT + 4096 * (l + 2 * rep));
    int* tokslot = (int*)(ws + (rep ? WS_H : WS_TOKSLOT)); float* gate = (float*)(ws + (rep ? WS_H + 8 * MiB : WS_GATE));
    bf16_t* x1b = (bf16_t*)(ws + WS_XB); float* stats = (float*)(ws + WS_STATS);
    const float* g1 = a.ln1_g + l * 1024; const float* b1 = a.ln1_b + l * 1024;
    const int lane = lane_now(), wave = F.wave, tid = wave * 64 + lane, r32 = lane & 31, hi = lane >> 5, pr = wave >> 1, half = wave & 1;
    LAS unsigned char* wl = F.lds + wave * 9472;
    LAS bf16_t* hiT = (LAS bf16_t*)wl; LAS bf16_t* loT = (LAS bf16_t*)(wl + 4608); LAS f32x2* stT = (LAS f32x2*)(wl + 9216);
    LAS float* xch = (LAS float*)(F.lds + 81920 + pr * 8192);
    LAS float* rbias = (LAS float*)(F.lds + 141312);
    LAS unsigned char* wbuf = F.lds + 75776;
    if (tid < 64) rbias[tid] = a.router_b[tid];
    __syncthreads();
    const int rsub = lane >> 4, c4 = (lane & 15) * 4;
    for (int it = F.vcu * 4 + pr; it < T / 32; it += F.G * 4) {
        const size_t t0 = (size_t)it * 32;
        if (lane < 32) { const float* ps = PS + (t0 + lane) * 32; float s = 0.f, q = 0.f;
#pragma unroll
            for (int i = 0; i < 8; ++i) { const f32x4 v = *(const GAS f32x4*)(ps + 4 * i); s += v[0] + v[2]; q += v[1] + v[3]; }
            const float mu = s * (1.0f / 1024.0f); const float var = __builtin_fmaxf(q * (1.0f / 1024.0f) - mu * mu, 0.f); const float rstd = 1.0f / sqrtf(var + LN_EPS);
            stT[lane] = (f32x2){mu, rstd};
            if (half == 0) *(GAS f32x2*)(stats + 2 * (t0 + lane)) = (f32x2){mu, rstd}; }
        f32x2 st8[8];
#pragma unroll
        for (int i = 0; i < 8; ++i) st8[i] = stT[4 * i + rsub];
        const int cb = half * 512;
        const float* ybase = y1 + (t0 + rsub) * 1024 + cb + c4;
        f32x4 ycur[8], ynext[8];
#pragma unroll
        for (int i = 0; i < 8; ++i) ycur[i] = *(const GAS f32x4*)(ybase + (size_t)(4 * i) * 1024);
        f32x16 a0 = {}, a1 = {};
        u32x4 wreg[4];
#define RW_LOAD(c) do { _Pragma("unroll") for (int i_ = 0; i_ < 4; ++i_) { const int p_ = tid + 512 * i_, c8_ = p_ & 7, e_ = (p_ >> 3) & 63, hl_ = (p_ >> 9) & 1, hf_ = p_ >> 10; \
            wreg[i_] = *(const GAS u32x4*)((hl_ ? RWl : RWh) + (size_t)e_ * 1024 + hf_ * 512 + 64 * (c) + c8_ * 8); } } while (0)
#define RW_WRITE(b) do { _Pragma("unroll") for (int i_ = 0; i_ < 4; ++i_) { const int p_ = tid + 512 * i_, c8_ = p_ & 7, e_ = (p_ >> 3) & 63, hl_ = (p_ >> 9) & 1, hf_ = p_ >> 10; \
            *(LAS u32x4*)(wbuf + (b) * 32768 + ((hf_ * 2 + hl_) * 64 + e_) * 128 + ((c8_ ^ (e_ & 7)) * 16)) = wreg[i_]; } } while (0)
        RW_LOAD(0); RW_WRITE(0);
        __syncthreads();
#pragma unroll 1
        for (int c = 0; c < 8; ++c) {
            if (c + 1 < 8) RW_LOAD(c + 1);
            if (c + 1 < 8) {
#pragma unroll
                for (int i = 0; i < 8; ++i) ynext[i] = *(const GAS f32x4*)(ybase + (size_t)(4 * i) * 1024 + 64 * (c + 1)); }
            const f32x4 gv = *(const GAS f32x4*)(g1 + cb + 64 * c + c4), bv = *(const GAS f32x4*)(b1 + cb + 64 * c + c4);
#pragma unroll
            for (int i = 0; i < 8; ++i) { const int row = 4 * i + rsub; const f32x4 xv = (ycur[i] - st8[i][0]) * st8[i][1] * gv + bv;
                *(GAS u32x2*)(x1b + (t0 + row) * 1024 + cb + 64 * c + c4) = pack4(xv);
                const unsigned h01 = cvtpk(xv[0], xv[1]), h23 = cvtpk(xv[2], xv[3]);
                const unsigned l01 = cvtpk(xv[0] - bflo(h01), xv[1] - bfhi(h01)), l23 = cvtpk(xv[2] - bflo(h23), xv[3] - bfhi(h23));
                *(LAS u32x2*)(hiT + row * 72 + c4) = (u32x2){h01, h23};
                *(LAS u32x2*)(loT + row * 72 + c4) = (u32x2){l01, l23}; }
            asm volatile("" ::: "memory");
            bf16x8 yh[4], yl[4];
#pragma unroll
            for (int ks = 0; ks < 4; ++ks) { yh[ks] = *(const LAS bf16x8*)(hiT + r32 * 72 + 16 * ks + 8 * hi); yl[ks] = *(const LAS bf16x8*)(loT + r32 * 72 + 16 * ks + 8 * hi); }
            asm volatile("s_waitcnt lgkmcnt(0)" ::: "memory");
#pragma unroll
            for (int ks = 0; ks < 4; ++ks) {
                const LAS unsigned char* wb_ = wbuf + (c & 1) * 32768 + (half * 2) * 8192 + r32 * 128 + (((2 * ks + hi) ^ (r32 & 7)) * 16);
                const bf16x8 h0 = *(const LAS bf16x8*)(wb_), h1 = *(const LAS bf16x8*)(wb_ + 4096);
                const bf16x8 l0 = *(const LAS bf16x8*)(wb_ + 8192), l1 = *(const LAS bf16x8*)(wb_ + 8192 + 4096);
                a0 = MFMA32(h0, yh[ks], a0); a0 = MFMA32(h0, yl[ks], a0); a0 = MFMA32(l0, yh[ks], a0);
                a1 = MFMA32(h1, yh[ks], a1); a1 = MFMA32(h1, yl[ks], a1); a1 = MFMA32(l1, yh[ks], a1); }
#pragma unroll
            for (int i = 0; i < 8; ++i) ycur[i] = ynext[i];
            if (c + 1 < 8) { if (c & 1) RW_WRITE(0); else RW_WRITE(1); }
            __syncthreads();
        }
#undef RW_LOAD
#undef RW_WRITE
        if (half == 1) {
#pragma unroll
            for (int r = 0; r < 16; ++r) { xch[r * 64 + lane] = a0[r]; xch[(16 + r) * 64 + lane] = a1[r]; } }
        __syncthreads();
        if (half == 0) {
#pragma unroll
            for (int r = 0; r < 16; ++r) { a0[r] += xch[r * 64 + lane]; a1[r] += xch[(16 + r) * 64 + lane]; }
            const size_t tok = t0 + r32;
            float bestg = -3e38f, bs1 = 0.f, bs2 = 0.f; int be1 = 0, be2 = 1;
#pragma unroll
            for (int gi = 0; gi < 8; ++gi) {
                const int blk = gi >> 2, q = gi & 3;
                float B1 = -3e38f, B2 = -3e38f, S1 = 0.f, S2 = 0.f; int I1 = 0, I2 = 0;
#pragma unroll
                for (int j = 0; j < 4; ++j) {
                    const int e = 32 * blk + 8 * q + 4 * hi + j;
                    const float logit = (blk == 0) ? a0[4 * q + j] : a1[4 * q + j];
                    const float s = 1.0f / (1.0f + __expf(-logit)); const float sb = s + rbias[e];
                    const int idx = 4 * hi + j;
                    if (sb > B1) { B2 = B1; S2 = S1; I2 = I1; B1 = sb; S1 = s; I1 = idx; } else if (sb > B2) { B2 = sb; S2 = s; I2 = idx; }
                }
                const float pB1 = xhalf(B1), pB2 = xhalf(B2), pS1 = xhalf(S1), pS2 = xhalf(S2); const int pI1 = __builtin_bit_cast(int, xhalf(__builtin_bit_cast(float, I1))), pI2 = __builtin_bit_cast(int, xhalf(__builtin_bit_cast(float, I2)));
                const bool mine_first = (B1 > pB1) || (B1 == pB1 && I1 < pI1);
                float T1, T2, U1, U2; int J1, J2;
                if (mine_first) { T1 = B1; U1 = S1; J1 = I1; const bool sec_mine = (B2 > pB1) || (B2 == pB1 && I2 < pI1); if (sec_mine) { T2 = B2; U2 = S2; J2 = I2; } else { T2 = pB1; U2 = pS1; J2 = pI1; } }
                else { T1 = pB1; U1 = pS1; J1 = pI1; const bool sec_p = (pB2 > B1) || (pB2 == B1 && pI2 < I1); if (sec_p) { T2 = pB2; U2 = pS2; J2 = pI2; } else { T2 = B1; U2 = S1; J2 = I1; } }
                const float gs = T1 + T2;
                if (gs > bestg) { bestg = gs; bs1 = U1; bs2 = U2; be1 = 8 * gi + J1; be2 = 8 * gi + J2; }
            }
            const float ginv = 1.0f / (bs1 + bs2);
            if (hi == 0) {
                const unsigned s1 = atomicAdd(cnt + 64 * be1, 1u), s2 = atomicAdd(cnt + 64 * be2, 1u);
                const size_t i1 = (size_t)be1 * CAP + s1, i2 = (size_t)be2 * CAP + s2;
                tokslot[i1] = (int)(2 * tok); gate[i1] = bs1 * ginv; tokslot[i2] = (int)(2 * tok + 1); gate[i2] = bs2 * ginv;
            }
        }
        __syncthreads();
    }
}

__device__ __forceinline__ void p7_ln2(Frame& F, const Args& a, int l, bool dummy) {
    unsigned char* ws = F.ws;
    float* y1 = a.out; const float* stats = (const float*)(ws + WS_STATS); const bf16_t* Y = (const bf16_t*)(ws + WS_Y); bf16_t* xb = (bf16_t*)(ws + WS_XB);
    const float* g1 = a.ln1_g + l * 1024; const float* b1 = a.ln1_b + l * 1024; const float* g2 = a.ln2_g + l * 1024; const float* b2 = a.ln2_b + l * 1024;
    const int gw = F.vcu * NWAVES + F.wave, NGW = F.G * NWAVES, lane = lane_now();
    f32x4 g1v[4], b1v[4], g2v[4], b2v[4];
#pragma unroll
    for (int j = 0; j < 4; ++j) { const int c = 4 * lane + 256 * j; g1v[j] = *(const GAS f32x4*)(g1 + c); b1v[j] = *(const GAS f32x4*)(b1 + c); g2v[j] = *(const GAS f32x4*)(g2 + c); b2v[j] = *(const GAS f32x4*)(b2 + c); }
    for (int row0 = gw; row0 < T; row0 += 2 * NGW) {
        const int rowA = row0, rowB = (row0 + NGW < T) ? row0 + NGW : row0;
        f32x4 z[2][4]; float s[2] = {0.f, 0.f};
#pragma unroll
        for (int q = 0; q < 2; ++q) { const size_t row = q ? rowB : rowA; const f32x2 st = *(const GAS f32x2*)(stats + 2 * row);
#pragma unroll
            for (int j = 0; j < 4; ++j) { const int c = 4 * lane + 256 * j;
                const f32x4 yv = *(const GAS f32x4*)(y1 + row * 1024 + c);
                const u32x2 e0 = *(const GAS u32x2*)(Y + (2 * row) * 1024 + c), e1 = *(const GAS u32x2*)(Y + (2 * row + 1) * 1024 + c);
                const f32x4 x1 = (yv - st[0]) * st[1] * g1v[j] + b1v[j];
                const f32x4 f0 = {bflo(e0.x), bfhi(e0.x), bflo(e0.y), bfhi(e0.y)}, f1 = {bflo(e1.x), bfhi(e1.x), bflo(e1.y), bfhi(e1.y)};
                z[q][j] = x1 * ALPHA + f0 + f1; s[q] += (z[q][j][0] + z[q][j][1]) + (z[q][j][2] + z[q][j][3]); } }
        float mean[2], s2[2] = {0.f, 0.f}, rstd[2];
        mean[0] = wave_sum(s[0]) * (1.0f / 1024.0f); mean[1] = wave_sum(s[1]) * (1.0f / 1024.0f);
#pragma unroll
        for (int q = 0; q < 2; ++q)
#pragma unroll
            for (int j = 0; j < 4; ++j) { z[q][j] = z[q][j] - mean[q]; s2[q] += (z[q][j][0] * z[q][j][0] + z[q][j][1] * z[q][j][1]) + (z[q][j][2] * z[q][j][2] + z[q][j][3] * z[q][j][3]); }
        rstd[0] = 1.0f / sqrtf(wave_sum(s2[0]) * (1.0f / 1024.0f) + LN_EPS); rstd[1] = 1.0f / sqrtf(wave_sum(s2[1]) * (1.0f / 1024.0f) + LN_EPS);
#pragma unroll
        for (int q = 0; q < 2; ++q) { const size_t row = q ? rowB : rowA; if (q == 1 && rowB == rowA) break;
#pragma unroll
            for (int j = 0; j < 4; ++j) { const int c = 4 * lane + 256 * j; const f32x4 o = z[q][j] * rstd[q] * g2v[j] + b2v[j];
                if (!dummy) { *(GAS f32x4*)(y1 + row * 1024 + c) = o; if (l + 1 < DEPTH) *(GAS u32x2*)(xb + row * 1024 + c) = pack4(o); } } }
    }
}

constexpr int N_PHASES = 1 + 9 * DEPTH;
#ifndef MK_N_LAUNCHES
#define MK_N_LAUNCHES 1
#endif

__device__ __forceinline__ void moe_tables(Frame& F, int l) {
    const unsigned* cntg = (const unsigned*)(F.ctl + CW_CNT + 4096 * l);
    const int tid = F.wave * 64 + lane_now();
    if (tid < 64) F.LC[LC_CNT + tid] = __hip_atomic_load(cntg + 64 * tid, RLX_AGENT);
    __syncthreads();
    if (tid == 0) { unsigned run = 0; for (int e = 0; e < 64; ++e) { F.LC[LC_TB + e] = run; run += (F.LC[LC_CNT + e] + 255u) >> 8; } F.LC[LC_TB + 64] = run; }
    __syncthreads();
}

__global__ void __launch_bounds__(NTHREADS, 2) mega_fwd(Args a_in) {
    extern __shared__ __attribute__((aligned(16))) unsigned char lds_raw[];
    Frame F;
    F.lds = (LAS unsigned char*)lds_raw;
    F.LC = (volatile LAS unsigned*)(F.lds + LDSCTL_OFF);
    F.ws = a_in.ws; F.ctl = (gu32*)(a_in.ws + WS_CTL);
    F.wave = __builtin_amdgcn_readfirstlane((int)threadIdx.x >> 6);
    F.G = gridDim.x; { const int bx = blockIdx.x; F.vcu = (F.G % 8 == 0) ? (bx % 8) * (F.G / 8) + bx / 8 : bx; }
    for (int u = threadIdx.x; u < (LDS_BYTES - LDSCTL_OFF) / 4; u += NTHREADS) F.LC[u] = 0u;
    __syncthreads();
    XcdBarrier bar; bar.bar = (unsigned*)(F.ctl + CW_BAR); bar.x = 0; bar.st = nullptr;
    if (MK_N_LAUNCHES == 1) bar = xcd_barrier_post((unsigned*)(F.ctl + CW_BAR), F.LC + LC_BAR, threadIdx.x == 0);
    const int lo = a_in.ph_lo, hi = a_in.ph_hi;
    const int wave_sgpr = __builtin_amdgcn_readfirstlane((int)threadIdx.x >> 6);
#define LAUNDER(p) asm volatile("" : "+s"(p))
    int ph = lo, rep = 0; bool first = true;
    while (ph < hi) {
        if (!first) { int ln0_; asm volatile("v_mbcnt_lo_u32_b32 %0, -1, 0\n\tv_mbcnt_hi_u32_b32 %0, -1, %0" : "=v"(ln0_)); xcd_barrier(bar, wave_sgpr == 0 && ln0_ == 0); }
        first = false;
        Args a = a_in;
        LAUNDER(a.x); LAUNDER(a.w_in); LAUNDER(a.q_norm); LAUNDER(a.w_uq); LAUNDER(a.kv_norm); LAUNDER(a.w_ukv); LAUNDER(a.w_out); LAUNDER(a.ln1_g); LAUNDER(a.ln1_b);
        LAUNDER(a.router_w); LAUNDER(a.router_b); LAUNDER(a.w1); LAUNDER(a.w3); LAUNDER(a.w2); LAUNDER(a.ln2_g); LAUNDER(a.ln2_b); LAUNDER(a.out); LAUNDER(a.ws);
        unsigned char* ws = a.ws; F.ws = ws; F.ctl = (gu32*)(ws + WS_CTL);
        { int w_ = wave_sgpr; LAUNDER(w_); F.wave = w_; }
#ifdef TSEL
        if (blockIdx.x == 0 && wave_sgpr == 0 && rep == 0) { const unsigned long long t_ = __builtin_amdgcn_s_memrealtime(); if (lane_now() == 0) ((GAS unsigned long long*)(ws + WS_GB + 8192))[ph] = t_; }
#endif
        const int l = (ph - 1) / 9, k = (ph == 0) ? 9 : ((ph - 1) % 9);
        bf16_t* PBo = (l == 0) ? (bf16_t*)a.out : (bf16_t*)(ws + WS_MOE); float* PBl = (float*)(ws + WS_CQ);
        if (k == 9) {
            p0_prologue(F, a);
        } else if (k == 0) {
            pg8::StaticOrder S; S.init(T, N_INP, F.G, (int)blockIdx.x);
            EpiP1 E{(bf16_t*)(ws + WS_CQ), (bf16_t*)(ws + WS_CKV), (bf16_t*)(ws + WS_KR), (bf16_t*)(ws + WS_QKV), (const f32x2*)(ws + WS_T64), (const f32x2*)(ws + WS_T32),
                    (float*)(F.ctl + CW_KMEAN) + (size_t)l * (8 * 6 * 16 * 64)};
            pg8::gemm_phase<EpiP1, pg8::StaticOrder, true, true>(F.wave, F.lds, (const bf16_t*)(ws + WS_XB), (const bf16_t*)(ws + WS_WIN + (size_t)l * WIN_L), DM, S, E);
            if (l == 0) moe_convert_tail(F, a, 0, 0, MOE_P0_FROM, S.nwg, (int)blockIdx.x); else moe_convert_tail(F, a, 1, MOE_L1_B, MOE_ITEMS_L, S.nwg, (int)blockIdx.x);
        } else if (k == 1) {
            p1b_mla(F, l); p1c_moba_gate(F, l);
        } else if (k == 2) {
            p2_attention(F, l, rep, (REPEAT_K == 2 && rep == 0) ? ABL : 0, PBo, PBl);
        } else if (k == 3) {
            p2c_d16(F); p2c_moba_merge(F, PBo, PBl);
        } else if (k == 4) {
            pg8::StaticOrder S; S.init(T, DM, F.G, (int)blockIdx.x);
            EpiP3 E{l == 0 ? a.x : (const float*)a.out, a.out, (float*)(ws + WS_PS)};
            pg8::gemm_phase<EpiP3, pg8::StaticOrder, true, true>(F.wave, F.lds, (const bf16_t*)(ws + WS_XB), (const bf16_t*)(ws + WS_WOUT) + (size_t)l * DM * DM, DM, S, E);
        } else if (k == 5) {
            p4_router(F, a, l, rep);
        } else if (k == 6) {
            moe_tables(F, l);
            const LAS int* tb = (const LAS int*)(F.lds + LDSCTL_OFF) + LC_TB; const LAS int* cn = (const LAS int*)(F.lds + LDSCTL_OFF) + LC_CNT;
            MoeSched S{tb, cn, (const int*)(ws + WS_TOKSLOT), 2, F.G, F.vcu, tb[64], true};
            EpiP5 E{(bf16_t*)(ws + WS_H)};
            pg8::gemm_phase<EpiP5, MoeSched, true, true>(F.wave, F.lds, (const bf16_t*)(ws + WS_XB), (const bf16_t*)(ws + WS_MOE + (size_t)l * MOE_L), DM, S, E);
            if (l == 0) moe_convert_tail(F, a, 1, 0, MOE_L1_A, S.ntiles * 2, F.vcu);
        } else if (k == 7) {
            moe_tables(F, l);
            const LAS int* tb = (const LAS int*)(F.lds + LDSCTL_OFF) + LC_TB; const LAS int* cn = (const LAS int*)(F.lds + LDSCTL_OFF) + LC_CNT;
            MoeSched S{tb, cn, (const int*)(ws + WS_TOKSLOT), 4, F.G, F.vcu, tb[64], false};
            EpiP6 E{(bf16_t*)(ws + WS_Y), tb, cn, (const int*)(ws + WS_TOKSLOT), (const float*)(ws + WS_GATE)};
            pg8::gemm_phase<EpiP6, MoeSched, true, true>(F.wave, F.lds, (const bf16_t*)(ws + WS_H), (const bf16_t*)(ws + WS_MOE + (size_t)l * MOE_L + 64 * MiB), DEXP, S, E);
            if (l == 0) moe_convert_tail(F, a, 1, MOE_L1_A, MOE_L1_B, S.ntiles * 4, F.vcu);
        } else {
            p7_ln2(F, a, l, (REPEAT_K == 8) && rep == 0);
        }
        const int nrep = (REPEAT_K >= 0 && k == REPEAT_K && (REPEAT_K != 4 || l == 0)) ? 1 + REPEAT_N : 1;
        if (++rep >= nrep) { rep = 0; ++ph; }
    }
}

extern "C" void kernel_launch(void* const* d_in, const int* in_sizes, int n_in, void* d_out, int out_size, void* d_ws, size_t ws_size, hipStream_t stream) {
    static int grid = 0;
    if (grid == 0) {
        if (n_in != 16 || out_size != T * DM || ws_size < WS_END) { fprintf(stderr, "kernel_launch: unexpected shapes (n_in %d out %d ws %zu need %zu)\n", n_in, out_size, ws_size, (size_t)WS_END); grid = -1; return; }
        int dev = 0, cus = 0, per_cu = 0;
        if (hipGetDevice(&dev) != hipSuccess || hipDeviceGetAttribute(&cus, hipDeviceAttributeMultiprocessorCount, dev) != hipSuccess) { grid = -1; return; }
        if (hipFuncSetAttribute((const void*)mega_fwd, hipFuncAttributeMaxDynamicSharedMemorySize, LDS_BYTES) != hipSuccess) { grid = -1; return; }
        if (hipOccupancyMaxActiveBlocksPerMultiprocessor(&per_cu, (const void*)mega_fwd, NTHREADS, LDS_BYTES) != hipSuccess || per_cu < 1) { fprintf(stderr, "kernel_launch: occupancy query says %d blocks/CU\n", per_cu); per_cu = 1; }
        (void)hipGetLastError();
        grid = cus;
    }
    if (grid < 0) return;
    if (hipMemsetAsync((char*)d_ws + WS_CTL, 0, CTL_BYTES, stream) != hipSuccess) return;
    Args a{};
    a.x = (const float*)d_in[0]; a.w_in = (const float*)d_in[1]; a.q_norm = (const float*)d_in[2]; a.w_uq = (const float*)d_in[3]; a.kv_norm = (const float*)d_in[4];
    a.w_ukv = (const float*)d_in[5]; a.w_out = (const float*)d_in[6]; a.ln1_g = (const float*)d_in[7]; a.ln1_b = (const float*)d_in[8]; a.router_w = (const float*)d_in[9];
    a.router_b = (const float*)d_in[10]; a.w1 = (const float*)d_in[11]; a.w3 = (const float*)d_in[12]; a.w2 = (const float*)d_in[13]; a.ln2_g = (const float*)d_in[14]; a.ln2_b = (const float*)d_in[15];
    a.out = (float*)d_out; a.ws = (unsigned char*)d_ws;
#if MK_N_LAUNCHES == 1
    a.ph_lo = 0; a.ph_hi = N_PHASES;
    hipLaunchKernelGGL(mega_fwd, dim3(grid), dim3(NTHREADS), LDS_BYTES, stream, a);
#else
    for (int ph = 0; ph < N_PHASES; ++ph) { a.ph_lo = ph; a.ph_hi = ph + 1; hipLaunchKernelGGL(mega_fwd, dim3(grid), dim3(NTHREADS), LDS_BYTES, stream, a); }
#endif
}
```

```cpp
#include <hip/hip_runtime.h>
#ifndef WGM_SEL
#define WGM_SEL 4
#endif
#ifndef REPEAT_K
#define REPEAT_K -1
#endif
#ifndef REPEAT_N
#define REPEAT_N 1
#endif
#ifndef ABL
#define ABL 0
#endif
#ifndef PROBE_ATT
#define PROBE_ATT 7
#endif
#include <cstdio>
#include <cstdint>

#define LAS __attribute__((address_space(3)))
#define GAS __attribute__((address_space(1)))
typedef unsigned short bf16_t;
typedef short bf16x8 __attribute__((ext_vector_type(8)));
typedef short s16x4 __attribute__((ext_vector_type(4)));
typedef float f32x2 __attribute__((ext_vector_type(2)));
typedef float f32x4 __attribute__((ext_vector_type(4)));
typedef float f32x16 __attribute__((ext_vector_type(16)));
typedef unsigned u32x2 __attribute__((ext_vector_type(2)));
typedef unsigned u32x4 __attribute__((ext_vector_type(4)));
typedef GAS unsigned gu32;

constexpr int BATCH = 8, SEQ = 4096, DM = 1024, T = BATCH * SEQ, DEPTH = 2;
constexpr int N_IN = 2720, N_INP = 2816;
constexpr int NEXP = 64, DEXP = 256, CAP = T;
constexpr float ALPHA = 1.4142135623730951f;
constexpr float LN_EPS = 1e-5f, RMS_EPS = 1e-6f;
constexpr float LOG2E = 1.4426950408889634f;
constexpr int NWAVES = 8, NTHREADS = 512;

constexpr size_t MiB = 1u << 20;
constexpr size_t WS_CTL = 0, CTL_BYTES = 2 * MiB;
constexpr size_t WS_T64 = 2 * MiB;
constexpr size_t WS_T32 = 3 * MiB;
constexpr size_t WS_GB = 3 * MiB + 512 * 1024;
constexpr size_t WS_WIN = 4 * MiB;
constexpr size_t WIN_L = (size_t)N_INP * DM * 2;
constexpr size_t WS_WOUT = 15 * MiB;
constexpr size_t WS_WUQ = 19 * MiB;
constexpr size_t WS_WUKV = 19 * MiB + 512 * 1024;
constexpr size_t WS_RW = 20 * MiB;
constexpr size_t WS_STATS = 21 * MiB;
constexpr size_t WS_PS = 528 * MiB;
constexpr size_t WS_TOKSLOT = 22 * MiB;
constexpr size_t WS_GATE = 30 * MiB;
constexpr size_t WS_XB = 38 * MiB;
constexpr size_t WS_A = 102 * MiB;
constexpr size_t WS_QKV = WS_A;
constexpr size_t SEG_ELEMS = (size_t)T * 384;
constexpr size_t WS_QA = WS_A + 144 * MiB;
constexpr size_t WS_KA = WS_A + 168 * MiB;
constexpr size_t WS_VA = WS_A + 192 * MiB;
constexpr size_t WS_CQ = WS_A + 208 * MiB;
constexpr size_t WS_CKV = WS_A + 224 * MiB;
constexpr size_t WS_KR = WS_A + 232 * MiB;
constexpr size_t WS_Y = WS_A;
constexpr size_t WS_H = WS_A + 144 * MiB;
constexpr size_t WS_MOE = 336 * MiB;
constexpr size_t MOE_L = 96 * MiB;
constexpr size_t WS_END = WS_MOE + 2 * MOE_L + 4 * MiB;
constexpr int CW_BAR = 4096;
constexpr int CW_QUEUE = 8192;
constexpr int CW_CNT = 16384;
constexpr int CW_KMEAN = 65536;
constexpr int CW_MOBA = 196608;
static_assert((CW_MOBA + 2 * 768 * 64) * 4 <= (int)CTL_BYTES, "ctl");
constexpr int MOBA_CAP = 3840;
constexpr size_t WS_MLIST = WS_TOKSLOT;

constexpr int LDS_BYTES = 147456;
constexpr int LDSCTL_OFF = 146432;
constexpr int LC_BAR = 0, LC_BCAST = 2, LC_TB = 16, LC_CNT = 96;

__device__ const float INV64[32] = {1.000000000e+00f, 7.498942614e-01f, 5.623413324e-01f, 4.216965139e-01f, 3.162277639e-01f, 2.371373773e-01f, 1.778279394e-01f, 1.333521307e-01f, 1.000000015e-01f, 7.498941571e-02f, 5.623413250e-02f, 4.216965288e-02f, 3.162277490e-02f, 2.371373773e-02f, 1.778279431e-02f, 1.333521493e-02f, 9.999999776e-03f, 7.498941850e-03f, 5.623413250e-03f, 4.216964822e-03f, 3.162277630e-03f, 2.371373586e-03f, 1.778279431e-03f, 1.333521446e-03f, 1.000000047e-03f, 7.498942432e-04f, 5.623413017e-04f, 4.216965172e-04f, 3.162277571e-04f, 2.371373703e-04f, 1.778279402e-04f, 1.333521504e-04f};
__device__ const float INV32[16] = {1.000000000e+00f, 5.623413324e-01f, 3.162277639e-01f, 1.778279394e-01f, 1.000000015e-01f, 5.623413250e-02f, 3.162277490e-02f, 1.778279431e-02f, 9.999999776e-03f, 5.623413250e-03f, 3.162277630e-03f, 1.778279431e-03f, 1.000000047e-03f, 5.623413017e-04f, 3.162277571e-04f, 1.778279402e-04f};

#define LDS_WAIT() asm volatile("s_waitcnt lgkmcnt(0)" ::: "memory")
#define VM_WAIT() asm volatile("s_waitcnt vmcnt(0)" ::: "memory")
#define RLX_AGENT __ATOMIC_RELAXED, __HIP_MEMORY_SCOPE_AGENT
__device__ __forceinline__ unsigned f2bf(float f) { unsigned u = __builtin_bit_cast(unsigned, f); return (u + 0x7fffu + ((u >> 16) & 1u)) >> 16; }
typedef __bf16 bf16x2_t __attribute__((ext_vector_type(2)));
__device__ __forceinline__ unsigned cvtpk(float lo, float hi) { f32x2 v = {lo, hi}; bf16x2_t b = __builtin_convertvector(v, bf16x2_t); return __builtin_bit_cast(unsigned, b); }
__device__ __forceinline__ unsigned pk2(float lo, float hi) { return cvtpk(lo, hi); }
__device__ __forceinline__ float bf2f(unsigned short b) { return __builtin_bit_cast(float, (unsigned)b << 16); }
__device__ __forceinline__ float bflo(unsigned w) { return __builtin_bit_cast(float, w << 16); }
__device__ __forceinline__ float bfhi(unsigned w) { return __builtin_bit_cast(float, w & 0xffff0000u); }
__device__ __forceinline__ int crow(int r, int hi) { return (r & 3) + 8 * (r >> 2) + 4 * hi; }
__device__ __forceinline__ int lane_now() { int l; asm volatile("v_mbcnt_lo_u32_b32 %0, -1, 0\n\tv_mbcnt_hi_u32_b32 %0, -1, %0" : "=v"(l)); return l; }
template <int MASK> __device__ __forceinline__ float swz_xor(float v) {
    return __uint_as_float((unsigned)__builtin_amdgcn_ds_swizzle((int)__float_as_uint(v), (MASK << 10) | 0x1f));
}
__device__ __forceinline__ float xsum32(float v) {
    const unsigned u = __float_as_uint(v); auto rr = __builtin_amdgcn_permlane32_swap(u, u, false, false); return __uint_as_float(rr[0]) + __uint_as_float(rr[1]);
}
__device__ __forceinline__ float wave_sum(float v) {
    v += swz_xor<1>(v); v += swz_xor<2>(v); v += swz_xor<4>(v); v += swz_xor<8>(v); v += swz_xor<16>(v);
    return xsum32(v);
}
__device__ __forceinline__ float xhalf(float v) {
    const unsigned u = __float_as_uint(v);
    auto rr = __builtin_amdgcn_permlane32_swap(u, u, false, false);
    return __uint_as_float(rr[0] ^ rr[1] ^ u);
}

namespace pg8 {
constexpr int BM = 256, BK = 64, HALF = 128, HTB = HALF * BK * 2, STAGE_BYTES = 8 * HTB, NXCD = 8, WGM = WGM_SEL;
__host__ __device__ __forceinline__ int lds_byte(int r, int c) { const int st = (r >> 4) * 2 + (c >> 5), rr = r & 15, cc = c & 31, ob = rr * 64 + cc * 2; return st * 1024 + (ob ^ (((ob >> 9) & 1) << 5)); }
__host__ __device__ __forceinline__ void stage_rc(int b, int& R, int& C) { const int st = b / 1024, sb = b % 1024, swz = sb ^ (((sb >> 9) & 1) << 5); R = (st >> 1) * 16 + swz / 64; C = (st & 1) * 32 + (swz % 64) / 2; }
__host__ __device__ __forceinline__ int perm32(int rho) { const int n = rho >> 4, i = rho & 15; return 8 * (i >> 2) + 4 * n + (i & 3); }

struct Unit { int pm, pn; };

struct StaticOrder {
    int nM, nN, nwg, G, c;
    __device__ void init(int M, int N, int G_, int c_) { nM = M / BM; nN = N / BM; nwg = nM * nN; G = G_; c = c_; }
    __device__ bool next(int i, Unit& u) const {
        const long L = (long)i * G + c; if (L >= nwg) return false;
        int wgid = (int)L; { const int q = nwg / NXCD, r = nwg % NXCD, xcd = wgid % NXCD, off = wgid / NXCD; wgid = (xcd < r ? xcd * (q + 1) : r * (q + 1) + (xcd - r) * q) + off; }
        const int nig = WGM * nN, gid = wgid / nig, fm = gid * WGM, gsz = (nM - fm) < WGM ? (nM - fm) : WGM;
        u.pm = fm + ((wgid % nig) % gsz); u.pn = (wgid % nig) / gsz; return true;
    }
    __device__ __forceinline__ int a_row(const Unit& u, int r) const { return u.pm * BM + r; }
};

template <class Epi, class Sched, bool ALIGN_EPI, bool SP2>
__device__ __forceinline__ void gemm_phase(const int wid, LAS unsigned char* lds, const bf16_t* A, const bf16_t* Bt, const int K, const Sched& S, const Epi& E) {
    const int lane = lane_now(), tid = wid * 64 + lane, wr = wid >> 2, wc = wid & 3, fr = lane & 15, fq = lane >> 4;
    const int nt = K / BK;
    unsigned voffB[2];
#pragma unroll
    for (int i = 0; i < 2; ++i) { int R, C; stage_rc(tid * 16 + i * 8192, R, C); const int Rb = Epi::PERM ? ((R & ~31) + perm32(R & 31)) : R;
        voffB[i] = (unsigned)(Rb * K + C) * 2u; }
    const size_t kstep = (size_t)(BK * 2);
    const size_t hstep = (size_t)HALF * K * 2;
    const size_t tstep = 2 * hstep;
    const unsigned ldsw = (unsigned)wid * 1024u;
    const int aoff = lds_byte(wr * 64 + fr, fq * 8), boff = lds_byte(wc * 32 + fr, fq * 8);
#define PG8_SA(b, h) (((b) * 2 + (h)) * HTB)
#define PG8_SB(b, h) ((4 + (b) * 2 + (h)) * HTB)
#define PG8_STAGE(bufoff, gbase, voff) do { _Pragma("unroll") for (int _i = 0; _i < 2; ++_i) \
        __builtin_amdgcn_global_load_lds((const unsigned*)((const char*)(gbase) + (voff)[_i]), (LAS unsigned*)(lds + (bufoff) + ldsw + _i * 8192), 16, 0, 0); } while (0)
#define PG8_AVOFF(dst, u) do { const int _tid = wid * 64 + lane_now(); _Pragma("unroll") for (int _i = 0; _i < 2; ++_i) { int _R, _C; stage_rc(_tid * 16 + _i * 8192, _R, _C); _Pragma("unroll") for (int _h = 0; _h < 2; ++_h) \
        dst[_h][_i] = (unsigned)((unsigned)S.a_row(u, _h * HALF + _R) * (unsigned)K + (unsigned)_C) * 2u; } } while (0)
#define PG8_LDA(dst, b, h) do { _Pragma("unroll") for (int m = 0; m < 4; ++m) _Pragma("unroll") for (int k = 0; k < 2; ++k) dst[m][k] = *(const LAS bf16x8*)(lds + PG8_SA(b, h) + aoff + m * 2048 + k * 1024); } while (0)
#define PG8_LDB(dst, b, h) do { _Pragma("unroll") for (int n = 0; n < 2; ++n) _Pragma("unroll") for (int k = 0; k < 2; ++k) dst[n][k] = *(const LAS bf16x8*)(lds + PG8_SB(b, h) + boff + n * 2048 + k * 1024); } while (0)
#define PG8_MMA(ai, bj, At, Bt_) do { __builtin_amdgcn_s_setprio(1); _Pragma("unroll") for (int m = 0; m < 4; ++m) _Pragma("unroll") for (int n = 0; n < 2; ++n) _Pragma("unroll") for (int k = 0; k < 2; ++k) \
        acc[ai][bj][m][n] = __builtin_amdgcn_mfma_f32_16x16x32_bf16(Bt_[n][k], At[m][k], acc[ai][bj][m][n], 0, 0, 0); __builtin_amdgcn_s_setprio(0); } while (0)
#define PG8_WAIT_V(n) asm volatile("s_waitcnt vmcnt(" #n ")" ::: "memory")
#define PG8_WAIT_L(n) asm volatile("s_waitcnt lgkmcnt(" #n ")" ::: "memory")
#define PG8_BAR __builtin_amdgcn_s_barrier()
#define PG8_SCHED __builtin_amdgcn_sched_barrier(0)
    Unit cur, nxt; int ui = 0;
    if (!S.next(0, cur)) return;
    f32x4 acc[2][2][4][2];
#pragma unroll
    for (int a = 0; a < 2; ++a)
#pragma unroll
        for (int b = 0; b < 2; ++b)
#pragma unroll
            for (int m = 0; m < 4; ++m)
#pragma unroll
                for (int n = 0; n < 2; ++n) acc[a][b][m][n] = (f32x4){0.f, 0.f, 0.f, 0.f};
    bf16x8 At[4][2], B0[2][2], B1[2][2];
    unsigned vc[2][2], vn[2][2];
    PG8_AVOFF(vc, cur);
    const char* cB = (const char*)Bt + (size_t)cur.pn * tstep;
    const char* gA = (const char*)A;
    if constexpr (SP2) {
        PG8_STAGE(PG8_SB(0, 0), cB, voffB); PG8_STAGE(PG8_SB(0, 1), cB + hstep, voffB); PG8_STAGE(PG8_SA(0, 0), gA, vc[0]); PG8_STAGE(PG8_SA(0, 1), gA, vc[1]);
        if (wr == 1) PG8_BAR;
        PG8_WAIT_V(2); PG8_BAR;
        PG8_STAGE(PG8_SB(1, 0), cB + kstep, voffB); PG8_STAGE(PG8_SA(1, 0), gA + kstep, vc[0]); PG8_STAGE(PG8_SB(1, 1), cB + hstep + kstep, voffB);
        PG8_WAIT_V(6); PG8_BAR;
    } else {
        PG8_STAGE(PG8_SB(0, 0), cB, voffB); PG8_STAGE(PG8_SA(0, 0), gA, vc[0]); PG8_STAGE(PG8_SB(0, 1), cB + hstep, voffB); PG8_STAGE(PG8_SA(0, 1), gA, vc[1]);
        if (wr == 1) PG8_BAR;
        PG8_WAIT_V(4); PG8_BAR;
        PG8_STAGE(PG8_SB(1, 0), cB + kstep, voffB); PG8_STAGE(PG8_SA(1, 0), gA + kstep, vc[0]); PG8_STAGE(PG8_SB(1, 1), cB + hstep + kstep, voffB);
        PG8_WAIT_V(6); PG8_BAR;
    }
    for (;;) {
        const bool has_next = S.next(ui + 1, nxt);
        const char* nB = has_next ? (const char*)Bt + (size_t)nxt.pn * tstep : cB;
        for (int t = 0; t < nt; t += 2) {
            const bool last = (t == nt - 2);
            if (t == (nt >= 4 ? nt - 4 : 0)) {
                if (has_next) { PG8_AVOFF(vn, nxt); } else {
#pragma unroll
                    for (int h = 0; h < 2; ++h)
#pragma unroll
                        for (int i = 0; i < 2; ++i) vn[h][i] = vc[h][i]; } }
            const char* a1 = gA + (size_t)(t + 1) * kstep;
            const char* a2 = last ? gA : gA + (size_t)(t + 2) * kstep; const char* b2 = last ? nB : cB + (size_t)(t + 2) * kstep;
            const char* a3 = a2 + kstep; const char* b3 = b2 + kstep;
            unsigned v2[2][2];
#pragma unroll
            for (int h = 0; h < 2; ++h)
#pragma unroll
                for (int i = 0; i < 2; ++i) v2[h][i] = last ? vn[h][i] : vc[h][i];
            if constexpr (SP2) {
            PG8_LDB(B0, 0, 0); PG8_LDB(B1, 0, 1); PG8_SCHED; PG8_LDA(At, 0, 0); PG8_STAGE(PG8_SA(1, 1), a1, vc[1]);
            PG8_WAIT_V(8); PG8_WAIT_L(0); PG8_BAR; PG8_MMA(0, 0, At, B0); PG8_MMA(0, 1, At, B1); PG8_BAR; PG8_SCHED;
            PG8_LDA(At, 0, 1); PG8_STAGE(PG8_SB(0, 0), b2, voffB); PG8_STAGE(PG8_SB(0, 1), b2 + hstep, voffB); PG8_STAGE(PG8_SA(0, 0), a2, v2[0]);
            PG8_WAIT_V(8); PG8_WAIT_L(0); PG8_BAR; PG8_MMA(1, 0, At, B0); PG8_MMA(1, 1, At, B1); PG8_BAR; PG8_SCHED;
            PG8_LDB(B0, 1, 0); PG8_LDB(B1, 1, 1); PG8_SCHED; PG8_LDA(At, 1, 0); PG8_STAGE(PG8_SA(0, 1), a2, v2[1]);
            PG8_WAIT_V(8); PG8_WAIT_L(0); PG8_BAR; PG8_MMA(0, 0, At, B0); PG8_MMA(0, 1, At, B1); PG8_BAR; PG8_SCHED;
            PG8_LDA(At, 1, 1); PG8_STAGE(PG8_SB(1, 0), b3, voffB); PG8_STAGE(PG8_SB(1, 1), b3 + hstep, voffB); PG8_STAGE(PG8_SA(1, 0), a3, v2[0]);
            PG8_WAIT_V(8); PG8_WAIT_L(0); PG8_BAR; PG8_MMA(1, 0, At, B0); PG8_MMA(1, 1, At, B1); PG8_BAR; PG8_SCHED;
            } else {
            PG8_LDB(B0, 0, 0); PG8_SCHED; PG8_LDA(At, 0, 0); PG8_STAGE(PG8_SA(1, 1), a1, vc[1]);
            PG8_WAIT_L(8); PG8_BAR; PG8_WAIT_L(0); PG8_MMA(0, 0, At, B0); PG8_BAR; PG8_SCHED;
            PG8_LDB(B1, 0, 1); PG8_STAGE(PG8_SB(0, 0), b2, voffB);
            PG8_BAR; PG8_WAIT_L(0); PG8_MMA(0, 1, At, B1); PG8_BAR;
            PG8_LDA(At, 0, 1); PG8_STAGE(PG8_SA(0, 0), a2, v2[0]);
            PG8_BAR; PG8_WAIT_L(0); PG8_MMA(1, 0, At, B0); PG8_BAR; PG8_SCHED;
            PG8_STAGE(PG8_SB(0, 1), b2 + hstep, voffB);
            PG8_WAIT_V(6); PG8_BAR; PG8_MMA(1, 1, At, B1); PG8_BAR;
            PG8_LDB(B0, 1, 0); PG8_SCHED; PG8_LDA(At, 1, 0); PG8_STAGE(PG8_SA(0, 1), a2, v2[1]);
            PG8_WAIT_L(8); PG8_BAR; PG8_WAIT_L(0); PG8_MMA(0, 0, At, B0); PG8_BAR; PG8_SCHED;
            PG8_LDB(B1, 1, 1); PG8_STAGE(PG8_SB(1, 0), b3, voffB);
            PG8_BAR; PG8_WAIT_L(0); PG8_MMA(0, 1, At, B1); PG8_BAR;
            PG8_LDA(At, 1, 1); PG8_STAGE(PG8_SA(1, 0), a3, v2[0]);
            PG8_BAR; PG8_WAIT_L(0); PG8_MMA(1, 0, At, B0); PG8_BAR; PG8_SCHED;
            PG8_STAGE(PG8_SB(1, 1), b3 + hstep, voffB);
            PG8_WAIT_V(6); PG8_BAR; PG8_MMA(1, 1, At, B1); PG8_BAR;
            }
        }
        if constexpr (ALIGN_EPI) { if (wr == 0) PG8_BAR; }
        E(acc, cur, wr, wc);
        if (!has_next) break;
#pragma unroll
        for (int a = 0; a < 2; ++a)
#pragma unroll
            for (int b = 0; b < 2; ++b)
#pragma unroll
                for (int m = 0; m < 4; ++m)
#pragma unroll
                    for (int n = 0; n < 2; ++n) acc[a][b][m][n] = (f32x4){0.f, 0.f, 0.f, 0.f};
        cur = nxt; cB = nB; ++ui;
#pragma unroll
        for (int h = 0; h < 2; ++h)
#pragma unroll
            for (int i = 0; i < 2; ++i) vc[h][i] = vn[h][i];
        if constexpr (ALIGN_EPI) { if (wr == 1) PG8_BAR; }
    }
    PG8_WAIT_V(0);
    if constexpr (!ALIGN_EPI) { if (wr == 0) PG8_BAR; }
    PG8_BAR;
#undef PG8_SA
#undef PG8_SB
#undef PG8_STAGE
#undef PG8_AVOFF
#undef PG8_LDA
#undef PG8_LDB
#undef PG8_MMA
#undef PG8_WAIT_V
#undef PG8_WAIT_L
#undef PG8_BAR
#undef PG8_SCHED
}
}

#define XB_TMO      128
#define XB_XCNT(j)  (256  + 64 * (j))
#define XB_XSUB(j)  (1280 + 64 * (j))
#define XB_XGEN(j)  (2304 + 64 * (j))
#define XB_TOP      3328
#define XB_TOPGEN   3392
#define XCD_BAR_WORDS 3456
#define XB_SPIN_CAP (1u << 20)
__device__ __forceinline__ unsigned xb_ld(unsigned* p)              { return __hip_atomic_load(p, __ATOMIC_RELAXED, __HIP_MEMORY_SCOPE_AGENT); }
__device__ __forceinline__ unsigned xb_add(unsigned* p, unsigned v) { return __hip_atomic_fetch_add(p, v, __ATOMIC_RELAXED, __HIP_MEMORY_SCOPE_AGENT); }
__device__ __forceinline__ unsigned xb_xcc_id() { return (unsigned)__builtin_amdgcn_s_getreg((3 << 11) | 20) & 0xFu; }
#define XB_SPIN(cond, bar) do { unsigned _sp = 0; while (cond) { __builtin_amdgcn_s_sleep(1); \
    if ((++_sp & 255u) == 0u) { if (xb_ld(&(bar)[XB_TMO])) break; if (_sp > XB_SPIN_CAP) { atomicAdd(&(bar)[XB_TMO], 1u); break; } } } } while (0)
struct XcdBarrier { unsigned* bar; unsigned x; volatile LAS unsigned* st; };
__device__ __forceinline__ XcdBarrier xcd_barrier_post(unsigned* bar, volatile LAS unsigned* st, bool leader) {
    XcdBarrier b; b.bar = bar; b.x = xb_xcc_id(); b.st = st;
    if (leader) (void)xb_add(&bar[XB_XCNT(b.x)], 1u);
    return b;
}
__device__ __forceinline__ void xcd_barrier_complete(unsigned* bar, unsigned x, unsigned& nloc, unsigned& nx) {
    const unsigned G = gridDim.x * gridDim.y * gridDim.z;
    unsigned sum, cnt, mine, sp = 0u;
    for (;;) {
        sum = 0u; cnt = 0u; mine = 0u;
#pragma unroll 1
        for (unsigned j = 0; j < 16; ++j) { const unsigned c = xb_ld(&bar[XB_XCNT(j)]); sum += c; cnt += (c > 0u) ? 1u : 0u; mine = (j == x) ? c : mine; }
        if (sum == G) break;
        __builtin_amdgcn_s_sleep(1);
        if ((++sp & 255u) == 0u) { if (xb_ld(&bar[XB_TMO])) break; if (sp > XB_SPIN_CAP) { atomicAdd(&bar[XB_TMO], 1u); break; } }
    }
    nloc = mine > 0u ? mine : 1u; nx = cnt > 0u ? cnt : 1u;
}
__device__ __forceinline__ void xcd_barrier(const XcdBarrier& b, bool leader) {
    asm volatile("s_waitcnt vmcnt(0)" ::: "memory");
    __syncthreads();
    if (leader) {
        unsigned* bar = b.bar;
        __builtin_amdgcn_s_waitcnt(0);
        unsigned nloc = b.st[0], nx = b.st[1];
        if (nloc == 0u) { xcd_barrier_complete(bar, b.x, nloc, nx); b.st[0] = nloc; b.st[1] = nx; }
        const unsigned old = xb_add(&bar[XB_XSUB(b.x)], 1u);
        const unsigned gen = old / nloc;
        if (old + 1u == (gen + 1u) * nloc) {
            __builtin_amdgcn_fence(__ATOMIC_RELEASE, "agent");
            asm volatile("s_waitcnt vmcnt(0)" ::: "memory");
            const unsigned og = xb_add(&bar[XB_TOP], 1u);
            const unsigned tg = og / nx;
            if (og + 1u == (tg + 1u) * nx) xb_add(&bar[XB_TOPGEN], 1u);
            else XB_SPIN(xb_ld(&bar[XB_TOPGEN]) == tg, bar);
            __builtin_amdgcn_fence(__ATOMIC_ACQUIRE, "agent");
            xb_add(&bar[XB_XGEN(b.x)], 1u);
            asm volatile("s_waitcnt vmcnt(0)" ::: "memory");
        } else {
            XB_SPIN(xb_ld(&bar[XB_XGEN(b.x)]) == gen, bar);
            __builtin_amdgcn_fence(__ATOMIC_ACQUIRE, "agent");
            asm volatile("s_waitcnt vmcnt(0)" ::: "memory");
        }
    }
    __syncthreads();
}

struct Args {
    const float* x; const float* w_in; const float* q_norm; const float* w_uq; const float* kv_norm; const float* w_ukv; const float* w_out;
    const float* ln1_g; const float* ln1_b; const float* router_w; const float* router_b; const float* w1; const float* w3; const float* w2;
    const float* ln2_g; const float* ln2_b;
    float* out; unsigned char* ws;
    int ph_lo, ph_hi;
};
struct Frame {
    LAS unsigned char* lds;
    volatile LAS unsigned* LC;
    gu32* ctl;
    unsigned char* ws;
    int wave, vcu, G;
};

template <class Map>
__device__ __forceinline__ void transpose_item(const float* W, int K, int N, bf16_t* WT, const float* kscale, LAS float* scr, int item, int lane, Map map) {
    const int nblk = N / 32, kb = item / nblk, nb = item % nblk, k0 = 64 * kb, n0 = 32 * nb;
    { const int c4 = (lane & 7) * 4; f32x4 v[8];
#pragma unroll
      for (int i = 0; i < 8; ++i) { const int kk = (lane >> 3) + 8 * i; v[i] = __builtin_nontemporal_load((const GAS f32x4*)(W + (size_t)(k0 + kk) * N + n0 + c4)); }
#pragma unroll
      for (int i = 0; i < 8; ++i) { const int kk = (lane >> 3) + 8 * i; f32x4 w = v[i]; if (kscale) w = w * kscale[k0 + kk];
          LAS float* d = scr + kk * 33 + c4; d[0] = w[0]; d[1] = w[1]; d[2] = w[2]; d[3] = w[3]; } }
    LDS_WAIT(); asm volatile("" ::: "memory");
    const int c = lane & 7;
#pragma unroll
    for (int j = 0; j < 4; ++j) { const int n = (lane >> 3) + 8 * j; const LAS float* s = scr + (8 * c) * 33 + n;
        u32x4 o; o.x = pk2(s[0], s[33]); o.y = pk2(s[66], s[99]); o.z = pk2(s[132], s[165]); o.w = pk2(s[198], s[231]);
        const int row = map(n0 + n);
        *(GAS u32x4*)(WT + (size_t)row * K + k0 + 8 * c) = o; }
    LDS_WAIT(); asm volatile("" ::: "memory");
}
__device__ __forceinline__ void router_item(const float* W, const float* g, bf16_t* WH, bf16_t* WL, LAS float* scr, int item, int lane) {
    const int K = 1024, N = 64, nblk = 2, kb = item / nblk, nb = item % nblk, k0 = 64 * kb, n0 = 32 * nb;
    { const int c4 = (lane & 7) * 4; f32x4 v[8];
#pragma unroll
      for (int i = 0; i < 8; ++i) { const int kk = (lane >> 3) + 8 * i; v[i] = __builtin_nontemporal_load((const GAS f32x4*)(W + (size_t)(k0 + kk) * N + n0 + c4)); }
#pragma unroll
      for (int i = 0; i < 8; ++i) { const int kk = (lane >> 3) + 8 * i; f32x4 w = v[i]; if (g) w = w * g[k0 + kk];
          LAS float* d = scr + kk * 33 + c4; d[0] = w[0]; d[1] = w[1]; d[2] = w[2]; d[3] = w[3]; } }
    LDS_WAIT(); asm volatile("" ::: "memory");
    const int c = lane & 7;
#pragma unroll
    for (int j = 0; j < 4; ++j) { const int n = (lane >> 3) + 8 * j; const LAS float* s = scr + (8 * c) * 33 + n;
        unsigned h[8], l[8];
#pragma unroll
        for (int q = 0; q < 8; ++q) { const float v = s[q * 33]; h[q] = f2bf(v); l[q] = f2bf(v - __builtin_bit_cast(float, h[q] << 16)); }
        u32x4 oh, ol; oh.x = h[0] | (h[1] << 16); oh.y = h[2] | (h[3] << 16); oh.z = h[4] | (h[5] << 16); oh.w = h[6] | (h[7] << 16);
        ol.x = l[0] | (l[1] << 16); ol.y = l[2] | (l[3] << 16); ol.z = l[4] | (l[5] << 16); ol.w = l[6] | (l[7] << 16);
        *(GAS u32x4*)(WH + (size_t)(n0 + n) * K + k0 + 8 * c) = oh; *(GAS u32x4*)(WL + (size_t)(n0 + n) * K + k0 + 8 * c) = ol; }
    LDS_WAIT(); asm volatile("" ::: "memory");
}
struct MapId { int off; __device__ __forceinline__ int operator()(int n) const { return off + n; } };
struct MapWin { __device__ __forceinline__ int operator()(int n) const {
    if (n < 384) return n;
    if (n < 416) { const int e = n - 384, nn = e >> 4, fq = (e >> 2) & 3, j = e & 3; return 384 + 8 * fq + 4 * nn + j; }
    const int m = n - 416, seg = m / 384, r = m % 384, hh = r >> 6, e = r & 63, base = 512 + seg * 384 + hh * 64;
    if (seg == 2 || seg == 5) return base + e;
    const int nn = e >> 5, wcl = (e >> 4) & 1, fq = (e >> 2) & 3, j = e & 3; return base + 32 * wcl + 8 * fq + 4 * nn + j; } };
struct MapW13 { int e, which; __device__ __forceinline__ int operator()(int n) const { return e * 512 + 256 * (n >> 7) + 128 * which + (n & 127); } };

__device__ __forceinline__ void sincos_d(double a, float& s, float& c) {
    const double INV = 0.15915494309189533577;
    const double t = a * INV; const float rf = (float)(t - __builtin_rint(t));
    s = __builtin_amdgcn_sinf(rf); c = __builtin_amdgcn_cosf(rf);
}

constexpr int MOE_ITEMS_L = 64 * 3 * 128;
constexpr int MOE_P0_FROM = 12288, MOE_L1_A = 11264, MOE_L1_B = 13312;
static_assert(DEPTH == 2, "the idle-tail conversion plan is written for two layers");
__device__ __forceinline__ void moe_convert_item(const Args& a, unsigned char* ws, int l, int r, LAS float* scr, int lane) {
    const int item = r % 128; r /= 128; const int which = r % 3, e = r / 3;
    bf16_t* W13t = (bf16_t*)(ws + WS_MOE + (size_t)l * MOE_L); bf16_t* W2t = (bf16_t*)(ws + WS_MOE + (size_t)l * MOE_L + 64 * MiB);
    const size_t eoff = ((size_t)l * 64 + e) * (size_t)(1024 * 256);
    if (which == 0) transpose_item(a.w1 + eoff, 1024, 256, W13t, nullptr, scr, item, lane, MapW13{e, 0});
    else if (which == 1) transpose_item(a.w3 + eoff, 1024, 256, W13t, nullptr, scr, item, lane, MapW13{e, 1});
    else transpose_item(a.w2 + eoff, 256, 1024, W2t, nullptr, scr, item, lane, MapId{e * 1024});
}
struct TDesc { const float* src; bf16_t* dst; int N, K; };
__device__ __forceinline__ TDesc moe_desc(const Args& a, unsigned char* ws, int l, int r) {
    const int item = r % 128; r /= 128; const int which = r % 3, e = r / 3;
    const size_t eoff = ((size_t)l * 64 + e) * (size_t)(1024 * 256);
    TDesc d;
    if (which < 2) { const int kb = item >> 3, n0 = 32 * (item & 7); d.N = 256; d.K = 1024;
        d.src = (which ? a.w3 : a.w1) + eoff + (size_t)(64 * kb) * 256 + n0;
        d.dst = (bf16_t*)(ws + WS_MOE + (size_t)l * MOE_L) + (size_t)(e * 512 + 256 * (n0 >> 7) + 128 * which + (n0 & 127)) * 1024 + 64 * kb; }
    else { const int kb = item >> 5, n0 = 32 * (item & 31); d.N = 1024; d.K = 256;
        d.src = a.w2 + eoff + (size_t)(64 * kb) * 1024 + n0;
        d.dst = (bf16_t*)(ws + WS_MOE + (size_t)l * MOE_L + 64 * MiB) + (size_t)(e * 1024 + n0) * 256 + 64 * kb; }
    return d;
}
__device__ __forceinline__ void tload(const TDesc& d, int lane, f32x4 (&v)[8]) {
#pragma unroll
    for (int i = 0; i < 8; ++i) v[i] = __builtin_nontemporal_load((const GAS f32x4*)(d.src + (size_t)((lane >> 3) + 8 * i) * d.N + (lane & 7) * 4));
}
__device__ __forceinline__ void tfinish(const TDesc& d, const f32x4 (&v)[8], LAS float* scr, int lane) {
    { const int c4 = (lane & 7) * 4;
#pragma unroll
      for (int i = 0; i < 8; ++i) { const int kk = (lane >> 3) + 8 * i; LAS float* p = scr + kk * 33 + c4; p[0] = v[i][0]; p[1] = v[i][1]; p[2] = v[i][2]; p[3] = v[i][3]; } }
    LDS_WAIT(); asm volatile("" ::: "memory");
    const int c = lane & 7;
#pragma unroll
    for (int j = 0; j < 4; ++j) { const int n = (lane >> 3) + 8 * j; const LAS float* s = scr + (8 * c) * 33 + n;
        u32x4 o; o.x = pk2(s[0], s[33]); o.y = pk2(s[66], s[99]); o.z = pk2(s[132], s[165]); o.w = pk2(s[198], s[231]);
        *(GAS u32x4*)(d.dst + (size_t)n * d.K + 8 * c) = o; }
    LDS_WAIT(); asm volatile("" ::: "memory");
}
__device__ __forceinline__ int moe_item(int q, int mode) { return mode == 0 ? q : mode == 1 ? (q >> 8) * 384 + (q & 255) : (q >> 7) * 384 + 256 + (q & 127); }
__device__ __forceinline__ void moe_convert_tail(Frame& F, const Args& a, int l, int lo, int hi, int nunits, int c, int mode = 0) {
    const int rounds = (nunits + F.G - 1) / F.G, busy_last = nunits - (rounds - 1) * F.G;
    int first = busy_last, npart = F.G - busy_last;
    if (npart <= 0) { first = 0; npart = F.G; }
    if (c < first) return;
    LAS float* scr = (LAS float*)(F.lds + F.wave * 16384); const int lane = lane_now();
    const int step = npart * NWAVES;
    int r = lo + (c - first) * NWAVES + F.wave;
    if (r >= hi) return;
    f32x4 va[8], vb[8];
    TDesc d0 = moe_desc(a, F.ws, l, moe_item(r, mode)); tload(d0, lane, va);
#pragma unroll 1
    for (;;) {
        const int r1 = r + step; const bool h1 = r1 < hi;
        TDesc d1 = d0; if (h1) { d1 = moe_desc(a, F.ws, l, moe_item(r1, mode)); tload(d1, lane, vb); }
        tfinish(d0, va, scr, lane);
        if (!h1) break;
        const int r2 = r1 + step; const bool h2 = r2 < hi;
        if (h2) { d0 = moe_desc(a, F.ws, l, moe_item(r2, mode)); tload(d0, lane, va); }
        tfinish(d1, vb, scr, lane);
        if (!h2) break;
        r = r2;
    }
}

__device__ __forceinline__ void p0_prologue(Frame& F, const Args& a) {
    LAS float* scr = (LAS float*)(F.lds + F.wave * 16384);
    const int gw = F.vcu * NWAVES + F.wave, NGW = F.G * NWAVES, lane = lane_now();
    unsigned char* ws = F.ws;
    constexpr int I_WIN = 16 * 85, I_WUQ = 4 * 12, I_WUKV = 2 * 16, I_WOUT = 16 * 32, I_RW = 16 * 2, I_MOE = 128;
    constexpr int PER_L = I_WIN + I_WUQ + I_WUKV + I_WOUT + I_RW;
    constexpr int N_SMALL = 2 * PER_L, N_MOE = MOE_ITEMS_L - MOE_P0_FROM, NITEMS = N_SMALL + N_MOE;
    moe_convert_tail(F, a, 0, MOE_P0_FROM, MOE_ITEMS_L, F.G, F.vcu);
    for (int it = gw; it < N_SMALL; it += NGW) {
        const int l = it / PER_L; int r = it % PER_L;
        if (r < I_WIN) { transpose_item(a.w_in + (size_t)l * 1024 * N_IN, 1024, N_IN, (bf16_t*)(ws + WS_WIN + (size_t)l * WIN_L), nullptr, scr, r, lane, MapWin{}); continue; } r -= I_WIN;
        if (r < I_WUQ) { transpose_item(a.w_uq + (size_t)l * 256 * 384, 256, 384, (bf16_t*)(ws + WS_WUQ) + (size_t)l * 384 * 256, a.q_norm + l * 256, scr, r, lane, MapId{0}); continue; } r -= I_WUQ;
        if (r < I_WUKV) { transpose_item(a.w_ukv + (size_t)l * 128 * 512, 128, 512, (bf16_t*)(ws + WS_WUKV) + (size_t)l * 512 * 128, a.kv_norm + l * 128, scr, r, lane, MapId{0}); continue; } r -= I_WUKV;
        if (r < I_WOUT) { transpose_item(a.w_out + (size_t)l * 1024 * 1024, 1024, 1024, (bf16_t*)(ws + WS_WOUT) + (size_t)l * 1024 * 1024, nullptr, scr, r, lane, MapId{0}); continue; } r -= I_WOUT;
        router_item(a.router_w, nullptr, (bf16_t*)(ws + WS_RW) + (size_t)(l * 2) * 65536, (bf16_t*)(ws + WS_RW) + (size_t)(l * 2 + 1) * 65536, scr, r, lane);
    }
    { const int gt = gw * 64 + lane, NT_ = NGW * 64;
      for (int i = gt; i < 2 * 96 * 128; i += NT_) { const int l = i / (96 * 128), r = i % (96 * 128);
          unsigned z_ = 0u; asm volatile("" : "+v"(z_)); *(GAS u32x4*)(ws + WS_WIN + (size_t)l * WIN_L + (size_t)416 * 2048 + (size_t)r * 16) = (u32x4){z_, z_, z_, z_}; }
      for (int i = gt; i < 4096 * 32; i += NT_) { const int pos = i >> 5, f = i & 31; const float ang = (float)pos * INV64[f]; float s, c; sincos_d((double)ang, s, c);
          ((GAS f32x2*)(ws + WS_T64))[i] = (f32x2){c, s}; }
      for (int i = gt; i < 4096 * 16; i += NT_) { const int pos = i >> 4, f = i & 15; const float ang = (float)pos * INV32[f]; float s, c; sincos_d((double)ang, s, c);
          ((GAS f32x2*)(ws + WS_T32))[i] = (f32x2){c, s}; }
    }
#ifdef TIMING_SEG
    if (gw == 0 && lane < 2) ((GAS unsigned*)(ws + WS_GB + 4096))[lane] = 0u;
#endif
    { bf16_t* xb = (bf16_t*)(ws + WS_XB);
      for (int it = gw; it < T * DM / 2048; it += NGW) { const size_t o = (size_t)it * 2048 + lane * 8;
          f32x4 v0[4], v1[4];
#pragma unroll
          for (int j = 0; j < 4; ++j) { v0[j] = __builtin_nontemporal_load((const GAS f32x4*)(a.x + o + 512 * j)); v1[j] = __builtin_nontemporal_load((const GAS f32x4*)(a.x + o + 512 * j + 4)); }
#pragma unroll
          for (int j = 0; j < 4; ++j) { u32x4 w; w.x = pk2(v0[j].x, v0[j].y); w.y = pk2(v0[j].z, v0[j].w); w.z = pk2(v1[j].x, v1[j].y); w.w = pk2(v1[j].z, v1[j].w);
              *(GAS u32x4*)(xb + o + 512 * j) = w; } } }
}

__device__ __forceinline__ u32x4 pack8(const f32x4& a, const f32x4& b) { u32x4 w; w.x = cvtpk(a[0], a[1]); w.y = cvtpk(a[2], a[3]); w.z = cvtpk(b[0], b[1]); w.w = cvtpk(b[2], b[3]); return w; }
__device__ __forceinline__ u32x2 pack4(const f32x4& a) { u32x2 w; w.x = cvtpk(a[0], a[1]); w.y = cvtpk(a[2], a[3]); return w; }

struct EpiP1 {
    static constexpr bool PERM = true;
    bf16_t *CQ, *CKV, *KR, *QKV; const f32x2* T64; const f32x2* T32; float* KM;
    __device__ __forceinline__ void operator()(const f32x4 (&acc)[2][2][4][2], const pg8::Unit& u, int wr, int wc) const {
        const int ln_ = lane_now(), fr = ln_ & 15, fq = ln_ >> 4;
        const int rowb = u.pm * 256 + wr * 64 + fr;
        if (u.pn == 0) {
#pragma unroll
            for (int ai = 0; ai < 2; ++ai)
#pragma unroll
                for (int m = 0; m < 4; ++m) { const size_t row = rowb + ai * 128 + m * 16;
#pragma unroll
                    for (int bj = 0; bj < 2; ++bj) *(GAS u32x4*)(CQ + row * 256 + bj * 128 + wc * 32 + 8 * fq) = pack8(acc[ai][bj][m][0], acc[ai][bj][m][1]); }
        } else if (u.pn == 1) {
#pragma unroll
            for (int ai = 0; ai < 2; ++ai) {
                f32x4 c = {1.f, 1.f, 1.f, 1.f}, s = {0.f, 0.f, 0.f, 0.f}, C = c, S = s;
                if (wc == 0) { const int pos0 = (int)((rowb + ai * 128) & 4095);
                    const f32x4 t0 = *(const GAS f32x4*)(T32 + pos0 * 16 + 4 * fq), t1 = *(const GAS f32x4*)(T32 + pos0 * 16 + 4 * fq + 2);
                    const f32x4 d0 = *(const GAS f32x4*)(T32 + 16 * 16 + 4 * fq), d1 = *(const GAS f32x4*)(T32 + 16 * 16 + 4 * fq + 2);
                    c = (f32x4){t0[0], t0[2], t1[0], t1[2]}; s = (f32x4){t0[1], t0[3], t1[1], t1[3]}; C = (f32x4){d0[0], d0[2], d1[0], d1[2]}; S = (f32x4){d0[1], d0[3], d1[1], d1[3]}; }
#pragma unroll
                for (int m = 0; m < 4; ++m) { const size_t row = rowb + ai * 128 + m * 16;
                    *(GAS u32x4*)(CKV + row * 128 + wc * 32 + 8 * fq) = pack8(acc[ai][0][m][0], acc[ai][0][m][1]);
                    if (wc == 0) {
                        const f32x4 x1 = acc[ai][1][m][0], x2 = acc[ai][1][m][1];
                        const f32x4 o1 = x1 * c - x2 * s, o2 = x2 * c + x1 * s;
                        *(GAS u32x2*)(KR + row * 32 + 4 * fq) = pack4(o1); *(GAS u32x2*)(KR + row * 32 + 16 + 4 * fq) = pack4(o2);
                        if (m < 3) { const f32x4 cn = c * C - s * S; s = s * C + c * S; c = cn; } }
                    asm volatile("" ::: "memory"); }
            }
        } else {
#pragma unroll
            for (int bj = 0; bj < 2; ++bj) {
                const int gh = (u.pn - 2) * 4 + 2 * bj + (wc >> 1), seg = gh / 6, hh = gh % 6, wcl = wc & 1;
                bf16_t* dst = QKV + (size_t)seg * SEG_ELEMS;
                if (seg == 2 || seg == 5) {
#pragma unroll
                    for (int ai = 0; ai < 2; ++ai)
#pragma unroll
                        for (int m = 0; m < 4; ++m) { const size_t row = rowb + ai * 128 + m * 16;
                            *(GAS u32x4*)(dst + row * 384 + hh * 64 + 32 * wcl + 8 * fq) = pack8(acc[ai][bj][m][0], acc[ai][bj][m][1]); }
                } else {
                    const int e0 = 16 * wcl + 4 * fq; f32x4 s1 = {0.f, 0.f, 0.f, 0.f}, s2 = {0.f, 0.f, 0.f, 0.f};
                    const float qs = (seg == 0 || seg == 3) ? 0.125f * LOG2E : 1.0f;
#pragma unroll
                    for (int ai = 0; ai < 2; ++ai) {
                        const int pos0 = (int)((rowb + ai * 128) & 4095);
                        const f32x4 t0 = *(const GAS f32x4*)(T64 + pos0 * 32 + e0), t1 = *(const GAS f32x4*)(T64 + pos0 * 32 + e0 + 2);
                        const f32x4 d0 = *(const GAS f32x4*)(T64 + 16 * 32 + e0), d1 = *(const GAS f32x4*)(T64 + 16 * 32 + e0 + 2);
                        f32x4 c = {t0[0], t0[2], t1[0], t1[2]}, s = {t0[1], t0[3], t1[1], t1[3]};
                        const f32x4 C = {d0[0], d0[2], d1[0], d1[2]}, S = {d0[1], d0[3], d1[1], d1[3]};
#pragma unroll
                        for (int m = 0; m < 4; ++m) { const size_t row = rowb + ai * 128 + m * 16;
                            const f32x4 x1 = acc[ai][bj][m][0], x2 = acc[ai][bj][m][1];
                            const f32x4 o1 = (x1 * c - x2 * s) * qs, o2 = (x2 * c + x1 * s) * qs;
                            *(GAS u32x4*)(dst + row * 384 + hh * 64 + 32 * wcl + 8 * fq) = pack8(o1, o2);
                            s1 += o1; s2 += o2;
                            if (m < 3) { const f32x4 cn = c * C - s * S; s = s * C + c * S; c = cn; }
                            asm volatile("" ::: "memory"); }
                    }
                    if (seg == 1) {
#pragma unroll
                        for (int j = 0; j < 4; ++j) {
                            s1[j] += swz_xor<1>(s1[j]); s2[j] += swz_xor<1>(s2[j]); s1[j] += swz_xor<2>(s1[j]); s2[j] += swz_xor<2>(s2[j]);
                            s1[j] += swz_xor<4>(s1[j]); s2[j] += swz_xor<4>(s2[j]); s1[j] += swz_xor<8>(s1[j]); s2[j] += swz_xor<8>(s2[j]); }
                        if (fr == 0) { float* km = KM + (((size_t)(u.pm >> 4) * 6 + hh) * 16 + (u.pm & 15)) * 64 + 32 * wcl + 8 * fq;
#pragma unroll
                            for (int j = 0; j < 4; ++j) { atomicAdd(km + j, s1[j]); atomicAdd(km + 4 + j, s2[j]); } }
                    }
                }
            }
        }
    }
};

struct EpiP3 {
    static constexpr bool PERM = false;
    const float* res; float* out; float* PS;
    __device__ __forceinline__ void operator()(const f32x4 (&acc)[2][2][4][2], const pg8::Unit& u, int wr, int wc) const {
        const int ln_ = lane_now(), fr = ln_ & 15, fq = ln_ >> 4;
        const int col0 = u.pn * 256 + wc * 32 + 4 * fq;
#pragma unroll
        for (int ai = 0; ai < 2; ++ai) {
            f32x4 rv[4][2][2];
#pragma unroll
            for (int m = 0; m < 4; ++m) { const size_t row = u.pm * 256 + ai * 128 + wr * 64 + m * 16 + fr;
#pragma unroll
                for (int bj = 0; bj < 2; ++bj)
#pragma unroll
                    for (int n = 0; n < 2; ++n) rv[m][bj][n] = *(const GAS f32x4*)(res + row * 1024 + col0 + bj * 128 + n * 16); }
#pragma unroll
            for (int m = 0; m < 4; ++m) { const size_t row = u.pm * 256 + ai * 128 + wr * 64 + m * 16 + fr; float s = 0.f, q = 0.f;
#pragma unroll
                for (int bj = 0; bj < 2; ++bj)
#pragma unroll
                    for (int n = 0; n < 2; ++n) { const size_t off = row * 1024 + col0 + bj * 128 + n * 16;
                        const f32x4 v = rv[m][bj][n] * ALPHA + acc[ai][bj][m][n]; *(GAS f32x4*)(out + off) = v;
                        s += (v[0] + v[1]) + (v[2] + v[3]); q += (v[0] * v[0] + v[1] * v[1]) + (v[2] * v[2] + v[3] * v[3]); }
                s += swz_xor<16>(s); q += swz_xor<16>(q); s = xsum32(s); q = xsum32(q);
                if (fq == 0) *(GAS f32x2*)(PS + ((row * 4 + u.pn) * 4 + wc) * 2) = (f32x2){s, q}; }
            asm volatile("" ::: "memory"); }
    }
};

struct MoeSched {
    const LAS int* tb; const LAS int* cnt; const int* tokslot; int NCT, G, c, ntiles; bool gather;
    __device__ __forceinline__ bool next(int i, pg8::Unit& u) const {
        const long L = (long)i * G + c; if (L >= (long)ntiles * NCT) return false;
        const int tau = (int)(L / NCT), ct = (int)(L % NCT);
        int lo = 0, hi = 64;
        while (hi - lo > 1) { const int mid = (lo + hi) >> 1; if (tb[mid] <= tau) lo = mid; else hi = mid; }
        u.pm = tau; u.pn = lo * NCT + ct; return true;
    }
    __device__ __forceinline__ int a_row(const pg8::Unit& u, int r) const {
        if (!gather) return u.pm * 256 + r;
        const int e = u.pn / NCT, slot = (u.pm - tb[e]) * 256 + r;
        return slot < cnt[e] ? (tokslot[(size_t)e * CAP + slot] >> 1) : 0;
    }
};
__device__ __forceinline__ float silu_f(float x) { return x * __builtin_amdgcn_rcpf(1.f + __builtin_amdgcn_exp2f(-x * LOG2E)); }
struct EpiP5 {
    static constexpr bool PERM = true;
    bf16_t* H;
    __device__ __forceinline__ void operator()(const f32x4 (&acc)[2][2][4][2], const pg8::Unit& u, int wr, int wc) const {
        const int ln_ = lane_now(), fr = ln_ & 15, fq = ln_ >> 4;
        const int ct = u.pn & 1;
#pragma unroll
        for (int ai = 0; ai < 2; ++ai)
#pragma unroll
            for (int m = 0; m < 4; ++m) { const size_t row = (size_t)u.pm * 256 + ai * 128 + wr * 64 + m * 16 + fr;
                f32x4 v[2];
#pragma unroll
                for (int n = 0; n < 2; ++n)
#pragma unroll
                    for (int j = 0; j < 4; ++j) v[n][j] = silu_f(acc[ai][0][m][n][j]) * acc[ai][1][m][n][j];
                *(GAS u32x4*)(H + row * 256 + ct * 128 + wc * 32 + 8 * fq) = pack8(v[0], v[1]); }
    }
};
struct EpiP6 {
    static constexpr bool PERM = true;
    bf16_t* Y; const LAS int* tb; const LAS int* cnt; const int* tokslot; const float* gate;
    __device__ __forceinline__ void operator()(const f32x4 (&acc)[2][2][4][2], const pg8::Unit& u, int wr, int wc) const {
        const int ln_ = lane_now(), fr = ln_ & 15, fq = ln_ >> 4;
        const int e = u.pn >> 2, ct = u.pn & 3, bs = (u.pm - tb[e]) * 256, ne = cnt[e];
        int dstv[2][4]; float gv[2][4];
#pragma unroll
        for (int ai = 0; ai < 2; ++ai)
#pragma unroll
            for (int m = 0; m < 4; ++m) { const int slot = bs + ai * 128 + wr * 64 + m * 16 + fr; const size_t idx = (size_t)e * CAP + (slot < ne ? slot : 0);
                dstv[ai][m] = tokslot[idx]; gv[ai][m] = gate[idx]; }
#pragma unroll
        for (int ai = 0; ai < 2; ++ai)
#pragma unroll
            for (int m = 0; m < 4; ++m) { const int slot = bs + ai * 128 + wr * 64 + m * 16 + fr;
                if (slot < ne) { const size_t dst = (size_t)dstv[ai][m]; const float g = gv[ai][m];
#pragma unroll
                    for (int bj = 0; bj < 2; ++bj) *(GAS u32x4*)(Y + dst * 1024 + ct * 256 + bj * 128 + wc * 32 + 8 * fq) = pack8(acc[ai][bj][m][0] * g, acc[ai][bj][m][1] * g); } }
    }
};

#define MFMA32(a, b, c) __builtin_amdgcn_mfma_f32_32x32x16_bf16(a, b, c, 0, 0, 0)
__device__ __forceinline__ float ssq8(const bf16x8& v) { float s = 0.f;
#pragma unroll
    for (int j = 0; j < 8; ++j) { const float f = bf2f((unsigned short)v[j]); s += f * f; } return s; }

__device__ __forceinline__ void blk_store(const f32x16& acc, LAS unsigned char* osc, bf16_t* dst0, int pitch, int r32, int hi) {
    const int sw = (r32 >> 2) & 3;
#pragma unroll
    for (int g = 0; g < 4; ++g) { u32x2 w; w.x = cvtpk(acc[4 * g], acc[4 * g + 1]); w.y = cvtpk(acc[4 * g + 2], acc[4 * g + 3]); *(LAS u32x2*)(osc + r32 * 64 + ((g ^ sw) * 16) + 8 * hi) = w; }
    LDS_WAIT(); asm volatile("" ::: "memory");
    const int ln = lane_now(), tk = ln >> 2, ch = ln & 3;
#pragma unroll
    for (int j = 0; j < 2; ++j) { const int t = tk + 16 * j; const u32x4 v = *(const LAS u32x4*)(osc + t * 64 + ((ch ^ ((t >> 2) & 3)) * 16));
        *(GAS u32x4*)(dst0 + (size_t)t * pitch + ch * 8) = v; }
    LDS_WAIT(); asm volatile("" ::: "memory");
}
constexpr float MLA_QSCALE = 0.10206207261596575f * LOG2E;
__device__ __forceinline__ void p1b_mla(Frame& F, int l) {
    unsigned char* ws = F.ws;
    const bf16_t* CQ = (const bf16_t*)(ws + WS_CQ); const bf16_t* CKV = (const bf16_t*)(ws + WS_CKV); const bf16_t* KR = (const bf16_t*)(ws + WS_KR);
    const bf16_t* Wuq = (const bf16_t*)(ws + WS_WUQ) + (size_t)l * 384 * 256; const bf16_t* Wukv = (const bf16_t*)(ws + WS_WUKV) + (size_t)l * 512 * 128;
    bf16_t* QA = (bf16_t*)(ws + WS_QA); bf16_t* KA = (bf16_t*)(ws + WS_KA); bf16_t* VA = (bf16_t*)(ws + WS_VA);
    const f32x2* T32 = (const f32x2*)(ws + WS_T32);
    const int lane = lane_now(), wave = F.wave, tid = wave * 64 + lane, r32 = lane & 31, hi = lane >> 5, path = wave >> 2;
    LAS unsigned char* osc = F.lds + 98304 + wave * 2048;
    LAS unsigned char* lds = F.lds;
    for (int it0 = F.vcu * 4; it0 < T / 32; it0 += F.G * 4) {
        const int it = it0 + (wave & 3);
        const size_t tok = (size_t)it * 32 + r32; const int pos = (int)(tok & 4095);
        u32x4 wq[2][2], wk[2];
#define W_LOAD(sp) do { _Pragma("unroll") for (int h_ = 0; h_ < 2; ++h_) { const int sn_ = 2 * (sp) + h_; \
            if (sn_ < 12) { _Pragma("unroll") for (int i_ = 0; i_ < 2; ++i_) { const int p_ = tid + 512 * i_, row_ = p_ >> 5, c_ = p_ & 31; wq[h_][i_] = *(const GAS u32x4*)(Wuq + (size_t)(32 * sn_ + row_) * 256 + c_ * 8); } } \
            { const int row_ = tid >> 4, c_ = tid & 15; wk[h_] = *(const GAS u32x4*)(Wukv + (size_t)(32 * sn_ + row_) * 128 + c_ * 8); } } } while (0)
#define W_WRITE(sp, b) do { _Pragma("unroll") for (int h_ = 0; h_ < 2; ++h_) { const int sn_ = 2 * (sp) + h_; \
            if (sn_ < 12) { _Pragma("unroll") for (int i_ = 0; i_ < 2; ++i_) { const int p_ = tid + 512 * i_, row_ = p_ >> 5, c_ = p_ & 31; *(LAS u32x4*)(lds + (b) * 49152 + h_ * 16384 + row_ * 512 + ((c_ ^ (row_ & 15)) * 16)) = wq[h_][i_]; } } \
            { const int row_ = tid >> 4, c_ = tid & 15; *(LAS u32x4*)(lds + (b) * 49152 + 32768 + h_ * 8192 + row_ * 256 + ((c_ ^ (row_ & 15)) * 16)) = wk[h_]; } } } while (0)
        f32x4 cs[2][2];
#pragma unroll
        for (int g = 0; g < 2; ++g) { cs[g][0] = *(const GAS f32x4*)(T32 + pos * 16 + 8 * g + 4 * hi); cs[g][1] = *(const GAS f32x4*)(T32 + pos * 16 + 8 * g + 4 * hi + 2); }
        W_LOAD(0);
        bf16x8 bq[16]; float ss = 0.f;
        { LAS unsigned char* sc = lds + wave * 16384; const size_t t0w = (size_t)it * 32; const int lane = lane_now();
          if (path == 0) {
#pragma unroll
              for (int hb = 0; hb < 2; ++hb) { u32x4 t_[8];
#pragma unroll
                  for (int i = 0; i < 8; ++i) { const int row = 2 * (8 * hb + i) + (lane >> 5), ch = lane & 31; t_[i] = *(const GAS u32x4*)(CQ + (t0w + row) * 256 + ch * 8); }
#pragma unroll
                  for (int i = 0; i < 8; ++i) { const int row = 2 * (8 * hb + i) + (lane >> 5), ch = lane & 31; *(LAS u32x4*)(sc + row * 512 + ((ch ^ row) & 31) * 16) = t_[i]; }
                  asm volatile("" ::: "memory"); }
              LDS_WAIT(); asm volatile("" ::: "memory");
#pragma unroll
              for (int ks = 0; ks < 16; ++ks) { bq[ks] = *(const LAS bf16x8*)(sc + r32 * 512 + (((2 * ks + hi) ^ r32) & 31) * 16); ss += ssq8(bq[ks]); }
          } else {
              u32x4 t_[8];
#pragma unroll
              for (int i = 0; i < 8; ++i) { const int row = 4 * i + (lane >> 4), ch = lane & 15; t_[i] = *(const GAS u32x4*)(CKV + (t0w + row) * 128 + ch * 8); }
#pragma unroll
              for (int i = 0; i < 8; ++i) { const int row = 4 * i + (lane >> 4), ch = lane & 15; *(LAS u32x4*)(sc + row * 256 + ((ch ^ row) & 15) * 16) = t_[i]; }
              LDS_WAIT(); asm volatile("" ::: "memory");
#pragma unroll
              for (int ks = 0; ks < 8; ++ks) { bq[ks] = *(const LAS bf16x8*)(sc + r32 * 256 + (((2 * ks + hi) ^ r32) & 15) * 16); ss += ssq8(bq[ks]); }
#pragma unroll
              for (int ks = 8; ks < 16; ++ks) bq[ks] = bq[0];
          }
          LDS_WAIT(); }
        __syncthreads();
        ss += xhalf(ss);
        const float rs = (path == 0) ? MLA_QSCALE / sqrtf(ss * (1.0f / 256.0f) + RMS_EPS) : 1.0f / sqrtf(ss * (1.0f / 128.0f) + RMS_EPS);
        W_WRITE(0, 0);
        __syncthreads();
#pragma unroll 1
        for (int sp = 0; sp < 8; ++sp) {
            if (sp + 1 < 8) W_LOAD(sp + 1);
#pragma unroll 1
            for (int h2 = 0; h2 < 2; ++h2) {
            const int sn = 2 * sp + h2;
            const LAS unsigned char* wbq = lds + (sp & 1) * 49152 + h2 * 16384; const LAS unsigned char* wbk = lds + (sp & 1) * 49152 + 32768 + h2 * 8192;
            if (path == 0) {
                if (sn < 12) {
                    f32x16 acc = {};
#pragma unroll
                    for (int ks = 0; ks < 16; ++ks) { const bf16x8 a = *(const LAS bf16x8*)(wbq + r32 * 512 + (((2 * ks + hi) ^ (r32 & 15)) * 16)); acc = MFMA32(a, bq[ks], acc); }
#pragma unroll
                    for (int r = 0; r < 16; ++r) acc[r] *= rs;
                    const int head = sn / 3, part = sn % 3;
                    if (part == 2) {
#pragma unroll
                        for (int r = 0; r < 8; ++r) { const int g = r >> 2, j = r & 3; const float c = cs[g][j >> 1][(j & 1) * 2], sv = cs[g][j >> 1][(j & 1) * 2 + 1];
                            const float x1 = acc[r], x2 = acc[r + 8]; acc[r] = x1 * c - x2 * sv; acc[r + 8] = x2 * c + x1 * sv; }
                    }
                    blk_store(acc, osc, QA + (size_t)it * 32 * 384 + head * 96 + part * 32, 384, r32, hi);
                }
            } else {
                f32x16 acc = {};
#pragma unroll
                for (int ks = 0; ks < 8; ++ks) { const bf16x8 a = *(const LAS bf16x8*)(wbk + r32 * 256 + (((2 * ks + hi) ^ (r32 & 15)) * 16)); acc = MFMA32(a, bq[ks], acc); }
#pragma unroll
                for (int r = 0; r < 16; ++r) acc[r] *= rs;
                const int head = sn >> 2, part = sn & 3;
                if (part < 2) blk_store(acc, osc, KA + (size_t)it * 32 * 384 + head * 96 + part * 32, 384, r32, hi);
                else blk_store(acc, osc, VA + (size_t)it * 32 * 256 + head * 64 + (part - 2) * 32, 256, r32, hi);
            }
            }
            if (sp + 1 < 8) { if (sp & 1) W_WRITE(sp + 1, 0); else W_WRITE(sp + 1, 1); }
            __syncthreads();
        }
#undef W_LOAD
#undef W_WRITE
        if (path == 1) {
            const u32x4 k0 = *(const GAS u32x4*)(KR + tok * 32 + 16 * hi), k1 = *(const GAS u32x4*)(KR + tok * 32 + 16 * hi + 8);
#pragma unroll
            for (int h = 0; h < 4; ++h) { *(GAS u32x4*)(KA + tok * 384 + h * 96 + 64 + 16 * hi) = k0; *(GAS u32x4*)(KA + tok * 384 + h * 96 + 64 + 16 * hi + 8) = k1; }
        }
    }
}

__device__ __forceinline__ void p1c_moba_gate(Frame& F, int l, int rep) {
    unsigned char* ws = F.ws;
    const bf16_t* Qb = (const bf16_t*)(ws + WS_QKV);
    const float* KM = (const float*)(F.ctl + CW_KMEAN) + (size_t)l * (8 * 6 * 16 * 64);
    unsigned* cnt = (unsigned*)(F.ctl + CW_MOBA) + (size_t)(rep ? 2 + l + 2 * (rep - 1) : l) * 768 * 64;
    int* list = (int*)(ws + (rep ? WS_MOE + (size_t)(1 - l) * MOE_L : WS_MLIST));
    const int gw = F.vcu * NWAVES + F.wave, NGW = F.G * NWAVES, lane = lane_now(), r32 = lane & 31, hi = lane >> 5;
    for (int tw = gw; tw < 48 * 128; tw += NGW) {
        const int bh = tw >> 7, qg = tw & 127, nb = qg >> 3;
        if (nb == 0) continue;
        const int b = bh / 6, h = bh % 6, t = 32 * qg + r32;
        const bf16_t* qrow = Qb + ((size_t)b * SEQ + t) * 384 + h * 64 + 8 * hi;
        int i1 = 0, i2 = 1, i3 = 2;
        if (nb > 3) {
            bf16x8 qr[4];
#pragma unroll
            for (int d0 = 0; d0 < 4; ++d0) qr[d0] = *(const GAS bf16x8*)(qrow + 16 * d0);
            LAS float* kml = (LAS float*)(F.lds + F.wave * 4096);
            { const float* kmg = KM + (size_t)bh * 16 * 64 + 4 * lane; f32x4 t_[4];
#pragma unroll
              for (int i = 0; i < 4; ++i) t_[i] = *(const GAS f32x4*)(kmg + 256 * i);
#pragma unroll
              for (int i = 0; i < 4; ++i) *(LAS f32x4*)(kml + 4 * lane + 256 * i) = t_[i]; }
            asm volatile("" ::: "memory");
            float v1 = -3e38f, v2 = -3e38f, v3 = -3e38f;
#pragma unroll
            for (int j = 0; j < 15; ++j) {
                if (j < nb) {
                    float g = 0.f;
#pragma unroll
                    for (int d0 = 0; d0 < 4; ++d0) { const LAS float* kp = kml + j * 64 + 16 * d0 + 8 * hi; const f32x4 a = *(const LAS f32x4*)kp, bb = *(const LAS f32x4*)(kp + 4);
                        const bf16x8 qv = qr[d0];
#define QF(e) bf2f((unsigned short)qv[e])
                        g += QF(0) * a[0] + QF(1) * a[1] + QF(2) * a[2] + QF(3) * a[3] + QF(4) * bb[0] + QF(5) * bb[1] + QF(6) * bb[2] + QF(7) * bb[3];
#undef QF
                    }
                    g += xhalf(g);
                    if (g > v1) { v3 = v2; i3 = i2; v2 = v1; i2 = i1; v1 = g; i1 = j; }
                    else if (g > v2) { v3 = v2; i3 = i2; v2 = g; i2 = j; }
                    else if (g > v3) { v3 = g; i3 = j; }
                }
            }
        }
        asm volatile("" ::: "memory");
        {
            const int ns = nb < 3 ? nb : 3;
            unsigned base_[3], rank_[3]; int lead_[3]; bool want_[3];
#pragma unroll
            for (int sl = 0; sl < 3; ++sl) {
                const int blk = (sl == 0) ? i1 : (sl == 1 ? i2 : i3);
                const bool want = (hi == 0) && (sl < ns); want_[sl] = want;
                unsigned long long todo = __ballot(want), mygrp = 0ull; int mylead = 0;
                while (todo) {
                    const int leader = __builtin_ctzll(todo);
                    const int bsel = __builtin_amdgcn_readlane(blk, leader);
                    const unsigned long long grp = __ballot(want && blk == bsel);
                    if (want && blk == bsel) { mygrp = grp; mylead = leader; }
                    todo &= ~grp;
                }
                lead_[sl] = mylead; rank_[sl] = (unsigned)__builtin_popcountll(mygrp & ((1ull << lane) - 1ull));
                base_[sl] = 0u;
                if (want && lane == mylead) base_[sl] = atomicAdd(cnt + (size_t)(bh * 16 + blk) * 64, (unsigned)__builtin_popcountll(mygrp));
            }
#pragma unroll
            for (int sl = 0; sl < 3; ++sl) {
                const int blk = (sl == 0) ? i1 : (sl == 1 ? i2 : i3);
                const unsigned base = (unsigned)__builtin_amdgcn_ds_bpermute(lead_[sl] << 2, (int)base_[sl]);
                if (want_[sl]) list[(size_t)(bh * 16 + blk) * MOBA_CAP + base + rank_[sl]] = (t << 2) | sl;
            }
        }
    }
}

typedef const LAS char* lds_cptr;
typedef short v4i16_t __attribute__((ext_vector_type(4)));
__device__ __forceinline__ s16x4 vtr(lds_cptr p) { return __builtin_bit_cast(s16x4, __builtin_amdgcn_ds_read_tr16_b64_v4i16((LAS v4i16_t*)p)); }
#define MX3(a, b, c) __builtin_fmaxf(__builtin_fmaxf((a), (b)), (c))
__device__ __forceinline__ float rowmax32(const f32x16& p0, const f32x16& p1) {
    float a = MX3(p0[0], p0[1], p1[0]), b = MX3(p0[2], p0[3], p1[1]); a = MX3(a, p1[2], p1[3]);
#pragma unroll
    for (int r = 4; r < 16; r += 4) { a = MX3(a, p0[r], p0[r + 1]); b = MX3(b, p0[r + 2], p0[r + 3]); a = MX3(a, p1[r], p1[r + 1]); b = MX3(b, p1[r + 2], p1[r + 3]); }
    const float m = __builtin_fmaxf(a, b); auto rr = __builtin_amdgcn_permlane32_swap(__float_as_uint(m), __float_as_uint(m), false, false);
    return __builtin_fmaxf(__uint_as_float(rr[0]), __uint_as_float(rr[1]));
}
struct AttnSt { f32x16 o0, o1, o2; float mhat; int first; };
constexpr float NEG_BIG = -1e30f, SM_THR = 8.0f;
__device__ __forceinline__ void attn_init(AttnSt& st) { st.o0 = f32x16{}; st.o1 = f32x16{}; st.o2 = f32x16{}; st.mhat = 0.f; st.first = 1; }

template <int DK, bool SPLIT = false>
__device__ __forceinline__ void qk_tile(f32x16& p0, f32x16& p1, lds_cptr K, const bf16x8* qr, const float mhat, int r32, int hi) {
    constexpr int RB = (DK > 64) ? 256 : 128;
    f32x16 negm;
#pragma unroll
    for (int r = 0; r < 16; ++r) negm[r] = -mhat;
    const lds_cptr kb = K + r32 * RB; const int sw = r32 & 7;
    if constexpr (SPLIT) {
        bf16x8 kf[DK / 16];
#pragma unroll
        for (int d0 = 0; d0 < DK / 16; ++d0) kf[d0] = *(const LAS bf16x8*)(kb + ((2 * d0 + hi) ^ sw) * 16);
        __builtin_amdgcn_sched_barrier(0);
#pragma unroll
        for (int d0 = 0; d0 < DK / 16; ++d0) p0 = MFMA32(kf[d0], qr[d0], d0 == 0 ? negm : p0);
        __builtin_amdgcn_sched_barrier(0);
#pragma unroll
        for (int d0 = 0; d0 < DK / 16; ++d0) kf[d0] = *(const LAS bf16x8*)(kb + 32 * RB + ((2 * d0 + hi) ^ sw) * 16);
        __builtin_amdgcn_sched_barrier(0);
#pragma unroll
        for (int d0 = 0; d0 < DK / 16; ++d0) p1 = MFMA32(kf[d0], qr[d0], d0 == 0 ? negm : p1);
        return;
    }
    bf16x8 kf0[DK / 16], kf1[DK / 16];
#pragma unroll
    for (int d0 = 0; d0 < DK / 16; ++d0) { const int co = ((2 * d0 + hi) ^ sw) * 16; kf0[d0] = *(const LAS bf16x8*)(kb + co); kf1[d0] = *(const LAS bf16x8*)(kb + 32 * RB + co); }
    __builtin_amdgcn_sched_barrier(0);
#pragma unroll
    for (int d0 = 0; d0 < DK / 16; ++d0) { p0 = MFMA32(kf0[d0], qr[d0], d0 == 0 ? negm : p0); p1 = MFMA32(kf1[d0], qr[d0], d0 == 0 ? negm : p1); }
}
__device__ __forceinline__ void softmax_step(f32x16& p0, f32x16& p1, AttnSt& st, LAS float* wsf, int r32, int hi, u32x4 (&pw)[4]) {
    const float rm = rowmax32(p0, p1);
    const bool first = st.first != 0;
    if (first || __any(rm > SM_THR)) {
        const float dl = first ? ((rm < -1e29f) ? 0.f : rm) : __builtin_fmaxf(rm, 0.f);
        st.mhat += dl;
#pragma unroll
        for (int r = 0; r < 16; ++r) { p0[r] -= dl; p1[r] -= dl; }
        if (!first) {
            const float f = __builtin_amdgcn_exp2f(-dl);
            if (hi == 0) wsf[r32] = f;
#pragma unroll
            for (int r = 0; r < 16; ++r) { const float a = wsf[crow(r, hi)]; st.o0[r] *= a; st.o1[r] *= a; st.o2[r] *= a; }
        }
        st.first = 0;
    }
#pragma unroll
    for (int r = 0; r < 16; ++r) { p0[r] = __builtin_amdgcn_exp2f(p0[r]); p1[r] = __builtin_amdgcn_exp2f(p1[r]); }
    pw[0] = (u32x4){cvtpk(p0[0], p0[1]), cvtpk(p0[2], p0[3]), cvtpk(p0[4], p0[5]), cvtpk(p0[6], p0[7])};
    pw[1] = (u32x4){cvtpk(p0[8], p0[9]), cvtpk(p0[10], p0[11]), cvtpk(p0[12], p0[13]), cvtpk(p0[14], p0[15])};
    pw[2] = (u32x4){cvtpk(p1[0], p1[1]), cvtpk(p1[2], p1[3]), cvtpk(p1[4], p1[5]), cvtpk(p1[6], p1[7])};
    pw[3] = (u32x4){cvtpk(p1[8], p1[9]), cvtpk(p1[10], p1[11]), cvtpk(p1[12], p1[13]), cvtpk(p1[14], p1[15])};
}
struct VFrag { s16x4 l0[4], h0[4], l1[4], h1[4]; };
__device__ __forceinline__ void pv_load(VFrag& vf, lds_cptr V, int lane) {
    const int hi = lane >> 5;
    const lds_cptr vp = V + ((lane >> 4) & 1) * 32 + (lane & 3) * 8 + (4 * hi + ((lane & 15) >> 2)) * 64;
#pragma unroll
    for (int ks = 0; ks < 4; ++ks) { vf.l0[ks] = vtr(vp + ks * 1024); vf.h0[ks] = vtr(vp + ks * 1024 + 512); vf.l1[ks] = vtr(vp + 4096 + ks * 1024); vf.h1[ks] = vtr(vp + 4096 + ks * 1024 + 512); }
    __builtin_amdgcn_sched_barrier(0);
}
__device__ __forceinline__ void pv_mma(AttnSt& st, const VFrag& vf, const u32x4 (&pw)[4]) {
#pragma unroll
    for (int ks = 0; ks < 4; ++ks) {
        const bf16x8 f0 = {vf.l0[ks][0], vf.l0[ks][1], vf.l0[ks][2], vf.l0[ks][3], vf.h0[ks][0], vf.h0[ks][1], vf.h0[ks][2], vf.h0[ks][3]};
        const bf16x8 f1 = {vf.l1[ks][0], vf.l1[ks][1], vf.l1[ks][2], vf.l1[ks][3], vf.h1[ks][0], vf.h1[ks][1], vf.h1[ks][2], vf.h1[ks][3]};
        const bf16x8 pa = __builtin_bit_cast(bf16x8, pw[ks]);
        const bf16x8 ones = {0x3F80, 0x3F80, 0x3F80, 0x3F80, 0x3F80, 0x3F80, 0x3F80, 0x3F80};
        st.o0 = MFMA32(pa, f0, st.o0); st.o1 = MFMA32(pa, f1, st.o1); st.o2 = MFMA32(pa, ones, st.o2); }
}
__device__ __forceinline__ void pv_tile(AttnSt& st, lds_cptr V, const u32x4 (&pw)[4], int lane) { VFrag vf; pv_load(vf, V, lane); pv_mma(st, vf, pw); }
__device__ __forceinline__ void attn_finish(AttnSt& st, LAS float* wsf, int r32, int hi, float (&rli)[16], float& lse2) {
    if (r32 == 0) {
#pragma unroll
        for (int r = 0; r < 16; ++r) wsf[32 + crow(r, hi)] = st.o2[r]; }
#pragma unroll
    for (int r = 0; r < 16; ++r) rli[r] = __builtin_amdgcn_rcpf(st.o2[r]);
    lse2 = st.mhat + __builtin_amdgcn_logf(wsf[32 + r32]);
}

constexpr int AL_K0 = 0, AL_K1 = 16384, AL_V0 = 32768, AL_V1 = 40960, AL_WSF = 65536, AL_OST = 67584;
constexpr int AL_M = 67584, AL_ML = 67584 + 65536;

template <int DK>
__device__ __forceinline__ void attn_shared_unit(Frame& F, const bf16_t* Qp, int qpitch, const bf16_t* Kp, int kpitch, const bf16_t* Vp, int vpitch, bf16_t* Op,
                                                 int q0, int NT, float sc, bool moba, const float* km, const int abl) {
    const int lane = lane_now(), wid = F.wave, tid = wid * 64 + lane, r32 = lane & 31, hi = lane >> 5;
    LAS unsigned char* lds = F.lds; LAS float* wsf = (LAS float*)(lds + AL_WSF) + wid * 64;
    bf16x8 qr[DK / 16];
    { const bf16_t* qrow = Qp + (size_t)(q0 + wid * 32 + r32) * qpitch + 8 * hi;
#pragma unroll
      for (int d0 = 0; d0 < DK / 16; ++d0) qr[d0] = *(const GAS bf16x8*)(qrow + 16 * d0); }
    constexpr int RB = (DK > 64) ? 256 : 128;
    const int krow = tid >> 3, kch = tid & 7, vdh = tid >> 8, vrow = (tid >> 2) & 63, vc4 = tid & 3;
    const int krow2 = (tid >> 2) & 63, kch2 = 8 + (tid & 3);
    const bf16_t* ksrc = Kp + (size_t)krow * kpitch + kch * 8;
    const bf16_t* ksrc2 = Kp + (size_t)krow2 * kpitch + kch2 * 8;
    const bf16_t* vsrc = Vp + (size_t)vrow * vpitch + vdh * 32 + vc4 * 8;
    const int kdst = krow * RB + ((kch ^ (krow & 7)) * 16), kdst2 = krow2 * RB + ((kch2 ^ (krow2 & 7)) * 16), vdst = vdh * 4096 + vrow * 64 + vc4 * 16;
    const bool k2 = (DK > 64) && (tid < 256);
    u32x4 kreg0, kreg1, vreg; { unsigned z_ = 0u; asm volatile("" : "+v"(z_)); kreg1 = (u32x4){z_, z_, z_, z_}; }
    kreg0 = *(const GAS u32x4*)ksrc; if (k2) kreg1 = *(const GAS u32x4*)ksrc2; vreg = *(const GAS u32x4*)vsrc;
    *(LAS u32x4*)(lds + AL_K0 + kdst) = kreg0; if (k2) *(LAS u32x4*)(lds + AL_K0 + kdst2) = kreg1; *(LAS u32x4*)(lds + AL_V0 + vdst) = vreg;
    __syncthreads();
    AttnSt st; attn_init(st);
    const int qrel = wid * 32 + r32;
#pragma unroll 1
    for (int t = 0; t < NT; ++t) {
        const int cur = t & 1;
        const bool more = (t + 1 < NT);
        if (more) { const size_t ro = (size_t)(t + 1) * 64;
            kreg0 = *(const GAS u32x4*)(ksrc + ro * kpitch); if (k2) kreg1 = *(const GAS u32x4*)(ksrc2 + ro * kpitch); vreg = *(const GAS u32x4*)(vsrc + ro * vpitch); }
        const int jb = t - (NT - 4);
        const bool active = (jb < 0) || (64 * jb <= 32 * wid + 31);
        if (active) {
            const lds_cptr Kb = (lds_cptr)(lds + (cur ? AL_K1 : AL_K0)), Vb = (lds_cptr)(lds + (cur ? AL_V1 : AL_V0));
            f32x16 p0, p1;
            qk_tile<DK>(p0, p1, Kb, qr, st.mhat, r32, hi);
            if (jb >= 0) {
#pragma unroll
                for (int r = 0; r < 16; ++r) { const int kv = 64 * jb + crow(r, hi); p0[r] = (kv > qrel) ? NEG_BIG : p0[r]; p1[r] = (kv + 32 > qrel) ? NEG_BIG : p1[r]; }
            }
            VFrag vf; pv_load(vf, Vb, lane);
            u32x4 pw[4];
            softmax_step(p0, p1, st, wsf, r32, hi, pw);
            pv_mma(st, vf, pw);
        }
        if (more) { const int kb = cur ? AL_K0 : AL_K1, vb = cur ? AL_V0 : AL_V1;
            *(LAS u32x4*)(lds + kb + kdst) = kreg0; if (k2) *(LAS u32x4*)(lds + kb + kdst2) = kreg1; *(LAS u32x4*)(lds + vb + vdst) = vreg; }
        __syncthreads();
    }
    float rli[16], lse2; attn_finish(st, wsf, r32, hi, rli, lse2);
    LAS bf16_t* stg = (LAS bf16_t*)(lds + AL_OST) + wid * 2048;
#pragma unroll
    for (int r = 0; r < 16; ++r) { const int orow = crow(r, hi); const unsigned w_ = cvtpk(st.o0[r] * rli[r], st.o1[r] * rli[r]); stg[orow * 64 + r32] = (bf16_t)(w_ & 0xffffu); stg[orow * 64 + 32 + r32] = (bf16_t)(w_ >> 16); }
#pragma unroll
    for (int i = 0; i < 4; ++i) { const int row = i * 8 + (lane >> 3), ch = lane & 7; const u32x4 v = *(const LAS u32x4*)(stg + row * 64 + ch * 8);
        *(GAS u32x4*)(Op + (size_t)(q0 + wid * 32 + row) * 1024 + ch * 8) = v; }
    __syncthreads();
}

__device__ __forceinline__ void dil_step(int sidx, int wid, int p0, int& dil, int& tres, int& lf) {
    if (sidx < 3) { dil = 1; tres = 0; lf = p0 - 128 + 64 * ((wid >> 1) + sidx); }
    else if (sidx < 6) { dil = 4; tres = wid >> 1; lf = (p0 >> 2) - 128 + 64 * (sidx - 3); }
    else { const int s = sidx - 6; dil = 16; tres = 2 * wid + (s >= 3 ? 1 : 0); lf = (p0 >> 4) - 128 + 64 * (s >= 3 ? s - 3 : s); }
}
__device__ __forceinline__ unsigned dil_rowoff(int dil, int tres, int lf, int lane, int i) {
    int kpos = (lf + 8 * i + (lane >> 3)) * dil + tres; kpos = kpos < 0 ? 0 : (kpos > SEQ - 1 ? SEQ - 1 : kpos); return (unsigned)kpos * 384u + (unsigned)(lane & 7) * 8u;
}
__device__ __forceinline__ void dil_query(int br, int wid, int p0, int r32, int& dil, int& rrq, int& lq) {
    if (br == 0) { dil = 1; rrq = 0; lq = p0 + 32 * wid + r32; }
    else if (br == 1) { dil = 4; rrq = wid >> 1; lq = (p0 >> 2) + 32 * (wid & 1) + r32; }
    else { dil = 16; rrq = 2 * wid + (r32 >> 4); lq = (p0 >> 4) + (r32 & 15); }
}
#ifdef TIMING_SEG
#define TSTAMP(i) do { if ((abl & 128) && ((i) == 0 || (i) == 6 || (i) == TIMING_SEG || (i) == TIMING_SEG + 1)) { __builtin_amdgcn_sched_barrier(0); unsigned long long t_; asm volatile("s_memtime %0\n\ts_waitcnt lgkmcnt(0)" : "=s"(t_) :: "memory"); __builtin_amdgcn_sched_barrier(0); \
    const unsigned tl_ = (unsigned)t_; \
    if (tprobe) { if ((i) == 0) atomicAdd(tw + 1, 0u - tl_); if ((i) == TIMING_SEG) atomicAdd(tw, 0u - tl_); if ((i) == TIMING_SEG + 1) atomicAdd(tw, tl_); if ((i) == 6) atomicAdd(tw + 1, tl_); } } } while (0)
#else
#define TSTAMP(i) do {} while (0)
#endif
__device__ __forceinline__ void dil_mask(f32x16& p0s, f32x16& p1s, int lf, int lq, int lq0, int hi) {
    if (lf >= 0 && lq0 - (lf + 63) >= 0 && lq0 + 31 - lf <= 128) return;
    const int D = lq - lf - 4 * hi;
    if (lf >= 0) {
#pragma unroll
        for (int r = 0; r < 16; ++r) { const int c = (r & 3) + 8 * (r >> 2);
            p0s[r] = ((unsigned)(D - c) <= 128u) ? p0s[r] : NEG_BIG; p1s[r] = ((unsigned)(D - c - 32) <= 128u) ? p1s[r] : NEG_BIG; }
    } else {
#pragma unroll
        for (int r = 0; r < 16; ++r) {
            const int lk0 = lf + crow(r, hi), lk1 = lk0 + 32; const int d0_ = lq - lk0, d1_ = lq - lk1;
            const bool ok0 = (lk0 >= 0) && (d0_ >= 0) && (d0_ <= 128), ok1 = (lk1 >= 0) && (d1_ >= 0) && (d1_ <= 128);
            p0s[r] = ok0 ? p0s[r] : NEG_BIG; p1s[r] = ok1 ? p1s[r] : NEG_BIG; }
    }
}
constexpr int DL_M = 98304, DL_ML = 131072, DL_WSF = 132096;
__device__ __forceinline__ void attn_dilated_unit(Frame& F, const bf16_t* Qc, const bf16_t* Kc, const bf16_t* Vc, bf16_t* Op, float* L14, int p0, const int abl, const unsigned nxt) {
    const int lane = lane_now(), wid = F.wave, tid = wid * 64 + lane, r32 = lane & 31, hi = lane >> 5;
    LAS unsigned char* lds = F.lds; LAS float* wsf = (LAS float*)(lds + DL_WSF) + wid * 64;
    LAS bf16_t* M = (LAS bf16_t*)(lds + DL_M); LAS float* ML = (LAS float*)(lds + DL_ML);
    const int srow = tid >> 3, sch = tid & 7;
    const int skd = srow * 128 + ((sch ^ (srow & 7)) * 16), svd = 8192 + (sch >> 2) * 4096 + srow * 64 + (sch & 3) * 16;
    bf16x8 qr[4];
    { const bf16_t* qrow = Qc + (size_t)(p0 + 32 * wid + r32) * 384 + 8 * hi;
#pragma unroll
      for (int d0 = 0; d0 < 4; ++d0) qr[d0] = *(const GAS bf16x8*)(qrow + 16 * d0); }
    bf16x8 q1[4];
    { const bf16_t* qrow = Qc + (size_t)(((p0 >> 2) + 32 * (wid & 1) + r32) * 4 + (wid >> 1)) * 384 + 8 * hi;
#pragma unroll
      for (int d0 = 0; d0 < 4; ++d0) q1[d0] = *(const GAS bf16x8*)(qrow + 16 * d0); }
    { u32x4 kk[6], vv[6];
#pragma unroll
      for (int i = 0; i < 6; ++i) { int kpos = p0 - 128 + 64 * i + srow; kpos = kpos < 0 ? 0 : kpos; const size_t off = (size_t)kpos * 384 + sch * 8;
          kk[i] = *(const GAS u32x4*)(Kc + off); vv[i] = *(const GAS u32x4*)(Vc + off); }
#pragma unroll
      for (int i = 0; i < 6; ++i) { *(LAS u32x4*)(lds + i * 16384 + skd) = kk[i]; *(LAS u32x4*)(lds + i * 16384 + svd) = vv[i]; } }
    if (tid == 0) F.LC[LC_BCAST] = nxt;
    __syncthreads();
    u32x4 k1[4], v1[4];
#pragma unroll
    for (int t = 0; t < 4; ++t) { int kpos = ((p0 >> 2) - 128 + srow) * 4 + t; kpos = kpos < 0 ? 0 : kpos; const size_t off = (size_t)kpos * 384 + sch * 8;
        k1[t] = *(const GAS u32x4*)(Kc + off); v1[t] = *(const GAS u32x4*)(Vc + off); }
    {
        const int lq = p0 + 32 * wid + r32;
        AttnSt st; attn_init(st);
#pragma unroll 1
        for (int s = 0; s < 3; ++s) {
            const int ti = (wid >> 1) + s, lf = p0 - 128 + 64 * ti;
            const lds_cptr Kb = (lds_cptr)(lds + ti * 16384), Vb = Kb + 8192;
            f32x16 p0s, p1s;
            qk_tile<64>(p0s, p1s, Kb, qr, st.mhat, r32, hi);
            dil_mask(p0s, p1s, lf, lq, p0 + 32 * wid, hi);
            VFrag vf; pv_load(vf, Vb, lane);
            u32x4 pw[4];
            softmax_step(p0s, p1s, st, wsf, r32, hi, pw);
            pv_mma(st, vf, pw);
        }
        float rli[16], lse2; attn_finish(st, wsf, r32, hi, rli, lse2);
#pragma unroll
        for (int r = 0; r < 16; ++r) { const int row = 32 * wid + crow(r, hi); const unsigned w_ = cvtpk(st.o0[r] * rli[r], st.o1[r] * rli[r]);
            M[row * 64 + r32] = (bf16_t)(w_ & 0xffffu); M[row * 64 + 32 + r32] = (bf16_t)(w_ >> 16); }
        if (hi == 0) ML[32 * wid + r32] = lse2;
    }
    __syncthreads();
    {
        const int rr = wid >> 1, lq = (p0 >> 2) + 32 * (wid & 1) + r32;
#pragma unroll
        for (int d0 = 0; d0 < 4; ++d0) qr[d0] = q1[d0];
        AttnSt st; attn_init(st);
#pragma unroll 1
        for (int s = 0; s < 3; ++s) {
#pragma unroll
            for (int t = 0; t < 4; ++t) { *(LAS u32x4*)(lds + t * 16384 + skd) = k1[t]; *(LAS u32x4*)(lds + t * 16384 + svd) = v1[t]; }
            __syncthreads();
            if (s < 2) {
#pragma unroll
                for (int t = 0; t < 4; ++t) { int kpos = ((p0 >> 2) - 128 + 64 * (s + 1) + srow) * 4 + t; kpos = kpos < 0 ? 0 : kpos; const size_t off = (size_t)kpos * 384 + sch * 8;
                    k1[t] = *(const GAS u32x4*)(Kc + off); v1[t] = *(const GAS u32x4*)(Vc + off); } }
            const int lf = (p0 >> 2) - 128 + 64 * s;
            const lds_cptr Kb = (lds_cptr)(lds + rr * 16384), Vb = Kb + 8192;
            f32x16 p0s, p1s;
            qk_tile<64>(p0s, p1s, Kb, qr, st.mhat, r32, hi);
            dil_mask(p0s, p1s, lf, lq, (p0 >> 2) + 32 * (wid & 1), hi);
            VFrag vf; pv_load(vf, Vb, lane);
            u32x4 pw[4];
            softmax_step(p0s, p1s, st, wsf, r32, hi, pw);
            pv_mma(st, vf, pw);
            __syncthreads();
        }
        float rli[16], lse2; attn_finish(st, wsf, r32, hi, rli, lse2);
#define PROW(q) (4 * (32 * (wid & 1) + (q)) + rr)
        if (hi == 0) wsf[r32] = lse2;
        LAS bf16_t* stg = (LAS bf16_t*)lds + wid * 2048;
#pragma unroll
        for (int r = 0; r < 16; ++r) { const int q = crow(r, hi), row = PROW(q); const float lb = wsf[q], la = ML[row]; const float mx = __builtin_fmaxf(la, lb);
            const float wa = __builtin_amdgcn_exp2f(la - mx), wb = __builtin_amdgcn_exp2f(lb - mx), inv = __builtin_amdgcn_rcpf(wa + wb);
            const float m0 = bf2f(M[row * 64 + r32]), m1 = bf2f(M[row * 64 + 32 + r32]);
            const unsigned w_ = cvtpk((wa * m0 + wb * (st.o0[r] * rli[r])) * inv, (wa * m1 + wb * (st.o1[r] * rli[r])) * inv);
            stg[q * 64 + r32] = (bf16_t)(w_ & 0xffffu); stg[q * 64 + 32 + r32] = (bf16_t)(w_ >> 16); }
        if (hi == 0) { const int row = PROW(r32); const float la = ML[row], lb = lse2, mx = __builtin_fmaxf(la, lb);
            L14[(size_t)(p0 + row) * 6] = mx + __builtin_amdgcn_logf(__builtin_amdgcn_exp2f(la - mx) + __builtin_amdgcn_exp2f(lb - mx)); }
        asm volatile("" ::: "memory");
#pragma unroll
        for (int i = 0; i < 4; ++i) { const int q = i * 8 + (lane >> 3), ch = lane & 7; const u32x4 v = *(const LAS u32x4*)(stg + q * 64 + ch * 8);
            *(GAS u32x4*)(Op + (size_t)(p0 + PROW(q)) * 1024 + ch * 8) = v; }
#undef PROW
    }
    __syncthreads();
}

constexpr int AL_MK = 0, AL_MV = 32768, AL_ENT = 100352;
__device__ __forceinline__ void moba_emit(LAS unsigned char* lds, int wid, int lane, AttnSt& st, int myidx, bf16_t* PBo, float* PBl) {
    const int r32 = lane & 31, hi = lane >> 5;
    LAS float* wsf = (LAS float*)(lds + AL_WSF) + wid * 64; LAS int* ent = (LAS int*)(lds + AL_ENT) + wid * 32;
    float rli[16], lse2; attn_finish(st, wsf, r32, hi, rli, lse2);
    if (hi == 0) { ent[r32] = myidx; if (myidx >= 0) PBl[myidx] = lse2; }
    LAS bf16_t* stg = (LAS bf16_t*)(lds + AL_OST) + wid * 2048;
#pragma unroll
    for (int r = 0; r < 16; ++r) { const int orow = crow(r, hi); const unsigned w_ = cvtpk(st.o0[r] * rli[r], st.o1[r] * rli[r]); stg[orow * 64 + r32] = (bf16_t)(w_ & 0xffffu); stg[orow * 64 + 32 + r32] = (bf16_t)(w_ >> 16); }
    asm volatile("" ::: "memory");
#pragma unroll
    for (int i = 0; i < 4; ++i) { const int row = i * 8 + (lane >> 3), ch = lane & 7; const int idx = ent[row]; const u32x4 v = *(const LAS u32x4*)(stg + row * 64 + ch * 8);
        if (idx >= 0) *(GAS u32x4*)(PBo + (size_t)idx * 64 + ch * 8) = v; }
    asm volatile("" ::: "memory");
}
__device__ __forceinline__ void attn_moba_kb_unit(Frame& F, const bf16_t* Qp, const bf16_t* Kp, const bf16_t* Vp, bf16_t* PBo, float* PBl, int j, const int* list, int n, const int abl, const unsigned nxt) {
    const int lane = lane_now(), wid = F.wave, tid = wid * 64 + lane, r32 = lane & 31, hi = lane >> 5;
    LAS unsigned char* lds = F.lds; LAS float* wsf = (LAS float*)(lds + AL_WSF) + wid * 64;
    { u32x4 kk[4], vv[4];
#pragma unroll
      for (int i = 0; i < 4; ++i) { const int pc = tid + 512 * i, row = pc >> 3, ch = pc & 7; const size_t so = (size_t)(256 * j + row) * 384 + ch * 8;
          kk[i] = *(const GAS u32x4*)(Kp + so); vv[i] = *(const GAS u32x4*)(Vp + so); }
#pragma unroll
      for (int i = 0; i < 4; ++i) { const int pc = tid + 512 * i, row = pc >> 3, ch = pc & 7;
          *(LAS u32x4*)(lds + AL_MK + row * 128 + ((ch ^ (row & 7)) * 16)) = kk[i];
          *(LAS u32x4*)(lds + AL_MV + (row >> 6) * 8192 + (ch >> 2) * 4096 + (row & 63) * 64 + (ch & 3) * 16) = vv[i]; } }
    if (tid == 0) F.LC[LC_BCAST] = nxt;
    __syncthreads();
    { const int tq = 256 * j + 32 * wid + r32, qrel = 32 * wid + r32;
      bf16x8 qr[4]; const bf16_t* qrow = Qp + (size_t)tq * 384 + 8 * hi;
#pragma unroll
      for (int d0 = 0; d0 < 4; ++d0) qr[d0] = *(const GAS bf16x8*)(qrow + 16 * d0);
      AttnSt st; attn_init(st);
#pragma unroll 1
      for (int tt = 0; tt <= (wid >> 1); ++tt) {
          f32x16 p0, p1; qk_tile<64>(p0, p1, (lds_cptr)(lds + AL_MK + tt * 8192), qr, st.mhat, r32, hi);
#pragma unroll
          for (int r = 0; r < 16; ++r) { const int kv = 64 * tt + crow(r, hi); p0[r] = (kv > qrel) ? NEG_BIG : p0[r]; p1[r] = (kv + 32 > qrel) ? NEG_BIG : p1[r]; }
          VFrag vf; pv_load(vf, (lds_cptr)(lds + AL_MV + tt * 8192), lane);
          u32x4 pw[4]; softmax_step(p0, p1, st, wsf, r32, hi, pw); pv_mma(st, vf, pw); }
      moba_emit(lds, wid, lane, st, tq * 4 + 3, PBo, PBl); }
    const int ng = (n + 31) >> 5;
#pragma unroll 1
    for (int g = wid; g < ng; g += NWAVES) {
        const int ei = 32 * g + r32; const bool valid = ei < n; const int e = list[valid ? ei : 0];
        const int tq = e >> 2, myidx = valid ? (tq * 4 + (e & 3)) : -1;
        bf16x8 qr[4]; const bf16_t* qrow = Qp + (size_t)tq * 384 + 8 * hi;
#pragma unroll
        for (int d0 = 0; d0 < 4; ++d0) qr[d0] = *(const GAS bf16x8*)(qrow + 16 * d0);
        AttnSt st; attn_init(st);
#pragma unroll 1
        for (int t8 = 0; t8 < ((abl & 256) ? 8 : 4); ++t8) { const int tt = t8 & 3;
            f32x16 p0, p1; qk_tile<64>(p0, p1, (lds_cptr)(lds + AL_MK + tt * 8192), qr, st.mhat, r32, hi);
            VFrag vf; pv_load(vf, (lds_cptr)(lds + AL_MV + tt * 8192), lane);
            u32x4 pw[4]; softmax_step(p0, p1, st, wsf, r32, hi, pw); pv_mma(st, vf, pw); }
        moba_emit(lds, wid, lane, st, myidx, PBo, PBl);
    }
    __syncthreads();
}
constexpr int AL_OSTF = 67584;
__device__ __forceinline__ void d16_load(const bf16_t* Kc, const bf16_t* Vc, int rr, int tid, u32x4 (&kk)[4], u32x4 (&vv)[4]) {
#pragma unroll
    for (int i = 0; i < 4; ++i) { const int pc = tid + 512 * i, row = pc >> 3, ch = pc & 7; const size_t so = (size_t)(16 * row + rr) * 384 + ch * 8;
        kk[i] = *(const GAS u32x4*)(Kc + so); vv[i] = *(const GAS u32x4*)(Vc + so); }
}
__device__ __forceinline__ void attn_d16_unit(Frame& F, const bf16_t* Qc, bf16_t* Op, const float* L14, int rr, u32x4 (&kk)[4], u32x4 (&vv)[4],
                                              const bool has_next, const bf16_t* Kn, const bf16_t* Vn, int rrn) {
    const int lane = lane_now(), wid = F.wave, tid = wid * 64 + lane, r32 = lane & 31, hi = lane >> 5;
    LAS unsigned char* lds = F.lds; LAS float* wsf = (LAS float*)(lds + AL_WSF) + wid * 64;
    const int lq = 32 * wid + r32;
    bf16x8 qr[4]; { const bf16_t* qrow = Qc + (size_t)(16 * lq + rr) * 384 + 8 * hi;
#pragma unroll
      for (int d0 = 0; d0 < 4; ++d0) qr[d0] = *(const GAS bf16x8*)(qrow + 16 * d0); }
#pragma unroll
    for (int i = 0; i < 4; ++i) { const int pc = tid + 512 * i, row = pc >> 3, ch = pc & 7;
        *(LAS u32x4*)(lds + AL_MK + row * 128 + ((ch ^ (row & 7)) * 16)) = kk[i];
        *(LAS u32x4*)(lds + AL_MV + (row >> 6) * 8192 + (ch >> 2) * 4096 + (row & 63) * 64 + (ch & 3) * 16) = vv[i]; }
    __syncthreads();
    if (has_next) d16_load(Kn, Vn, rrn, tid, kk, vv);
    float la_[4]; u32x4 ov_[4];
#pragma unroll
    for (int i = 0; i < 4; ++i) { const int row = i * 8 + (lane >> 3), ch = lane & 7; const size_t tq = (size_t)16 * (32 * wid + row) + rr;
        la_[i] = L14[tq * 6]; ov_[i] = *(const GAS u32x4*)(Op + tq * 1024 + ch * 8); }
    AttnSt st; attn_init(st);
    const int t_lo = (32 * wid - 128) < 0 ? 0 : ((32 * wid - 128) >> 6), t_hi = (32 * wid + 31) >> 6;
#pragma unroll 1
    for (int tt = t_lo; tt <= t_hi; ++tt) {
        f32x16 p0, p1; qk_tile<64>(p0, p1, (lds_cptr)(lds + AL_MK + tt * 8192), qr, st.mhat, r32, hi);
#pragma unroll
        for (int r = 0; r < 16; ++r) { const int d0_ = lq - (64 * tt + crow(r, hi)), d1_ = d0_ - 32;
            p0[r] = (d0_ >= 0 && d0_ <= 128) ? p0[r] : NEG_BIG; p1[r] = (d1_ >= 0 && d1_ <= 128) ? p1[r] : NEG_BIG; }
        VFrag vf; pv_load(vf, (lds_cptr)(lds + AL_MV + tt * 8192), lane);
        u32x4 pw[4]; softmax_step(p0, p1, st, wsf, r32, hi, pw); pv_mma(st, vf, pw); }
    float rli[16], lse2; attn_finish(st, wsf, r32, hi, rli, lse2);
    LAS float* ostf = (LAS float*)(lds + AL_OSTF) + wid * 2048;
    asm volatile("" ::: "memory");
    if (hi == 0) wsf[r32] = lse2;
#pragma unroll
    for (int r = 0; r < 16; ++r) { const int orow = crow(r, hi); ostf[orow * 64 + r32] = st.o0[r] * rli[r]; ostf[orow * 64 + 32 + r32] = st.o1[r] * rli[r]; }
    asm volatile("" ::: "memory");
#pragma unroll
    for (int i = 0; i < 4; ++i) { const int row = i * 8 + (lane >> 3), ch = lane & 7; const size_t tq = (size_t)16 * (32 * wid + row) + rr;
        const float lb = wsf[row], la = la_[i]; const float mx = __builtin_fmaxf(la, lb);
        const float wa = __builtin_amdgcn_exp2f(la - mx), wb = __builtin_amdgcn_exp2f(lb - mx), inv = 1.0f / (wa + wb), ca = wa * inv, cb = wb * inv;
        const f32x4 b0 = *(const LAS f32x4*)(ostf + row * 64 + ch * 8), b1 = *(const LAS f32x4*)(ostf + row * 64 + ch * 8 + 4);
        bf16_t* op = Op + tq * 1024 + ch * 8; const u32x4 v = ov_[i];
        u32x4 o; o.x = cvtpk(ca * bflo(v.x) + cb * b0[0], ca * bfhi(v.x) + cb * b0[1]); o.y = cvtpk(ca * bflo(v.y) + cb * b0[2], ca * bfhi(v.y) + cb * b0[3]);
        o.z = cvtpk(ca * bflo(v.z) + cb * b1[0], ca * bfhi(v.z) + cb * b1[1]); o.w = cvtpk(ca * bflo(v.w) + cb * b1[2], ca * bfhi(v.w) + cb * b1[3]);
        *(GAS u32x4*)op = o; }
    __syncthreads();
}
__device__ __forceinline__ void p2c_d16(Frame& F) {
    unsigned char* ws = F.ws; const bf16_t* QKV = (const bf16_t*)(ws + WS_QKV); bf16_t* O = (bf16_t*)(ws + WS_XB); const float* L14 = (const float*)(ws + WS_PS);
    const int tid = F.wave * 64 + lane_now();
    u32x4 kk[4], vv[4];
#define D16_PTR(u_, seg_) (QKV + (seg_) * SEG_ELEMS + (size_t)(((u_) >> 4) / 6) * SEQ * 384 + (((u_) >> 4) % 6) * 64)
    if (F.vcu < 768) d16_load(D16_PTR(F.vcu, 4), D16_PTR(F.vcu, 5), F.vcu & 15, tid, kk, vv);
    for (int u = F.vcu; u < 768; u += F.G) { const int bh = u >> 4, rr = u & 15, b = bh / 6, h = bh % 6; const size_t rb = (size_t)b * SEQ;
        const int un = u + F.G; const bool has_next = un < 768; const int uc = has_next ? un : u;
        attn_d16_unit(F, D16_PTR(u, 3), O + rb * 1024 + 640 + h * 64, L14 + rb * 6 + h, rr, kk, vv, has_next, D16_PTR(uc, 4), D16_PTR(uc, 5), uc & 15); }
#undef D16_PTR
}

__device__ __forceinline__ void moba_merge_task(const bf16_t* PBo, const float* PBl, bf16_t* O, int task) {
    const int ch = task & 7, t = (task >> 3) & 4095, bh = task >> 15, b = bh / 6, h = bh % 6;
    const int nb = t >> 8, nv = nb < 3 ? nb : 3;
    const size_t base = ((size_t)bh * 4096 + t) * 4;
    const f32x4 ls = *(const GAS f32x4*)(PBl + base);
    u32x4 v[4];
#pragma unroll
    for (int sl = 0; sl < 4; ++sl) v[sl] = *(const GAS u32x4*)(PBo + (base + ((sl == 3 || sl < nv) ? sl : 3)) * 64 + ch * 8);
    float mx = ls[3];
    if (nv > 0) mx = __builtin_fmaxf(mx, ls[0]); if (nv > 1) mx = __builtin_fmaxf(mx, ls[1]); if (nv > 2) mx = __builtin_fmaxf(mx, ls[2]);
    float w[4]; w[0] = nv > 0 ? __builtin_amdgcn_exp2f(ls[0] - mx) : 0.f; w[1] = nv > 1 ? __builtin_amdgcn_exp2f(ls[1] - mx) : 0.f; w[2] = nv > 2 ? __builtin_amdgcn_exp2f(ls[2] - mx) : 0.f; w[3] = __builtin_amdgcn_exp2f(ls[3] - mx);
    const float inv = 1.0f / (w[0] + w[1] + w[2] + w[3]);
    float acc[8] = {0.f, 0.f, 0.f, 0.f, 0.f, 0.f, 0.f, 0.f};
#pragma unroll
    for (int sl = 0; sl < 4; ++sl) { const float ww = w[sl] * inv;
        acc[0] += ww * bflo(v[sl].x); acc[1] += ww * bfhi(v[sl].x); acc[2] += ww * bflo(v[sl].y); acc[3] += ww * bfhi(v[sl].y); acc[4] += ww * bflo(v[sl].z); acc[5] += ww * bfhi(v[sl].z); acc[6] += ww * bflo(v[sl].w); acc[7] += ww * bfhi(v[sl].w); }
    u32x4 o; o.x = cvtpk(acc[0], acc[1]); o.y = cvtpk(acc[2], acc[3]); o.z = cvtpk(acc[4], acc[5]); o.w = cvtpk(acc[6], acc[7]);
    *(GAS u32x4*)(O + ((size_t)b * SEQ + t) * 1024 + 256 + h * 64 + ch * 8) = o;
}
__device__ __forceinline__ void p2c_moba_merge(Frame& F, const bf16_t* PBo, const float* PBl) {
    bf16_t* O = (bf16_t*)(F.ws + WS_XB);
    const int gt = (F.vcu * NWAVES + F.wave) * 64 + lane_now(), NT_ = F.G * NWAVES * 64;
    constexpr int NTASK = 48 * 4096 * 8;
    int task = gt;
    for (; task + 3 * NT_ < NTASK; task += 4 * NT_) {
        moba_merge_task(PBo, PBl, O, task); moba_merge_task(PBo, PBl, O, task + NT_); moba_merge_task(PBo, PBl, O, task + 2 * NT_); moba_merge_task(PBo, PBl, O, task + 3 * NT_); }
    for (; task < NTASK; task += NT_) moba_merge_task(PBo, PBl, O, task);
}

__device__ __forceinline__ void p2_attention(Frame& F0, int l, int rep, const int abl, bf16_t* PBo, float* PBl) {
    Frame& F = F0;
    unsigned char* ws = F.ws;
    const bf16_t* QKV = (const bf16_t*)(ws + WS_QKV); const bf16_t* QA = (const bf16_t*)(ws + WS_QA); const bf16_t* KA = (const bf16_t*)(ws + WS_KA); const bf16_t* VA = (const bf16_t*)(ws + WS_VA);
    bf16_t* O = (bf16_t*)(ws + WS_XB);
    const float* KM = (const float*)(F.ctl + CW_KMEAN) + (size_t)l * (8 * 6 * 16 * 64);
    unsigned* queue = (unsigned*)(F.ctl + CW_QUEUE + 64 * (l + 2 * rep));
    float* L14 = (float*)(ws + WS_PS);
    const unsigned* mcnt = (const unsigned*)(F.ctl + CW_MOBA) + (size_t)l * 768 * 64; const int* mlist = (const int*)(ws + WS_MLIST);
    if (F.wave == 0 && lane_now() == 0) F.LC[LC_BCAST] = atomicAdd(queue, 1u);
    for (;;) {
        __syncthreads();
        const int uq = __builtin_amdgcn_readfirstlane((int)F.LC[LC_BCAST]);
        __syncthreads();
        if (uq >= 2048) break;
        const bool ahead = (uq >= 512);
        unsigned nxt_ = 0u; if (ahead && F.wave == 0 && lane_now() == 0) nxt_ = atomicAdd(queue, 1u);
        const int u = (uq < 512 + 384) ? uq : (uq < 512 + 384 + 768) ? (uq - 384 + 768) : (uq - 768);
#if 1
        if (abl >= 0 && rep == 0 && REPEAT_K == 2) { const int kind = (u >= 1280) ? 2 : (u < 512 ? 0 : 1); if (!((PROBE_ATT >> kind) & 1)) { if (F.wave == 0 && lane_now() == 0) F.LC[LC_BCAST] = ahead ? nxt_ : atomicAdd(queue, 1u); continue; } }
#endif
        if (u < 512) {
            const int c = 15 - u / 32, v = u % 32, b = v >> 2, h = v & 3; const size_t rb = (size_t)b * SEQ;
            attn_shared_unit<96>(F, QA + rb * 384 + h * 96, 384, KA + rb * 384 + h * 96, 384, VA + rb * 256 + h * 64, 256, O + rb * 1024 + h * 64,
                                 256 * c, 4 * (c + 1), 1.0f, false, nullptr, abl);
            if (F.wave == 0 && lane_now() == 0) F.LC[LC_BCAST] = atomicAdd(queue, 1u);
        } else if (u < 1280) {
            const int v = u - 512, j = v / 48, bh = v % 48, b = bh / 6, h = bh % 6; const size_t rb = (size_t)b * SEQ;
            const int n = (int)__hip_atomic_load(mcnt + (size_t)(bh * 16 + j) * 64, RLX_AGENT);
            attn_moba_kb_unit(F, QKV + rb * 384 + h * 64, QKV + SEG_ELEMS + rb * 384 + h * 64, QKV + 2 * SEG_ELEMS + rb * 384 + h * 64,
                              PBo + (size_t)bh * 4096 * 4 * 64, PBl + (size_t)bh * 4096 * 4, j, mlist + (size_t)(bh * 16 + j) * MOBA_CAP, n, abl, nxt_);
        } else {
            const int v = u - 1280, bh = v >> 4, b = bh / 6, h = bh % 6, pb = v & 15; const size_t rb = (size_t)b * SEQ;
            attn_dilated_unit(F, QKV + 3 * SEG_ELEMS + rb * 384 + h * 64, QKV + 4 * SEG_ELEMS + rb * 384 + h * 64, QKV + 5 * SEG_ELEMS + rb * 384 + h * 64,
                              O + rb * 1024 + 640 + h * 64, L14 + rb * 6 + h, 256 * pb, abl, nxt_);
        }
    }
}

__device__ __forceinline__ void p4_router(Frame& F, const Args& a, int l, int rep) {
    unsigned char* ws = F.ws;
    const float* y1 = a.out;
    const bf16_t* RWh = (const bf16_t*)(ws + WS_RW) + (size_t)(l * 2) * 65536; const bf16_t* RWl = RWh + 65536;
    const float* PS = (const float*)(ws + WS_PS);
    unsigned* cnt = (unsigned*)(F.ctl + CW_CNT + 4096 * (l + 2 * rep));
    int* tokslot = (int*)(ws + (rep ? WS_H : WS_TOKSLOT)); float* gate = (float*)(ws + (rep ? WS_H + 8 * MiB : WS_GATE));
    bf16_t* x1b = (bf16_t*)(ws + WS_XB); float* stats = (float*)(ws + WS_STATS);
    const float* g1 = a.ln1_g + l * 1024; const float* b1 = a.ln1_b + l * 1024;
    const int lane = lane_now(), wave = F.wave, tid = wave * 64 + lane, r32 = lane & 31, hi = lane >> 5, pr = wave >> 1, half = wave & 1;
    LAS unsigned char* wl = F.lds + wave * 9472;
    LAS bf16_t* hiT = (LAS bf16_t*)wl; LAS bf16_t* loT = (LAS bf16_t*)(wl + 4608); LAS f32x2* stT = (LAS f32x2*)(wl + 9216);
    LAS float* xch = (LAS float*)(F.lds + 81920 + pr * 8192);
    LAS float* rbias = (LAS float*)(F.lds + 141312);
    LAS unsigned char* wbuf = F.lds + 75776;
    LAS unsigned* hist = (LAS unsigned*)(F.lds + 141568); LAS unsigned* hbase = (LAS unsigned*)(F.lds + 141824);
    if (tid < 64) { rbias[tid] = a.router_b[tid]; hist[tid] = 0u; }
    __syncthreads();
    const int rsub = lane >> 4, c4 = (lane & 15) * 4;
    for (int it = F.vcu * 4 + pr; it < T / 32; it += F.G * 4) {
        const size_t t0 = (size_t)it * 32;
        if (lane < 32) { const float* ps = PS + (t0 + lane) * 32; float s = 0.f, q = 0.f;
#pragma unroll
            for (int i = 0; i < 8; ++i) { const f32x4 v = *(const GAS f32x4*)(ps + 4 * i); s += v[0] + v[2]; q += v[1] + v[3]; }
            const float mu = s * (1.0f / 1024.0f); const float var = __builtin_fmaxf(q * (1.0f / 1024.0f) - mu * mu, 0.f); const float rstd = 1.0f / sqrtf(var + LN_EPS);
            stT[lane] = (f32x2){mu, rstd};
            if (half == 0) *(GAS f32x2*)(stats + 2 * (t0 + lane)) = (f32x2){mu, rstd}; }
        f32x2 st8[8];
#pragma unroll
        for (int i = 0; i < 8; ++i) st8[i] = stT[4 * i + rsub];
        const int cb = half * 512;
        const float* ybase = y1 + (t0 + rsub) * 1024 + cb + c4;
        f32x4 ycur[8], ynext[8];
#pragma unroll
        for (int i = 0; i < 8; ++i) ycur[i] = *(const GAS f32x4*)(ybase + (size_t)(4 * i) * 1024);
        f32x16 a0 = {}, a1 = {};
        u32x4 wreg[4];
#define RW_LOAD(c) do { _Pragma("unroll") for (int i_ = 0; i_ < 4; ++i_) { const int p_ = tid + 512 * i_, c8_ = p_ & 7, e_ = (p_ >> 3) & 63, hl_ = (p_ >> 9) & 1, hf_ = p_ >> 10; \
            wreg[i_] = *(const GAS u32x4*)((hl_ ? RWl : RWh) + (size_t)e_ * 1024 + hf_ * 512 + 64 * (c) + c8_ * 8); } } while (0)
#define RW_WRITE(b) do { _Pragma("unroll") for (int i_ = 0; i_ < 4; ++i_) { const int p_ = tid + 512 * i_, c8_ = p_ & 7, e_ = (p_ >> 3) & 63, hl_ = (p_ >> 9) & 1, hf_ = p_ >> 10; \
            *(LAS u32x4*)(wbuf + (b) * 32768 + ((hf_ * 2 + hl_) * 64 + e_) * 128 + ((c8_ ^ (e_ & 7)) * 16)) = wreg[i_]; } } while (0)
        RW_LOAD(0); RW_WRITE(0);
        __syncthreads();
#pragma unroll 1
        for (int c = 0; c < 8; ++c) {
            if (c + 1 < 8) RW_LOAD(c + 1);
            if (c + 1 < 8) {
#pragma unroll
                for (int i = 0; i < 8; ++i) ynext[i] = *(const GAS f32x4*)(ybase + (size_t)(4 * i) * 1024 + 64 * (c + 1)); }
            const f32x4 gv = *(const GAS f32x4*)(g1 + cb + 64 * c + c4), bv = *(const GAS f32x4*)(b1 + cb + 64 * c + c4);
#pragma unroll
            for (int i = 0; i < 8; ++i) { const int row = 4 * i + rsub; const f32x4 xv = (ycur[i] - st8[i][0]) * st8[i][1] * gv + bv;
                *(GAS u32x2*)(x1b + (t0 + row) * 1024 + cb + 64 * c + c4) = pack4(xv);
                const unsigned h01 = cvtpk(xv[0], xv[1]), h23 = cvtpk(xv[2], xv[3]);
                const unsigned l01 = cvtpk(xv[0] - bflo(h01), xv[1] - bfhi(h01)), l23 = cvtpk(xv[2] - bflo(h23), xv[3] - bfhi(h23));
                *(LAS u32x2*)(hiT + row * 72 + c4) = (u32x2){h01, h23};
                *(LAS u32x2*)(loT + row * 72 + c4) = (u32x2){l01, l23}; }
            asm volatile("" ::: "memory");
            bf16x8 yh[4], yl[4];
#pragma unroll
            for (int ks = 0; ks < 4; ++ks) { yh[ks] = *(const LAS bf16x8*)(hiT + r32 * 72 + 16 * ks + 8 * hi); yl[ks] = *(const LAS bf16x8*)(loT + r32 * 72 + 16 * ks + 8 * hi); }
            asm volatile("s_waitcnt lgkmcnt(0)" ::: "memory");
#pragma unroll
            for (int ks = 0; ks < 4; ++ks) {
                const LAS unsigned char* wb_ = wbuf + (c & 1) * 32768 + (half * 2) * 8192 + r32 * 128 + (((2 * ks + hi) ^ (r32 & 7)) * 16);
                const bf16x8 h0 = *(const LAS bf16x8*)(wb_), h1 = *(const LAS bf16x8*)(wb_ + 4096);
                const bf16x8 l0 = *(const LAS bf16x8*)(wb_ + 8192), l1 = *(const LAS bf16x8*)(wb_ + 8192 + 4096);
                a0 = MFMA32(h0, yh[ks], a0); a0 = MFMA32(h0, yl[ks], a0); a0 = MFMA32(l0, yh[ks], a0);
                a1 = MFMA32(h1, yh[ks], a1); a1 = MFMA32(h1, yl[ks], a1); a1 = MFMA32(l1, yh[ks], a1); }
#pragma unroll
            for (int i = 0; i < 8; ++i) ycur[i] = ynext[i];
            if (c + 1 < 8) { if (c & 1) RW_WRITE(0); else RW_WRITE(1); }
            __syncthreads();
        }
#undef RW_LOAD
#undef RW_WRITE
        if (half == 1) {
#pragma unroll
            for (int r = 0; r < 16; ++r) { xch[r * 64 + lane] = a0[r]; xch[(16 + r) * 64 + lane] = a1[r]; } }
        __syncthreads();
        float g1_ = 0.f, g2_ = 0.f; int e1_ = 0, e2_ = 0; unsigned r1_ = 0u, r2_ = 0u;
        if (half == 0) {
#pragma unroll
            for (int r = 0; r < 16; ++r) { a0[r] += xch[r * 64 + lane]; a1[r] += xch[(16 + r) * 64 + lane]; }
            const size_t tok = t0 + r32;
            float bestg = -3e38f, bs1 = 0.f, bs2 = 0.f; int be1 = 0, be2 = 1;
#pragma unroll
            for (int gi = 0; gi < 8; ++gi) {
                const int blk = gi >> 2, q = gi & 3;
                float B1 = -3e38f, B2 = -3e38f, S1 = 0.f, S2 = 0.f; int I1 = 0, I2 = 0;
#pragma unroll
                for (int j = 0; j < 4; ++j) {
                    const int e = 32 * blk + 8 * q + 4 * hi + j;
                    const float logit = (blk == 0) ? a0[4 * q + j] : a1[4 * q + j];
                    const float s = 1.0f / (1.0f + __expf(-logit)); const float sb = s + rbias[e];
                    const int idx = 4 * hi + j;
                    if (sb > B1) { B2 = B1; S2 = S1; I2 = I1; B1 = sb; S1 = s; I1 = idx; } else if (sb > B2) { B2 = sb; S2 = s; I2 = idx; }
                }
                const float pB1 = xhalf(B1), pB2 = xhalf(B2), pS1 = xhalf(S1), pS2 = xhalf(S2); const int pI1 = __builtin_bit_cast(int, xhalf(__builtin_bit_cast(float, I1))), pI2 = __builtin_bit_cast(int, xhalf(__builtin_bit_cast(float, I2)));
                const bool mine_first = (B1 > pB1) || (B1 == pB1 && I1 < pI1);
                float T1, T2, U1, U2; int J1, J2;
                if (mine_first) { T1 = B1; U1 = S1; J1 = I1; const bool sec_mine = (B2 > pB1) || (B2 == pB1 && I2 < pI1); if (sec_mine) { T2 = B2; U2 = S2; J2 = I2; } else { T2 = pB1; U2 = pS1; J2 = pI1; } }
                else { T1 = pB1; U1 = pS1; J1 = pI1; const bool sec_p = (pB2 > B1) || (pB2 == B1 && pI2 < I1); if (sec_p) { T2 = pB2; U2 = pS2; J2 = pI2; } else { T2 = B1; U2 = S1; J2 = I1; } }
                const float gs = T1 + T2;
                if (gs > bestg) { bestg = gs; bs1 = U1; bs2 = U2; be1 = 8 * gi + J1; be2 = 8 * gi + J2; }
            }
            const float ginv = 1.0f / (bs1 + bs2);
            g1_ = bs1 * ginv; g2_ = bs2 * ginv; e1_ = be1; e2_ = be2;
            if (hi == 0) { r1_ = __hip_atomic_fetch_add(hist + be1, 1u, __ATOMIC_RELAXED, __HIP_MEMORY_SCOPE_WORKGROUP); r2_ = __hip_atomic_fetch_add(hist + be2, 1u, __ATOMIC_RELAXED, __HIP_MEMORY_SCOPE_WORKGROUP); }
        }
        __syncthreads();
        if (tid < 64) { const unsigned h_ = hist[tid]; hbase[tid] = h_ ? atomicAdd(cnt + 64 * tid, h_) : 0u; hist[tid] = 0u; }
        __syncthreads();
        if (half == 0 && hi == 0) { const size_t tok = t0 + r32;
            const size_t i1 = (size_t)e1_ * CAP + hbase[e1_] + r1_, i2 = (size_t)e2_ * CAP + hbase[e2_] + r2_;
            tokslot[i1] = (int)(2 * tok); gate[i1] = g1_; tokslot[i2] = (int)(2 * tok + 1); gate[i2] = g2_; }
        __syncthreads();
    }
}

__device__ __forceinline__ void p7_ln2(Frame& F, const Args& a, int l, bool dummy) {
    unsigned char* ws = F.ws;
    float* y1 = a.out; const float* stats = (const float*)(ws + WS_STATS); const bf16_t* Y = (const bf16_t*)(ws + WS_Y); bf16_t* xb = (bf16_t*)(ws + WS_XB);
    const float* g1 = a.ln1_g + l * 1024; const float* b1 = a.ln1_b + l * 1024; const float* g2 = a.ln2_g + l * 1024; const float* b2 = a.ln2_b + l * 1024;
    const int gw = F.vcu * NWAVES + F.wave, NGW = F.G * NWAVES, lane = lane_now();
    f32x4 g1v[4], b1v[4], g2v[4], b2v[4];
#pragma unroll
    for (int j = 0; j < 4; ++j) { const int c = 4 * lane + 256 * j; g1v[j] = *(const GAS f32x4*)(g1 + c); b1v[j] = *(const GAS f32x4*)(b1 + c); g2v[j] = *(const GAS f32x4*)(g2 + c); b2v[j] = *(const GAS f32x4*)(b2 + c); }
    for (int row0 = gw; row0 < T; row0 += 2 * NGW) {
        const int rowA = row0, rowB = (row0 + NGW < T) ? row0 + NGW : row0;
        f32x4 z[2][4]; float s[2] = {0.f, 0.f};
#pragma unroll
        for (int q = 0; q < 2; ++q) { const size_t row = q ? rowB : rowA; const f32x2 st = *(const GAS f32x2*)(stats + 2 * row);
#pragma unroll
            for (int j = 0; j < 4; ++j) { const int c = 4 * lane + 256 * j;
                const f32x4 yv = *(const GAS f32x4*)(y1 + row * 1024 + c);
                const u32x2 e0 = __builtin_nontemporal_load((const GAS u32x2*)(Y + (2 * row) * 1024 + c)), e1 = __builtin_nontemporal_load((const GAS u32x2*)(Y + (2 * row + 1) * 1024 + c));
                const f32x4 x1 = (yv - st[0]) * st[1] * g1v[j] + b1v[j];
                const f32x4 f0 = {bflo(e0.x), bfhi(e0.x), bflo(e0.y), bfhi(e0.y)}, f1 = {bflo(e1.x), bfhi(e1.x), bflo(e1.y), bfhi(e1.y)};
                z[q][j] = x1 * ALPHA + f0 + f1; s[q] += (z[q][j][0] + z[q][j][1]) + (z[q][j][2] + z[q][j][3]); } }
        float mean[2], s2[2] = {0.f, 0.f}, rstd[2];
        mean[0] = wave_sum(s[0]) * (1.0f / 1024.0f); mean[1] = wave_sum(s[1]) * (1.0f / 1024.0f);
#pragma unroll
        for (int q = 0; q < 2; ++q)
#pragma unroll
            for (int j = 0; j < 4; ++j) { z[q][j] = z[q][j] - mean[q]; s2[q] += (z[q][j][0] * z[q][j][0] + z[q][j][1] * z[q][j][1]) + (z[q][j][2] * z[q][j][2] + z[q][j][3] * z[q][j][3]); }
        rstd[0] = 1.0f / sqrtf(wave_sum(s2[0]) * (1.0f / 1024.0f) + LN_EPS); rstd[1] = 1.0f / sqrtf(wave_sum(s2[1]) * (1.0f / 1024.0f) + LN_EPS);
#pragma unroll
        for (int q = 0; q < 2; ++q) { const size_t row = q ? rowB : rowA; if (q == 1 && rowB == rowA) break;
#pragma unroll
            for (int j = 0; j < 4; ++j) { const int c = 4 * lane + 256 * j; const f32x4 o = z[q][j] * rstd[q] * g2v[j] + b2v[j];
                if (!dummy) { *(GAS f32x4*)(y1 + row * 1024 + c) = o; if (l + 1 < DEPTH) *(GAS u32x2*)(xb + row * 1024 + c) = pack4(o); } } }
    }
}

constexpr int N_PHASES = 1 + 9 * DEPTH;
#ifndef MK_N_LAUNCHES
#define MK_N_LAUNCHES 1
#endif

__device__ __forceinline__ void moe_tables(Frame& F, int l) {
    const unsigned* cntg = (const unsigned*)(F.ctl + CW_CNT + 4096 * l);
    const int tid = F.wave * 64 + lane_now();
    if (tid < 64) {
        const unsigned c = __hip_atomic_load(cntg + 64 * tid, RLX_AGENT); F.LC[LC_CNT + tid] = c;
        const unsigned tl = (c + 255u) >> 8; unsigned incl = tl;
#pragma unroll
        for (int d = 1; d < 64; d <<= 1) { const unsigned o = (unsigned)__builtin_amdgcn_ds_bpermute((tid - d) << 2, (int)incl); if (tid >= d) incl += o; }
        F.LC[LC_TB + tid] = incl - tl; if (tid == 63) F.LC[LC_TB + 64] = incl; }
    __syncthreads();
}

__global__ void __launch_bounds__(NTHREADS, 2) mega_fwd(Args a_in) {
    extern __shared__ __attribute__((aligned(16))) unsigned char lds_raw[];
    Frame F;
    F.lds = (LAS unsigned char*)lds_raw;
    F.LC = (volatile LAS unsigned*)(F.lds + LDSCTL_OFF);
    F.ws = a_in.ws; F.ctl = (gu32*)(a_in.ws + WS_CTL);
    F.wave = __builtin_amdgcn_readfirstlane((int)threadIdx.x >> 6);
    F.G = gridDim.x; { const int bx = blockIdx.x; F.vcu = (F.G % 8 == 0) ? (bx % 8) * (F.G / 8) + bx / 8 : bx; }
    for (int u = threadIdx.x; u < (LDS_BYTES - LDSCTL_OFF) / 4; u += NTHREADS) F.LC[u] = 0u;
    __syncthreads();
    XcdBarrier bar; bar.bar = (unsigned*)(F.ctl + CW_BAR); bar.x = 0; bar.st = nullptr;
    if (MK_N_LAUNCHES == 1) bar = xcd_barrier_post((unsigned*)(F.ctl + CW_BAR), F.LC + LC_BAR, threadIdx.x == 0);
    const int lo = a_in.ph_lo, hi = a_in.ph_hi;
    const int wave_sgpr = __builtin_amdgcn_readfirstlane((int)threadIdx.x >> 6);
#define LAUNDER(p) asm volatile("" : "+s"(p))
    int ph = lo, rep = 0; bool first = true;
    while (ph < hi) {
        if (!first) { int ln0_; asm volatile("v_mbcnt_lo_u32_b32 %0, -1, 0\n\tv_mbcnt_hi_u32_b32 %0, -1, %0" : "=v"(ln0_)); xcd_barrier(bar, wave_sgpr == 0 && ln0_ == 0); }
        first = false;
        Args a = a_in;
        LAUNDER(a.x); LAUNDER(a.w_in); LAUNDER(a.q_norm); LAUNDER(a.w_uq); LAUNDER(a.kv_norm); LAUNDER(a.w_ukv); LAUNDER(a.w_out); LAUNDER(a.ln1_g); LAUNDER(a.ln1_b);
        LAUNDER(a.router_w); LAUNDER(a.router_b); LAUNDER(a.w1); LAUNDER(a.w3); LAUNDER(a.w2); LAUNDER(a.ln2_g); LAUNDER(a.ln2_b); LAUNDER(a.out); LAUNDER(a.ws);
        unsigned char* ws = a.ws; F.ws = ws; F.ctl = (gu32*)(ws + WS_CTL);
        { int w_ = wave_sgpr; LAUNDER(w_); F.wave = w_; }
#ifdef TSEL
        if (blockIdx.x == 0 && wave_sgpr == 0 && rep == 0) { const unsigned long long t_ = __builtin_amdgcn_s_memrealtime(); if (lane_now() == 0) ((GAS unsigned long long*)(ws + WS_GB + 8192))[ph] = t_; }
#endif
        const int l = (ph - 1) / 9, k = (ph == 0) ? 9 : ((ph - 1) % 9);
        bf16_t* PBo = (l == 0) ? (bf16_t*)a.out : (bf16_t*)(ws + WS_MOE); float* PBl = (float*)(ws + WS_CQ);
        if (k == 9) {
            p0_prologue(F, a);
        } else if (k == 0) {
            pg8::StaticOrder S; S.init(T, N_INP, F.G, (int)blockIdx.x);
            EpiP1 E{(bf16_t*)(ws + WS_CQ), (bf16_t*)(ws + WS_CKV), (bf16_t*)(ws + WS_KR), (bf16_t*)(ws + WS_QKV), (const f32x2*)(ws + WS_T64), (const f32x2*)(ws + WS_T32),
                    (float*)(F.ctl + CW_KMEAN) + (size_t)l * (8 * 6 * 16 * 64)};
            pg8::gemm_phase<EpiP1, pg8::StaticOrder, true, true>(F.wave, F.lds, (const bf16_t*)(ws + WS_XB), (const bf16_t*)(ws + WS_WIN + (size_t)l * WIN_L), DM, S, E);
            if (l == 0) moe_convert_tail(F, a, 0, 0, MOE_P0_FROM, S.nwg, (int)blockIdx.x); else moe_convert_tail(F, a, 1, MOE_L1_B, 16384, S.nwg, (int)blockIdx.x, 1);
        } else if (k == 1) {
            p1b_mla(F, l); p1c_moba_gate(F, l, rep);
        } else if (k == 2) {
            p2_attention(F, l, rep, (REPEAT_K == 2 && rep == 0) ? ABL : 0, PBo, PBl);
        } else if (k == 3) {
            p2c_d16(F); p2c_moba_merge(F, PBo, PBl);
        } else if (k == 4) {
            pg8::StaticOrder S; S.init(T, DM, F.G, (int)blockIdx.x);
            EpiP3 E{l == 0 ? a.x : (const float*)a.out, a.out, (float*)(ws + WS_PS)};
            pg8::gemm_phase<EpiP3, pg8::StaticOrder, true, true>(F.wave, F.lds, (const bf16_t*)(ws + WS_XB), (const bf16_t*)(ws + WS_WOUT) + (size_t)l * DM * DM, DM, S, E);
        } else if (k == 5) {
            p4_router(F, a, l, rep);
        } else if (k == 6) {
            moe_tables(F, l);
            const LAS int* tb = (const LAS int*)(F.lds + LDSCTL_OFF) + LC_TB; const LAS int* cn = (const LAS int*)(F.lds + LDSCTL_OFF) + LC_CNT;
            MoeSched S{tb, cn, (const int*)(ws + WS_TOKSLOT), 2, F.G, F.vcu, tb[64], true};
            EpiP5 E{(bf16_t*)(ws + WS_H)};
            pg8::gemm_phase<EpiP5, MoeSched, true, true>(F.wave, F.lds, (const bf16_t*)(ws + WS_XB), (const bf16_t*)(ws + WS_MOE + (size_t)l * MOE_L), DM, S, E);
            if (l == 0) moe_convert_tail(F, a, 1, 0, MOE_L1_A, S.ntiles * 2, F.vcu, 1); else moe_convert_tail(F, a, 1, 0, 8192, S.ntiles * 2, F.vcu, 2);
        } else if (k == 7) {
            moe_tables(F, l);
            const LAS int* tb = (const LAS int*)(F.lds + LDSCTL_OFF) + LC_TB; const LAS int* cn = (const LAS int*)(F.lds + LDSCTL_OFF) + LC_CNT;
            MoeSched S{tb, cn, (const int*)(ws + WS_TOKSLOT), 4, F.G, F.vcu, tb[64], false};
            EpiP6 E{(bf16_t*)(ws + WS_Y), tb, cn, (const int*)(ws + WS_TOKSLOT), (const float*)(ws + WS_GATE)};
            pg8::gemm_phase<EpiP6, MoeSched, true, true>(F.wave, F.lds, (const bf16_t*)(ws + WS_H), (const bf16_t*)(ws + WS_MOE + (size_t)l * MOE_L + 64 * MiB), DEXP, S, E);
            if (l == 0) moe_convert_tail(F, a, 1, MOE_L1_A, MOE_L1_B, S.ntiles * 4, F.vcu, 1);
        } else {
            p7_ln2(F, a, l, (REPEAT_K == 8) && rep == 0);
        }
        const int nrep = (REPEAT_K >= 0 && k == REPEAT_K && (REPEAT_K != 4 || l == 0)) ? 1 + REPEAT_N : 1;
        if (++rep >= nrep) { rep = 0; ++ph; }
    }
}

extern "C" void kernel_launch(void* const* d_in, const int* in_sizes, int n_in, void* d_out, int out_size, void* d_ws, size_t ws_size, hipStream_t stream) {
    static int grid = 0;
    if (grid == 0) {
        if (n_in != 16 || out_size != T * DM || ws_size < WS_END) { fprintf(stderr, "kernel_launch: unexpected shapes (n_in %d out %d ws %zu need %zu)\n", n_in, out_size, ws_size, (size_t)WS_END); grid = -1; return; }
        int dev = 0, cus = 0, per_cu = 0;
        if (hipGetDevice(&dev) != hipSuccess || hipDeviceGetAttribute(&cus, hipDeviceAttributeMultiprocessorCount, dev) != hipSuccess) { grid = -1; return; }
        if (hipFuncSetAttribute((const void*)mega_fwd, hipFuncAttributeMaxDynamicSharedMemorySize, LDS_BYTES) != hipSuccess) { grid = -1; return; }
        if (hipOccupancyMaxActiveBlocksPerMultiprocessor(&per_cu, (const void*)mega_fwd, NTHREADS, LDS_BYTES) != hipSuccess || per_cu < 1) { fprintf(stderr, "kernel_launch: occupancy query says %d blocks/CU\n", per_cu); per_cu = 1; }
        (void)hipGetLastError();
        grid = cus;
    }
    if (grid < 0) return;
    if (hipMemsetAsync((char*)d_ws + WS_CTL, 0, CTL_BYTES, stream) != hipSuccess) return;
    Args a{};
    a.x = (const float*)d_in[0]; a.w_in = (const float*)d_in[1]; a.q_norm = (const float*)d_in[2]; a.w_uq = (const float*)d_in[3]; a.kv_norm = (const float*)d_in[4];
    a.w_ukv = (const float*)d_in[5]; a.w_out = (const float*)d_in[6]; a.ln1_g = (const float*)d_in[7]; a.ln1_b = (const float*)d_in[8]; a.router_w = (const float*)d_in[9];
    a.router_b = (const float*)d_in[10]; a.w1 = (const float*)d_in[11]; a.w3 = (const float*)d_in[12]; a.w2 = (const float*)d_in[13]; a.ln2_g = (const float*)d_in[14]; a.ln2_b = (const float*)d_in[15];
    a.out = (float*)d_out; a.ws = (unsigned char*)d_ws;
#if MK_N_LAUNCHES == 1
    a.ph_lo = 0; a.ph_hi = N_PHASES;
    hipLaunchKernelGGL(mega_fwd, dim3(grid), dim3(NTHREADS), LDS_BYTES, stream, a);
#else
    for (int ph = 0; ph < N_PHASES; ++ph) { a.ph_lo = ph; a.ph_hi = ph + 1; hipLaunchKernelGGL(mega_fwd, dim3(grid), dim3(NTHREADS), LDS_BYTES, stream, a); }
#endif
}
```
